# Optimizing an MI355X kernel written in HIP

```python
import math
import jax, jax.numpy as jnp
from jax import lax
import numpy as np

D_MODEL = 1024
BATCH = 4
SEQ = 8192
DEPTH = 1

N_META = 16
BLOCK = 128
N_PAD = BLOCK - N_META
D_MIX = D_MODEL
DIFF_WIDTH = D_MIX // 2
DIFF_V_DIM = 128
DIFF_QK_DIM = DIFF_V_DIM // 2
DIFF_HEADS = DIFF_WIDTH // DIFF_V_DIM
FOX_WIDTH = D_MIX - DIFF_WIDTH
FOX_HEAD_DIM = 64
FOX_HEADS = FOX_WIDTH // FOX_HEAD_DIM
ROPE_DIMS = DIFF_QK_DIM // 4
ROPE_THETA = 500000.0
D_FF = ((8 * D_MODEL // 3 + 255) // 256) * 256
RMS_EPS = 1e-6
SUBLN_EPS = 1e-5
NEG_INF = -1e30
DIFF_Q_COLS = DIFF_HEADS * 2 * DIFF_QK_DIM
DIFF_K_COLS = DIFF_HEADS * 2 * DIFF_QK_DIM
DIFF_V_COLS = DIFF_HEADS * DIFF_V_DIM
FOX_Q_COLS = FOX_HEADS * FOX_HEAD_DIM
FOX_K_COLS = FOX_HEADS * FOX_HEAD_DIM
FOX_V_COLS = FOX_HEADS * FOX_HEAD_DIM
FOX_F_COLS = FOX_HEADS
IN_COLS = DIFF_Q_COLS + DIFF_K_COLS + DIFF_V_COLS + FOX_Q_COLS + FOX_K_COLS + FOX_V_COLS + FOX_F_COLS
SPLITS = list(np.cumsum([DIFF_Q_COLS, DIFF_K_COLS, DIFF_V_COLS, FOX_Q_COLS, FOX_K_COLS, FOX_V_COLS]))

kernel_name = "hybrid_diffattn_fox_macaron_meta"


def lambda_init_fn(layer_idx):
    return 0.8 - 0.6 * math.exp(-0.3 * layer_idx)


def rmsnorm(x, g, eps=RMS_EPS):
    xf = x.astype(jnp.float32)
    y = xf * lax.rsqrt(jnp.mean(xf * xf, axis=-1, keepdims=True) + eps)
    return (y * g.astype(jnp.float32)).astype(x.dtype)


def swiglu(x, w_gate_up, w_down):
    g, u = jnp.split(x @ w_gate_up, 2, axis=-1)
    return (jax.nn.silu(g) * u) @ w_down


def apply_partial_rope(t, cos, sin):
    tf = t.astype(jnp.float32)
    half = ROPE_DIMS // 2
    x1 = tf[..., :half]
    x2 = tf[..., half:ROPE_DIMS]
    rot = jnp.concatenate([x1 * cos - x2 * sin, x2 * cos + x1 * sin, tf[..., ROPE_DIMS:]], axis=-1)
    return rot.astype(t.dtype)


def hybrid_mixer(hn, w_in, b_forget, lam_q1, lam_k1, lam_q2, lam_k2, subln_g, w_out, lambda_init):
    B, L, _ = hn.shape
    Lp = L + N_PAD
    n_blocks = Lp // BLOCK
    proj = hn @ w_in
    dq, dk, dv, fq, fk, fv, fl = jnp.split(proj, SPLITS, axis=-1)
    pad = lambda t: jnp.pad(t, ((0, 0), (N_PAD, 0), (0, 0)))

    pos = (jnp.arange(Lp, dtype=jnp.int32) - N_PAD).astype(jnp.float32)
    inv_freq = jnp.power(ROPE_THETA, -jnp.arange(0, ROPE_DIMS, 2, dtype=jnp.float32) / ROPE_DIMS)
    ang = pos[:, None] * inv_freq[None, :]
    cos = jnp.cos(ang)[None, :, None, None, :]
    sin = jnp.sin(ang)[None, :, None, None, :]

    dq = apply_partial_rope(pad(dq).reshape(B, Lp, DIFF_HEADS, 2, DIFF_QK_DIM), cos, sin).transpose(0, 2, 3, 1, 4)
    dk = apply_partial_rope(pad(dk).reshape(B, Lp, DIFF_HEADS, 2, DIFF_QK_DIM), cos, sin).transpose(0, 2, 3, 1, 4)
    dv = pad(dv).reshape(B, Lp, DIFF_HEADS, DIFF_V_DIM).transpose(0, 2, 1, 3)
    lam = (jnp.exp(jnp.sum(lam_q1.astype(jnp.float32) * lam_k1.astype(jnp.float32)))
           - jnp.exp(jnp.sum(lam_q2.astype(jnp.float32) * lam_k2.astype(jnp.float32)))
           + lambda_init)

    fq = pad(fq).reshape(B, Lp, FOX_HEADS, FOX_HEAD_DIM).transpose(0, 2, 1, 3)
    fk = pad(fk).reshape(B, Lp, FOX_HEADS, FOX_HEAD_DIM).transpose(0, 2, 1, 3)
    fv = pad(fv).reshape(B, Lp, FOX_HEADS, FOX_HEAD_DIM).transpose(0, 2, 1, 3)
    log_f = jax.nn.log_sigmoid(fl.astype(jnp.float32) + b_forget.astype(jnp.float32))
    log_f = jnp.pad(log_f, ((0, 0), (N_PAD, 0), (0, 0)))
    cum = jnp.cumsum(log_f, axis=1).transpose(0, 2, 1)

    diff_scale = DIFF_QK_DIM ** -0.5
    fox_scale = FOX_HEAD_DIM ** -0.5
    kidx = jnp.arange(Lp, dtype=jnp.int32)

    def block(i):
        start = i * BLOCK
        qidx = start + jnp.arange(BLOCK, dtype=jnp.int32)
        valid = (kidx[None, :] <= qidx[:, None]) & (kidx[None, :] >= N_PAD)
        q_d = lax.dynamic_slice_in_dim(dq, start, BLOCK, axis=3)
        s_d = jnp.einsum('bhcqd,bhckd->bhcqk', q_d, dk, preferred_element_type=jnp.float32) * diff_scale
        p_d = jax.nn.softmax(jnp.where(valid, s_d, NEG_INF), axis=-1)
        a_d = p_d[:, :, 0] - lam * p_d[:, :, 1]
        o_d = jnp.einsum('bhqk,bhkd->bhqd', a_d.astype(dv.dtype), dv)
        o_d = rmsnorm(o_d, subln_g, SUBLN_EPS) * (1.0 - lambda_init)
        q_f = lax.dynamic_slice_in_dim(fq, start, BLOCK, axis=2)
        c_q = lax.dynamic_slice_in_dim(cum, start, BLOCK, axis=2)
        s_f = (jnp.einsum('bhqd,bhkd->bhqk', q_f, fk, preferred_element_type=jnp.float32) * fox_scale
               + c_q[..., :, None] - cum[..., None, :])
        p_f = jax.nn.softmax(jnp.where(valid, s_f, NEG_INF), axis=-1)
        o_f = jnp.einsum('bhqk,bhkd->bhqd', p_f.astype(fv.dtype), fv)
        return jnp.concatenate([
            o_d.transpose(0, 2, 1, 3).reshape(B, BLOCK, DIFF_WIDTH),
            o_f.transpose(0, 2, 1, 3).reshape(B, BLOCK, FOX_WIDTH)], axis=-1)

    outs = lax.map(block, jnp.arange(n_blocks, dtype=jnp.int32))
    o = outs.transpose(1, 0, 2, 3).reshape(B, Lp, D_MIX)[:, N_PAD:]
    return o @ w_out


def setup_inputs(seed: int = 0) -> dict:
    key = jax.random.key(seed)
    ks = jax.random.split(key, 20)
    f32 = jnp.float32
    nrm = lambda k, shape, scale: jax.random.normal(k, shape, f32) * scale
    gain = lambda k, shape: 1.0 + 0.02 * jax.random.normal(k, shape, f32)
    return {
        "x": jax.random.normal(ks[0], (BATCH, SEQ, D_MODEL), f32),
        "meta_tokens": nrm(ks[1], (N_META, D_MODEL), 1.0),
        "ffn1_norm_g": gain(ks[2], (DEPTH, D_MODEL)),
        "ffn1_w_gate_up": nrm(ks[3], (DEPTH, D_MODEL, 2 * D_FF), D_MODEL ** -0.5),
        "ffn1_w_down": nrm(ks[4], (DEPTH, D_FF, D_MODEL), D_FF ** -0.5),
        "mix_norm_g": gain(ks[5], (DEPTH, D_MODEL)),
        "w_in": nrm(ks[6], (DEPTH, D_MODEL, IN_COLS), D_MODEL ** -0.5),
        "b_forget": 1.0 + 0.1 * jax.random.normal(ks[7], (DEPTH, FOX_HEADS), f32),
        "lam_q1": nrm(ks[8], (DEPTH, DIFF_QK_DIM), 0.1),
        "lam_k1": nrm(ks[9], (DEPTH, DIFF_QK_DIM), 0.1),
        "lam_q2": nrm(ks[10], (DEPTH, DIFF_QK_DIM), 0.1),
        "lam_k2": nrm(ks[11], (DEPTH, DIFF_QK_DIM), 0.1),
        "diff_subln_g": gain(ks[12], (DEPTH, DIFF_V_DIM)),
        "w_out": nrm(ks[13], (DEPTH, D_MIX, D_MODEL), D_MIX ** -0.5),
        "ffn2_norm_g": gain(ks[14], (DEPTH, D_MODEL)),
        "ffn2_w_gate_up": nrm(ks[15], (DEPTH, D_MODEL, 2 * D_FF), D_MODEL ** -0.5),
        "ffn2_w_down": nrm(ks[16], (DEPTH, D_FF, D_MODEL), D_FF ** -0.5),
        "final_norm_g": gain(ks[17], (D_MODEL,)),
    }


def reference(x, meta_tokens, ffn1_norm_g, ffn1_w_gate_up, ffn1_w_down, mix_norm_g, w_in, b_forget,
              lam_q1, lam_k1, lam_q2, lam_k2, diff_subln_g, w_out, ffn2_norm_g, ffn2_w_gate_up,
              ffn2_w_down, final_norm_g):
    B = x.shape[0]
    meta = jnp.broadcast_to(meta_tokens.astype(x.dtype)[None], (B, N_META, D_MODEL))
    h = jnp.concatenate([meta, x], axis=1)
    for layer in range(DEPTH):
        h = h + 0.5 * swiglu(rmsnorm(h, ffn1_norm_g[layer]), ffn1_w_gate_up[layer], ffn1_w_down[layer])
        h = h + hybrid_mixer(rmsnorm(h, mix_norm_g[layer]), w_in[layer], b_forget[layer],
                             lam_q1[layer], lam_k1[layer], lam_q2[layer], lam_k2[layer],
                             diff_subln_g[layer], w_out[layer], lambda_init_fn(layer))
        h = h + 0.5 * swiglu(rmsnorm(h, ffn2_norm_g[layer]), ffn2_w_gate_up[layer], ffn2_w_down[layer])
    return rmsnorm(h, final_norm_g)[:, N_META:]
```

```cpp
#include <hip/hip_runtime.h>
#include <hip/hip_cooperative_groups.h>
namespace cg = cooperative_groups;
#include <cstdio>
#include <cstdint>

typedef unsigned short bf16_t;
typedef unsigned u32x4 __attribute__((ext_vector_type(4)));
typedef float f32x4 __attribute__((ext_vector_type(4)));
#define LAS __attribute__((address_space(3)))

constexpr int D = 1024, BATCH = 4, SEQ = 8192, NMETA = 16, NPAD = 240, REAL0 = 256, LP = 8448, TP = BATCH * LP;
constexpr int DFF = 2816, NGU = 2 * DFF, NIN = 3080, NINP = 3328;
constexpr int QKW = 2048;
constexpr float RMS_EPS = 1e-6f, SUBLN_EPS = 1e-5f, LAMBDA_INIT = 0.2f;
constexpr float QSCALE = 0.18033688011112042f;
constexpr float LOG2E = 1.4426950408889634f;
constexpr float NEGBIG = -1e30f;

constexpr size_t MiB = 1u << 20;
constexpr size_t WS_CTL = 0;
constexpr size_t WS_AT0 = 64 * 1024, WS_ACTT = 128 * 1024, WS_H1T = 320 * 1024, WS_SSQM = 384 * 1024;
constexpr size_t WS_SSQ = 1 * MiB;
constexpr size_t WS_LOGF = 4 * MiB;
constexpr size_t WS_CUM = 6 * MiB;
constexpr size_t WS_ROPE = 8 * MiB;
constexpr size_t WS_WGU1 = 9 * MiB, WS_WD1 = 20 * MiB, WS_WIN = 26 * MiB, WS_WOUT = 33 * MiB, WS_WGU2 = 35 * MiB, WS_WD2 = 46 * MiB;
constexpr size_t WS_H = 52 * MiB;
constexpr size_t WS_AO = 184 * MiB;
constexpr size_t WS_BIG = 250 * MiB;
constexpr size_t WS_VT = WS_BIG + 132 * MiB;
constexpr size_t WS_END = WS_BIG + 198 * MiB;

struct Params {
    const float* in[18];
    float* out; unsigned char* ws;
    int ph_lo, ph_hi;
};

__device__ __forceinline__ unsigned f2bf(float f) { unsigned u = __float_as_uint(f); return (u + 0x7fffu + ((u >> 16) & 1u)) >> 16; }
__device__ __forceinline__ unsigned pk2(float lo, float hi) { return f2bf(lo) | (f2bf(hi) << 16); }
__device__ __forceinline__ float bf2f(unsigned short b) { return __uint_as_float(((unsigned)b) << 16); }
__device__ __forceinline__ float bflo(unsigned w) { return __uint_as_float(w << 16); }
__device__ __forceinline__ float bfhi(unsigned w) { return __uint_as_float(w & 0xffff0000u); }
__device__ __forceinline__ float wave_sum(float v) {
#pragma unroll
    for (int o = 1; o < 64; o <<= 1) v += __shfl_xor(v, o);
    return v;
}
struct F8 { float v[8]; };

__device__ __forceinline__ void wconv_item(const float* W, const float* gvec, int K, int N, bf16_t* WT, int mode, LAS float* scr, int item, int nblk, int lane) {
    const int kb = item / nblk, nb = item % nblk, k0 = 64 * kb, n0 = 64 * nb;
    const int nl = 4 * (lane & 15);
    const int ng = n0 + nl;
    int sc; if (mode == 1) { const int pn = ng >> 8, w = ng & 255, bj = w >> 7, c = w & 127; sc = bj * DFF + 128 * pn + c; } else sc = ng;
    const bool valid = (mode != 2) || (ng < NIN);
#pragma unroll 8
    for (int i = 0; i < 16; ++i) { const int kk = 4 * i + (lane >> 4);
        f32x4 w = valid ? *(const f32x4*)(W + (size_t)(k0 + kk) * N + sc) : (f32x4){0.f, 0.f, 0.f, 0.f};
        if (gvec) { const int kx = k0 + kk; const float gs = (mode == 3) ? (kx < 512 ? gvec[kx & 127] * (1.0f - LAMBDA_INIT) : 1.0f) : gvec[kx]; w.x *= gs; w.y *= gs; w.z *= gs; w.w *= gs; }
        *(LAS f32x4*)(scr + kk * 68 + nl) = w; }
    asm volatile("s_waitcnt lgkmcnt(0)" ::: "memory");
    const int c = lane & 7;
#pragma unroll
    for (int j = 0; j < 8; ++j) { const int n = (lane >> 3) + 8 * j; const LAS float* sp = scr + (8 * c) * 68 + n;
        u32x4 o; o.x = pk2(sp[0 * 68], sp[1 * 68]); o.y = pk2(sp[2 * 68], sp[3 * 68]); o.z = pk2(sp[4 * 68], sp[5 * 68]); o.w = pk2(sp[6 * 68], sp[7 * 68]);
        *(u32x4*)(WT + (size_t)(n0 + n) * K + k0 + 8 * c) = o; }
    asm volatile("s_waitcnt lgkmcnt(0)" ::: "memory");
}

__device__ __forceinline__ const float* h0_row(const Params& P, int row) {
    const int b = row / LP, p = row % LP;
    if (p < NPAD) return nullptr;
    if (p < NPAD + NMETA) return P.in[1] + (size_t)(p - NPAD) * D;
    return P.in[0] + ((size_t)b * SEQ + (p - REAL0)) * D;
}

__device__ __forceinline__ void p0_prologue(const Params& P, LAS float* scr_wave, int gw, int NGW, int lane) {
    unsigned char* ws = P.ws;
    constexpr int I_GU = 16 * (NGU / 64), I_D = (DFF / 64) * (D / 64), I_IN = 16 * (NINP / 64), I_OUT = 16 * (D / 64);
    constexpr int NITEMS = 2 * I_GU + 2 * I_D + I_IN + I_OUT;
    for (int it = gw; it < NITEMS; it += NGW) {
        int r = it;
        if (r < I_GU) { wconv_item(P.in[3], P.in[2], D, NGU, (bf16_t*)(ws + WS_WGU1), 1, scr_wave, r, NGU / 64, lane); continue; } r -= I_GU;
        if (r < I_GU) { wconv_item(P.in[15], P.in[14], D, NGU, (bf16_t*)(ws + WS_WGU2), 1, scr_wave, r, NGU / 64, lane); continue; } r -= I_GU;
        if (r < I_D) { wconv_item(P.in[4], nullptr, DFF, D, (bf16_t*)(ws + WS_WD1), 0, scr_wave, r, D / 64, lane); continue; } r -= I_D;
        if (r < I_D) { wconv_item(P.in[16], nullptr, DFF, D, (bf16_t*)(ws + WS_WD2), 0, scr_wave, r, D / 64, lane); continue; } r -= I_D;
        if (r < I_IN) { wconv_item(P.in[6], P.in[5], D, NIN, (bf16_t*)(ws + WS_WIN), 2, scr_wave, r, NINP / 64, lane); continue; } r -= I_IN;
        wconv_item(P.in[13], P.in[12], D, D, (bf16_t*)(ws + WS_WOUT), 3, scr_wave, r, D / 64, lane);
    }
    float* ssq = (float*)(ws + WS_SSQ);
    bf16_t* HB = (bf16_t*)P.out;
    for (int row = gw; row < TP; row += 2 * NGW) {
        const int row2 = row + NGW; const bool has2 = row2 < TP;
        const float* src = h0_row(P, row); const float* src2 = has2 ? h0_row(P, row2) : nullptr;
        f32x4 v[4], u[4]; float s = 0.f, s2 = 0.f;
#pragma unroll
        for (int j = 0; j < 4; ++j) { v[j] = src ? *((const f32x4*)src + lane + 64 * j) : (f32x4){0.f, 0.f, 0.f, 0.f}; u[j] = src2 ? *((const f32x4*)src2 + lane + 64 * j) : (f32x4){0.f, 0.f, 0.f, 0.f}; }
#pragma unroll
        for (int j = 0; j < 4; ++j) { s += (v[j].x * v[j].x + v[j].y * v[j].y) + (v[j].z * v[j].z + v[j].w * v[j].w); s2 += (u[j].x * u[j].x + u[j].y * u[j].y) + (u[j].z * u[j].z + u[j].w * u[j].w); }
        s = wave_sum(s); s2 = wave_sum(s2);
        unsigned long long* o8 = (unsigned long long*)(HB + (size_t)row * D) + lane;
#pragma unroll
        for (int j = 0; j < 4; ++j) o8[64 * j] = (unsigned long long)pk2(v[j].x, v[j].y) | ((unsigned long long)pk2(v[j].z, v[j].w) << 32);
        if (lane < 4) ssq[(size_t)lane * TP + row] = (lane == 0) ? s : 0.f;
        if (has2) {
            unsigned long long* p8 = (unsigned long long*)(HB + (size_t)row2 * D) + lane;
#pragma unroll
            for (int j = 0; j < 4; ++j) p8[64 * j] = (unsigned long long)pk2(u[j].x, u[j].y) | ((unsigned long long)pk2(u[j].z, u[j].w) << 32);
            if (lane < 4) ssq[(size_t)lane * TP + row2] = (lane == 0) ? s2 : 0.f;
        }
    }
    float* rope = (float*)(ws + WS_ROPE);
    for (int e = gw * 64 + lane; e < (NMETA + SEQ) * 8; e += NGW * 64) {
        const int pos = e >> 3, i = e & 7;
        const double invf = (i == 0) ? 1.0 : (i == 1) ? 0.19392274474868576 : (i == 2) ? 0.03760603093086393 : (i == 3) ? 0.007292664737217109 :
                            (i == 4) ? 0.001414213562373095 : (i == 5) ? 0.0002742481756762073 : (i == 6) ? 5.318295896944988e-05 : 1.031338537721246e-05;
        double rev = (double)pos * invf * 0.15915494309189535; rev -= floor(rev);
        const float rf = (float)rev;
        rope[2 * e] = __builtin_amdgcn_cosf(rf); rope[2 * e + 1] = __builtin_amdgcn_sinf(rf);
    }
    if (gw >= 8 && gw < 8 + NMETA) {
        const int r = gw - 8; const float* src = P.in[1] + (size_t)r * D; const float* g1 = P.in[2]; float* AT0 = (float*)(ws + WS_AT0);
        float v[16]; float sq = 0.f;
#pragma unroll
        for (int j = 0; j < 16; ++j) { v[j] = src[lane + 64 * j]; sq += v[j] * v[j]; }
        const float rs = rsqrtf(wave_sum(sq) * (1.0f / D) + RMS_EPS);
#pragma unroll
        for (int j = 0; j < 16; ++j) { const int k = lane + 64 * j; AT0[k * 16 + r] = v[j] * rs * g1[k]; }
        if (lane == 0) ((float*)(ws + WS_SSQM))[r] = 0.f;
    }
    if (gw == 0) {
        const float a = wave_sum(P.in[8][lane] * P.in[9][lane]), b = wave_sum(P.in[10][lane] * P.in[11][lane]);
        if (lane == 0) { ((float*)(ws + WS_CTL))[0] = expf(a) - expf(b) + LAMBDA_INIT; ((unsigned*)(ws + WS_CTL))[16] = 0u; }
        if (lane < 8) ((unsigned*)(ws + WS_CTL))[64 + 64 * lane] = 0u;
    }
}

__device__ __forceinline__ void zero_pad_kv(unsigned char* ws, int gw, int NGW, int lane) {
    {
        float* logf = (float*)(ws + WS_LOGF); bf16_t* QKz = (bf16_t*)(ws + WS_BIG); bf16_t* VTz = (bf16_t*)(ws + WS_VT);
        for (int e = gw * 64 + lane; e < BATCH * NPAD * 8; e += NGW * 64) { const int b = e / (NPAD * 8), o = e % (NPAD * 8); logf[(size_t)b * LP * 8 + o] = 0.f; }
        for (int e = gw * 64 + lane; e < BATCH * 48 * (QKW / 8); e += NGW * 64) { const int b = e / (48 * (QKW / 8)), o = e % (48 * (QKW / 8)); *(u32x4*)(QKz + ((size_t)b * LP + 192) * QKW + (size_t)o * 8) = (u32x4){0u, 0u, 0u, 0u}; }
        for (int e = gw * 64 + lane; e < BATCH * 1024 * 6; e += NGW * 64) { const int bv = e / 6, o = e % 6; *(u32x4*)(VTz + (size_t)bv * LP + 192 + o * 8) = (u32x4){0u, 0u, 0u, 0u}; }
    }
}

__device__ __forceinline__ float row_rstd(const float* ssq, int row) { return rsqrtf(ssq[row] * (1.0f / D) + RMS_EPS); }

struct EpiSwiglu {
    const float* ssq; bf16_t* ACT;
    __device__ __forceinline__ void operator()(int row, int col, const F8& v, const F8& w, float rstd) const {
        float a[8];
#pragma unroll
        for (int j = 0; j < 8; ++j) { const float g = v.v[j] * rstd, u = w.v[j] * rstd; a[j] = g * u * __builtin_amdgcn_rcpf(1.f + __builtin_amdgcn_exp2f(-LOG2E * g)); }
        u32x4 o; o.x = pk2(a[0], a[1]); o.y = pk2(a[2], a[3]); o.z = pk2(a[4], a[5]); o.w = pk2(a[6], a[7]);
        *(u32x4*)(ACT + (size_t)row * DFF + col) = o;
    }
};
struct EpiResid {
    const Params* P; int from_x; float scale; float* H; bf16_t* HB; const bf16_t* HBin;
    __device__ __forceinline__ F8 load(int row, int col) const {
        F8 r;
        if (from_x) { const float* src = h0_row(*P, row); f32x4 b0 = {0.f, 0.f, 0.f, 0.f}, b1 = b0; if (src) { b0 = *(const f32x4*)(src + col); b1 = *(const f32x4*)(src + col + 4); }
            r.v[0] = b0.x; r.v[1] = b0.y; r.v[2] = b0.z; r.v[3] = b0.w; r.v[4] = b1.x; r.v[5] = b1.y; r.v[6] = b1.z; r.v[7] = b1.w; }
        else { const u32x4 w = *(const u32x4*)(HBin + (size_t)row * D + col);
            r.v[0] = bflo(w.x); r.v[1] = bfhi(w.x); r.v[2] = bflo(w.y); r.v[3] = bfhi(w.y); r.v[4] = bflo(w.z); r.v[5] = bfhi(w.z); r.v[6] = bflo(w.w); r.v[7] = bfhi(w.w); }
        return r;
    }
    __device__ __forceinline__ float finish(int row, int col, const F8& v, const F8& bs) const {
        f32x4 h0 = {bs.v[0] + scale * v.v[0], bs.v[1] + scale * v.v[1], bs.v[2] + scale * v.v[2], bs.v[3] + scale * v.v[3]};
        f32x4 h1 = {bs.v[4] + scale * v.v[4], bs.v[5] + scale * v.v[5], bs.v[6] + scale * v.v[6], bs.v[7] + scale * v.v[7]};
        if (H) { *(f32x4*)(H + (size_t)row * D + col) = h0; *(f32x4*)(H + (size_t)row * D + col + 4) = h1; }
        if (HB) { u32x4 o; o.x = pk2(h0.x, h0.y); o.y = pk2(h0.z, h0.w); o.z = pk2(h1.x, h1.y); o.w = pk2(h1.z, h1.w); *(u32x4*)(HB + (size_t)row * D + col) = o; }
        return (h0.x * h0.x + h0.y * h0.y) + (h0.z * h0.z + h0.w * h0.w) + (h1.x * h1.x + h1.y * h1.y) + (h1.z * h1.z + h1.w * h1.w);
    }
    __device__ __forceinline__ float operator()(int row, int col, const F8& v) const { return finish(row, col, v, load(row, col)); }
};
struct EpiInproj {
    const float* rope; const float* bforget; bf16_t* QK; bf16_t* VT; float* logf;
    __device__ __forceinline__ void operator()(int row, int col, const F8& v, const F8& w) const {
        const int b = row / LP, p = row % LP;
        if (col < 1024 || (col >= 1536 && col < 2560)) {
            float a[8]; int dst;
#pragma unroll
            for (int j = 0; j < 8; ++j) a[j] = v.v[j];
            if (col < 1024) {
                const int d = col & 63;
                if (d < 16 && p >= NPAD) {
                    const float* cs = rope + (size_t)(p - NPAD) * 16;
#pragma unroll
                    for (int j = 0; j < 8; ++j) { const float c = cs[2 * j], s = cs[2 * j + 1]; a[j] = (d < 8) ? v.v[j] * c - w.v[j] * s : v.v[j] * c + w.v[j] * s; }
                }
                if (col < 512) {
#pragma unroll
                    for (int j = 0; j < 8; ++j) a[j] *= QSCALE;
                }
                dst = col;
            } else {
                if (col < 2048) {
#pragma unroll
                    for (int j = 0; j < 8; ++j) a[j] *= QSCALE;
                }
                dst = col - 512;
            }
            u32x4 o; o.x = pk2(a[0], a[1]); o.y = pk2(a[2], a[3]); o.z = pk2(a[4], a[5]); o.w = pk2(a[6], a[7]);
            *(u32x4*)(QK + (size_t)row * QKW + dst) = o;
        } else if (col < 3072) {
            const int vcol = (col < 1536) ? col - 1024 : col - 2560 + 512;
            bf16_t* dstp = VT + ((size_t)b * 1024 + vcol) * LP + p;
#pragma unroll
            for (int j = 0; j < 8; ++j) dstp[(size_t)j * LP] = (bf16_t)f2bf(v.v[j]);
        } else if (col == 3072) {
            f32x4 o0, o1; float r[8];
#pragma unroll
            for (int j = 0; j < 8; ++j) { const float x = v.v[j] + bforget[j]; r[j] = (p >= NPAD) ? (fminf(x, 0.f) - log1pf(__expf(-fabsf(x)))) : 0.f; }
            o0 = (f32x4){r[0], r[1], r[2], r[3]}; o1 = (f32x4){r[4], r[5], r[6], r[7]};
            *(f32x4*)(logf + (size_t)row * 8) = o0; *(f32x4*)(logf + (size_t)row * 8 + 4) = o1;
        }
    }
};

template <int MODE  >
__global__ void __launch_bounds__(256) naive_gemm(Params P, const bf16_t* A, const bf16_t* Bt, int K, int norm_in, int norm_out, int from_x, float scale, int writeHB) {
    const int row = blockIdx.x * 256 + threadIdx.x;
    const int c16 = blockIdx.y * 16;
    int n0;
    if (MODE == 0) { const int pn = c16 >> 7, c = c16 & 127; n0 = pn * 256 + c; } else n0 = c16;
    constexpr int NACC = (MODE == 0) ? 32 : 16;
    float acc[NACC];
#pragma unroll
    for (int i = 0; i < NACC; ++i) acc[i] = 0.f;
    const bf16_t* ap = A + (size_t)row * K;
    for (int k = 0; k < K; k += 8) {
        const u32x4 av = *(const u32x4*)(ap + k);
        float a[8] = {bflo(av.x), bfhi(av.x), bflo(av.y), bfhi(av.y), bflo(av.z), bfhi(av.z), bflo(av.w), bfhi(av.w)};
#pragma unroll
        for (int i = 0; i < NACC; ++i) {
            const int n = n0 + (i & 15) + ((i >> 4) << 7);
            const u32x4 bv = *(const u32x4*)(Bt + (size_t)n * K + k);
            acc[i] += a[0] * bflo(bv.x) + a[1] * bfhi(bv.x) + a[2] * bflo(bv.y) + a[3] * bfhi(bv.y) + a[4] * bflo(bv.z) + a[5] * bfhi(bv.z) + a[6] * bflo(bv.w) + a[7] * bfhi(bv.w);
        }
    }
    float* ssq = (float*)(P.ws + WS_SSQ);
    if (MODE == 0) {
        const float rstd = row_rstd(ssq + (size_t)norm_in * TP, row);
        EpiSwiglu E{nullptr, (bf16_t*)(P.ws + WS_BIG)};
        F8 g0, g1, u0, u1;
#pragma unroll
        for (int j = 0; j < 8; ++j) { g0.v[j] = acc[j]; g1.v[j] = acc[8 + j]; u0.v[j] = acc[16 + j]; u1.v[j] = acc[24 + j]; }
        E(row, c16, g0, u0, rstd); E(row, c16 + 8, g1, u1, rstd);
    } else if (MODE == 1) {
        EpiResid E{&P, from_x, scale, (float*)(P.ws + WS_H), writeHB ? (bf16_t*)P.out : nullptr};
        F8 v0, v1;
#pragma unroll
        for (int j = 0; j < 8; ++j) { v0.v[j] = acc[j]; v1.v[j] = acc[8 + j]; }
        const float s = E(row, c16, v0) + E(row, c16 + 8, v1);
        atomicAdd(ssq + (size_t)norm_out * TP + row, s);
    } else {
        const float rstd = row_rstd(ssq + (size_t)norm_in * TP, row);
        EpiInproj E{(const float*)(P.ws + WS_ROPE), P.in[7], (bf16_t*)(P.ws + WS_BIG), (bf16_t*)(P.ws + WS_VT), (float*)(P.ws + WS_LOGF)};
        F8 v0, v1;
#pragma unroll
        for (int j = 0; j < 8; ++j) { v0.v[j] = acc[j] * rstd; v1.v[j] = acc[8 + j] * rstd; }
        E(row, c16, v0, v1); E(row, c16 + 8, v1, v0);
    }
}

constexpr size_t WS_KNMAX = 448 * 1024;
__device__ __forceinline__ void key_norm_max(const bf16_t* QK, float* knmax, int bh, LAS float* sh, int tid) {
    const int b = bh >> 3, h = bh & 7; float mx = 0.f;
    for (int p = NPAD + tid; p < LP; p += 512) { const bf16_t* kr = QK + ((size_t)b * LP + p) * QKW + 1536 + h * 64; float q = 0.f;
#pragma unroll
        for (int i = 0; i < 8; ++i) { const u32x4 w = *(const u32x4*)(kr + 8 * i); const float a0 = bflo(w.x), a1 = bfhi(w.x), a2 = bflo(w.y), a3 = bfhi(w.y), a4 = bflo(w.z), a5 = bfhi(w.z), a6 = bflo(w.w), a7 = bfhi(w.w);
            q += (a0 * a0 + a1 * a1) + (a2 * a2 + a3 * a3) + (a4 * a4 + a5 * a5) + (a6 * a6 + a7 * a7); }
        mx = fmaxf(mx, q); }
#pragma unroll
    for (int o = 1; o < 64; o <<= 1) mx = fmaxf(mx, __shfl_xor(mx, o));
    if ((tid & 63) == 0) sh[tid >> 6] = mx;
    __syncthreads();
    if (tid == 0) { float m = sh[0]; for (int i = 1; i < 8; ++i) m = fmaxf(m, sh[i]); knmax[bh] = sqrtf(m); }
    __syncthreads();
}
__device__ __forceinline__ void cum_scan_seq(const float* logf, float* cum, int bh, LAS float* sh  , int tid) {
    const int b = bh >> 3, h = bh & 7;
    constexpr int PER = 17;
    const int p0 = tid * PER;
    float v[PER]; float s = 0.f;
#pragma unroll
    for (int i = 0; i < PER; ++i) { const int p = p0 + i; v[i] = (p < LP) ? logf[((size_t)b * LP + p) * 8 + h] : 0.f; s += v[i]; v[i] = s; }
    sh[tid] = s;
    __syncthreads();
    for (int off = 1; off < 512; off <<= 1) {
        const float t = (tid >= off) ? sh[tid - off] : 0.f;
        __syncthreads();
        sh[tid] += t;
        __syncthreads();
    }
    const float base = sh[tid] - s;
#pragma unroll
    for (int i = 0; i < PER; ++i) { const int p = p0 + i; if (p < LP) cum[((size_t)b * 8 + h) * LP + p] = (base + v[i]) * LOG2E; }
    __syncthreads();
}

__device__ __forceinline__ void final_norm_rows(const Params& P, int gw, int NGW, int lane) {
    const float* H = (const float*)(P.ws + WS_H); const float* ssq = (const float*)(P.ws + WS_SSQ) + (size_t)3 * TP; const float* g = P.in[17];
    f32x4 gv[4];
#pragma unroll
    for (int j = 0; j < 4; ++j) gv[j] = *((const f32x4*)g + lane + 64 * j);
    for (int t = gw; t < BATCH * SEQ; t += 2 * NGW) {
        const int t2 = t + NGW; const bool has2 = t2 < BATCH * SEQ;
        const int row = (t / SEQ) * LP + REAL0 + (t % SEQ), row2 = has2 ? (t2 / SEQ) * LP + REAL0 + (t2 % SEQ) : row;
        const float rstd = rsqrtf(ssq[row] * (1.0f / D) + RMS_EPS), rstd2 = rsqrtf(ssq[row2] * (1.0f / D) + RMS_EPS);
        const f32x4* hr = (const f32x4*)(H + (size_t)row * D) + lane; const f32x4* hr2 = (const f32x4*)(H + (size_t)row2 * D) + lane;
        f32x4 hv[4], hw[4];
#pragma unroll
        for (int j = 0; j < 4; ++j) { hv[j] = hr[64 * j]; hw[j] = hr2[64 * j]; }
        f32x4* o = (f32x4*)(P.out + (size_t)t * D) + lane;
#pragma unroll
        for (int j = 0; j < 4; ++j) o[64 * j] = (f32x4){hv[j].x * rstd * gv[j].x, hv[j].y * rstd * gv[j].y, hv[j].z * rstd * gv[j].z, hv[j].w * rstd * gv[j].w};
        if (has2) { f32x4* o2 = (f32x4*)(P.out + (size_t)t2 * D) + lane;
#pragma unroll
            for (int j = 0; j < 4; ++j) o2[64 * j] = (f32x4){hw[j].x * rstd2 * gv[j].x, hw[j].y * rstd2 * gv[j].y, hw[j].z * rstd2 * gv[j].z, hw[j].w * rstd2 * gv[j].w}; }
    }
}

template <bool DIFF>
__device__ __forceinline__ void naive_attn_body(const Params& P, int tid, int bx, int h, int b) {
    constexpr int NS = DIFF ? 4 : 2, RPB = 256 / NS;
    const int ql = tid / NS, sub = tid % NS;
    const int pq = bx * RPB + ql;
    const size_t row = (size_t)b * LP + pq;
    const bf16_t* QK = (const bf16_t*)(P.ws + WS_BIG); const bf16_t* VT = (const bf16_t*)(P.ws + WS_VT); const float* cum = (const float*)(P.ws + WS_CUM) + ((size_t)b * 8 + h) * LP;
    bf16_t* AO = (bf16_t*)(P.ws + WS_AO);
    const float lam = ((const float*)(P.ws + WS_CTL))[0];
    float res[32];
#pragma unroll
    for (int j = 0; j < 32; ++j) res[j] = 0.f;
    const bool live = pq >= NPAD;
    for (int map = 0; map < (DIFF ? 2 : 1); ++map) {
        const int qcol = DIFF ? h * 128 + map * 64 : 1024 + h * 64, kcol = DIFF ? 512 + h * 128 + map * 64 : 1536 + h * 64;
        const int vcol0 = DIFF ? h * 128 + sub * 32 : 512 + h * 64 + sub * 32;
        float q[64];
#pragma unroll
        for (int i = 0; i < 8; ++i) { const u32x4 w = *(const u32x4*)(QK + row * QKW + qcol + 8 * i);
            q[8 * i] = bflo(w.x); q[8 * i + 1] = bfhi(w.x); q[8 * i + 2] = bflo(w.y); q[8 * i + 3] = bfhi(w.y); q[8 * i + 4] = bflo(w.z); q[8 * i + 5] = bfhi(w.z); q[8 * i + 6] = bflo(w.w); q[8 * i + 7] = bfhi(w.w); }
        const float cq = DIFF ? 0.f : cum[pq];
        float m = NEGBIG, l = 0.f, o[32];
#pragma unroll
        for (int j = 0; j < 32; ++j) o[j] = 0.f;
        if (live) for (int s0 = NPAD; s0 <= pq; s0 += 8) {
            float sc[8]; float gm = NEGBIG;
#pragma unroll
            for (int e = 0; e < 8; ++e) {
                const int s = s0 + e; const bf16_t* kr = QK + ((size_t)b * LP + s) * QKW + kcol; float d = 0.f;
#pragma unroll
                for (int i = 0; i < 8; ++i) { const u32x4 w = *(const u32x4*)(kr + 8 * i);
                    d += q[8 * i] * bflo(w.x) + q[8 * i + 1] * bfhi(w.x) + q[8 * i + 2] * bflo(w.y) + q[8 * i + 3] * bfhi(w.y) + q[8 * i + 4] * bflo(w.z) + q[8 * i + 5] * bfhi(w.z) + q[8 * i + 6] * bflo(w.w) + q[8 * i + 7] * bfhi(w.w); }
                if (!DIFF) d += cq - cum[s];
                sc[e] = (s <= pq) ? d : NEGBIG; gm = fmaxf(gm, sc[e]);
            }
            const float mn = fmaxf(m, gm), f = exp2f(m - mn);
            float pw[8]; float ps = 0.f;
#pragma unroll
            for (int e = 0; e < 8; ++e) { pw[e] = (s0 + e <= pq) ? exp2f(sc[e] - mn) : 0.f; ps += pw[e]; }
            l = l * f + ps; m = mn;
#pragma unroll
            for (int j = 0; j < 32; ++j) { const u32x4 w = *(const u32x4*)(VT + ((size_t)b * 1024 + vcol0 + j) * LP + s0);
                o[j] = o[j] * f + (pw[0] * bflo(w.x) + pw[1] * bfhi(w.x) + pw[2] * bflo(w.y) + pw[3] * bfhi(w.y) + pw[4] * bflo(w.z) + pw[5] * bfhi(w.z) + pw[6] * bflo(w.w) + pw[7] * bfhi(w.w)); }
        }
        const float il = (l > 0.f) ? 1.f / l : 0.f;
        if (DIFF) {
#pragma unroll
            for (int j = 0; j < 32; ++j) res[j] = (map == 0) ? o[j] * il : res[j] - lam * o[j] * il;
        } else {
#pragma unroll
            for (int j = 0; j < 32; ++j) res[j] = o[j] * il;
        }
    }
    if (DIFF) {
        float ss = 0.f;
#pragma unroll
        for (int j = 0; j < 32; ++j) ss += res[j] * res[j];
        ss += __shfl_xor(ss, 1); ss += __shfl_xor(ss, 2);
        const float r = rsqrtf(ss * (1.0f / 128.f) + SUBLN_EPS) * (1.0f - LAMBDA_INIT);
        const float* g = P.in[12] + sub * 32;
#pragma unroll
        for (int j = 0; j < 32; ++j) res[j] = res[j] * r * g[j];
    }
    bf16_t* dst = AO + row * D + (DIFF ? h * 128 + sub * 32 : 512 + h * 64 + sub * 32);
#pragma unroll
    for (int j = 0; j < 4; ++j) { u32x4 o4; o4.x = pk2(res[8 * j], res[8 * j + 1]); o4.y = pk2(res[8 * j + 2], res[8 * j + 3]); o4.z = pk2(res[8 * j + 4], res[8 * j + 5]); o4.w = pk2(res[8 * j + 6], res[8 * j + 7]);
        *(u32x4*)(dst + 8 * j) = live ? o4 : (u32x4){0u, 0u, 0u, 0u}; }
}


namespace pg8 {
#define PG8_LAS __attribute__((address_space(3)))
typedef unsigned short bf16_t;
typedef short bf16x8 __attribute__((ext_vector_type(8)));
typedef float f32x4 __attribute__((ext_vector_type(4)));
typedef unsigned u32x4 __attribute__((ext_vector_type(4)));
constexpr int BM = 256, BK = 64, HALF = 128, HTB = HALF * BK * 2  , STAGE_BYTES = 8 * HTB, NXCD = 8, WGM = 8;

__host__ __device__ __forceinline__ int lds_byte(int r, int c) { const int st = (r >> 4) * 2 + (c >> 5), rr = r & 15, cc = c & 31, ob = rr * 64 + cc * 2; return st * 1024 + (ob ^ (((ob >> 9) & 1) << 5)); }
__host__ __device__ __forceinline__ void stage_rc(int b, int& R, int& C) { const int st = b / 1024, sb = b % 1024, swz = sb ^ (((sb >> 9) & 1) << 5); R = (st >> 1) * 16 + swz / 64; C = (st & 1) * 32 + (swz % 64) / 2; }
__host__ __device__ __forceinline__ int perm32(int rho) { const int n = rho >> 4, i = rho & 15; return 8 * (i >> 2) + 4 * n + (i & 3); }

struct Unit { int pm, pn; };
struct Gemm { const bf16_t* A; const bf16_t* Bt; int M, N, K; };

struct StaticOrder {
    int nM, nN, nwg, G, c;
    __host__ __device__ void init(int M, int N, int G_, int c_) { nM = M / BM; nN = N / BM; nwg = nM * nN; G = G_; c = c_; }
    __host__ __device__ bool next(int i, Unit& u) const {
        const long L = (long)i * G + c; if (L >= nwg) return false;
        int wgid = (int)L; { const int q = nwg / NXCD, r = nwg % NXCD, xcd = wgid % NXCD, off = wgid / NXCD; wgid = (xcd < r ? xcd * (q + 1) : r * (q + 1) + (xcd - r) * q) + off; }
        const int nig = WGM * nN, gid = wgid / nig, fm = gid * WGM, gsz = (nM - fm) < WGM ? (nM - fm) : WGM;
        u.pm = fm + ((wgid % nig) % gsz); u.pn = (wgid % nig) / gsz; return true;
    }
    __device__ __forceinline__ void a_ready(const Unit&) const {}
    __device__ __forceinline__ void done(const Unit&) const {}
};

template <class Epi, class Sched, bool ALIGN_EPI = false, bool SP2 = false>
__device__ __forceinline__ void gemm_phase(PG8_LAS unsigned char* lds, const Gemm g, const Sched& S, const Epi& E) {
    const int tid = threadIdx.x, wid = __builtin_amdgcn_readfirstlane(tid >> 6), lane = tid & 63, wr = wid >> 2, wc = wid & 3, fr = lane & 15, fq = lane >> 4;
    const int K = g.K, nt = K / BK;
    unsigned voffA[2], voffB[2];
#pragma unroll
    for (int i = 0; i < 2; ++i) { int R, C; stage_rc(tid * 16 + i * 8192, R, C); const int Rb = Epi::PERM ? ((R & ~31) + perm32(R & 31)) : R;
        voffA[i] = (unsigned)(R * K + C) * 2u; voffB[i] = (unsigned)(Rb * K + C) * 2u; }
    const size_t kstep = (size_t)(BK * 2);
    const size_t hstep = (size_t)HALF * K * 2;
    const size_t tstep = 2 * hstep;
    const unsigned ldsw = (unsigned)wid * 1024u;
    const int aoff = lds_byte(wr * 64 + fr, fq * 8), boff = lds_byte(wc * 32 + fr, fq * 8);
#define PG8_SA(b, h) (((b) * 2 + (h)) * HTB)
#define PG8_SB(b, h) ((4 + (b) * 2 + (h)) * HTB)
#define PG8_STAGE(bufoff, gbase, voff) do { _Pragma("unroll") for (int _i = 0; _i < 2; ++_i) \
        __builtin_amdgcn_global_load_lds((const unsigned*)((const char*)(gbase) + (voff)[_i]), (PG8_LAS unsigned*)(lds + (bufoff) + ldsw + _i * 8192), 16, 0, 0); } while (0)
#define PG8_LDA(dst, b, h) do { _Pragma("unroll") for (int m = 0; m < 4; ++m) _Pragma("unroll") for (int k = 0; k < 2; ++k) dst[m][k] = *(const PG8_LAS bf16x8*)(lds + PG8_SA(b, h) + aoff + m * 2048 + k * 1024); } while (0)
#define PG8_LDB(dst, b, h) do { _Pragma("unroll") for (int n = 0; n < 2; ++n) _Pragma("unroll") for (int k = 0; k < 2; ++k) dst[n][k] = *(const PG8_LAS bf16x8*)(lds + PG8_SB(b, h) + boff + n * 2048 + k * 1024); } while (0)
#define PG8_MMA(ai, bj, At, Bt) do { __builtin_amdgcn_s_setprio(1); _Pragma("unroll") for (int m = 0; m < 4; ++m) _Pragma("unroll") for (int n = 0; n < 2; ++n) _Pragma("unroll") for (int k = 0; k < 2; ++k) \
        acc[ai][bj][m][n] = __builtin_amdgcn_mfma_f32_16x16x32_bf16(Bt[n][k], At[m][k], acc[ai][bj][m][n], 0, 0, 0); __builtin_amdgcn_s_setprio(0); } while (0)
#define PG8_WAIT_V(n) asm volatile("s_waitcnt vmcnt(" #n ")" ::: "memory")
#define PG8_WAIT_L(n) asm volatile("s_waitcnt lgkmcnt(" #n ")" ::: "memory")
#define PG8_BAR __builtin_amdgcn_s_barrier()
#define PG8_SCHED __builtin_amdgcn_sched_barrier(0)
    Unit cur, nxt; int ui = 0;
    if (!S.next(0, cur)) return;
    f32x4 acc[2][2][4][2];
#pragma unroll
    for (int a = 0; a < 2; ++a)
#pragma unroll
        for (int b = 0; b < 2; ++b)
#pragma unroll
            for (int m = 0; m < 4; ++m)
#pragma unroll
                for (int n = 0; n < 2; ++n) acc[a][b][m][n] = (f32x4){0.f, 0.f, 0.f, 0.f};
    bf16x8 At[4][2], B0[2][2], B1[2][2];
    const char* cA = (const char*)g.A + (size_t)cur.pm * tstep; const char* cB = (const char*)g.Bt + (size_t)cur.pn * tstep;
    S.a_ready(cur);
    if constexpr (SP2) {
        PG8_STAGE(PG8_SB(0, 0), cB, voffB); PG8_STAGE(PG8_SB(0, 1), cB + hstep, voffB); PG8_STAGE(PG8_SA(0, 0), cA, voffA); PG8_STAGE(PG8_SA(0, 1), cA + hstep, voffA);
        if (wr == 1) PG8_BAR;
        PG8_WAIT_V(2); PG8_BAR;
        PG8_STAGE(PG8_SB(1, 0), cB + kstep, voffB); PG8_STAGE(PG8_SA(1, 0), cA + kstep, voffA); PG8_STAGE(PG8_SB(1, 1), cB + hstep + kstep, voffB);
        PG8_WAIT_V(6); PG8_BAR;
    } else {
        PG8_STAGE(PG8_SB(0, 0), cB, voffB); PG8_STAGE(PG8_SA(0, 0), cA, voffA); PG8_STAGE(PG8_SB(0, 1), cB + hstep, voffB); PG8_STAGE(PG8_SA(0, 1), cA + hstep, voffA);
        if (wr == 1) PG8_BAR;
        PG8_WAIT_V(4); PG8_BAR;
        PG8_STAGE(PG8_SB(1, 0), cB + kstep, voffB); PG8_STAGE(PG8_SA(1, 0), cA + kstep, voffA); PG8_STAGE(PG8_SB(1, 1), cB + hstep + kstep, voffB);
        PG8_WAIT_V(6); PG8_BAR;
    }
    for (;;) {
        const bool has_next = S.next(ui + 1, nxt);
        const char* nA = has_next ? (const char*)g.A + (size_t)nxt.pm * tstep : cA; const char* nB = has_next ? (const char*)g.Bt + (size_t)nxt.pn * tstep : cB;
        for (int t = 0; t < nt; t += 2) {
            const bool last = (t == nt - 2);
            const char* a1 = cA + (size_t)(t + 1) * kstep;
            const char* a2 = last ? nA : cA + (size_t)(t + 2) * kstep; const char* b2 = last ? nB : cB + (size_t)(t + 2) * kstep;
            const char* a3 = a2 + kstep; const char* b3 = b2 + kstep;
            if (last && has_next) S.a_ready(nxt);
            if constexpr (SP2) {
            PG8_LDB(B0, 0, 0); PG8_LDB(B1, 0, 1); PG8_SCHED; PG8_LDA(At, 0, 0); PG8_STAGE(PG8_SA(1, 1), a1 + hstep, voffA);
            PG8_WAIT_V(8); PG8_WAIT_L(0); PG8_BAR; PG8_MMA(0, 0, At, B0); PG8_MMA(0, 1, At, B1); PG8_BAR; PG8_SCHED;
            PG8_LDA(At, 0, 1); PG8_STAGE(PG8_SB(0, 0), b2, voffB); PG8_STAGE(PG8_SB(0, 1), b2 + hstep, voffB); PG8_STAGE(PG8_SA(0, 0), a2, voffA);
            PG8_WAIT_V(8); PG8_WAIT_L(0); PG8_BAR; PG8_MMA(1, 0, At, B0); PG8_MMA(1, 1, At, B1); PG8_BAR; PG8_SCHED;
            PG8_LDB(B0, 1, 0); PG8_LDB(B1, 1, 1); PG8_SCHED; PG8_LDA(At, 1, 0); PG8_STAGE(PG8_SA(0, 1), a2 + hstep, voffA);
            PG8_WAIT_V(8); PG8_WAIT_L(0); PG8_BAR; PG8_MMA(0, 0, At, B0); PG8_MMA(0, 1, At, B1); PG8_BAR; PG8_SCHED;
            PG8_LDA(At, 1, 1); PG8_STAGE(PG8_SB(1, 0), b3, voffB); PG8_STAGE(PG8_SB(1, 1), b3 + hstep, voffB); PG8_STAGE(PG8_SA(1, 0), a3, voffA);
            PG8_WAIT_V(8); PG8_WAIT_L(0); PG8_BAR; PG8_MMA(1, 0, At, B0); PG8_MMA(1, 1, At, B1); PG8_BAR; PG8_SCHED;
            } else {
            PG8_LDB(B0, 0, 0); PG8_SCHED; PG8_LDA(At, 0, 0); PG8_STAGE(PG8_SA(1, 1), a1 + hstep, voffA);
            PG8_WAIT_L(8); PG8_BAR; PG8_WAIT_L(0); PG8_MMA(0, 0, At, B0); PG8_BAR; PG8_SCHED;
            PG8_LDB(B1, 0, 1); PG8_STAGE(PG8_SB(0, 0), b2, voffB);
            PG8_BAR; PG8_WAIT_L(0); PG8_MMA(0, 1, At, B1); PG8_BAR;
            PG8_LDA(At, 0, 1); PG8_STAGE(PG8_SA(0, 0), a2, voffA);
            PG8_BAR; PG8_WAIT_L(0); PG8_MMA(1, 0, At, B0); PG8_BAR; PG8_SCHED;
            PG8_STAGE(PG8_SB(0, 1), b2 + hstep, voffB);
            PG8_WAIT_V(6); PG8_BAR; PG8_MMA(1, 1, At, B1); PG8_BAR;
            PG8_LDB(B0, 1, 0); PG8_SCHED; PG8_LDA(At, 1, 0); PG8_STAGE(PG8_SA(0, 1), a2 + hstep, voffA);
            PG8_WAIT_L(8); PG8_BAR; PG8_WAIT_L(0); PG8_MMA(0, 0, At, B0); PG8_BAR; PG8_SCHED;
            PG8_LDB(B1, 1, 1); PG8_STAGE(PG8_SB(1, 0), b3, voffB);
            PG8_BAR; PG8_WAIT_L(0); PG8_MMA(0, 1, At, B1); PG8_BAR;
            PG8_LDA(At, 1, 1); PG8_STAGE(PG8_SA(1, 0), a3, voffA);
            PG8_BAR; PG8_WAIT_L(0); PG8_MMA(1, 0, At, B0); PG8_BAR; PG8_SCHED;
            PG8_STAGE(PG8_SB(1, 1), b3 + hstep, voffB);
            PG8_WAIT_V(6); PG8_BAR; PG8_MMA(1, 1, At, B1); PG8_BAR;
            }
        }
        if constexpr (ALIGN_EPI) { if (wr == 0) PG8_BAR; }
        if constexpr (!Epi::AFTER_DRAIN) { E(acc, cur, wr, wc, fr, fq); S.done(cur); }
        if (!has_next) break;
#pragma unroll
        for (int a = 0; a < 2; ++a)
#pragma unroll
            for (int b = 0; b < 2; ++b)
#pragma unroll
                for (int m = 0; m < 4; ++m)
#pragma unroll
                    for (int n = 0; n < 2; ++n) acc[a][b][m][n] = (f32x4){0.f, 0.f, 0.f, 0.f};
        cur = nxt; cA = nA; cB = nB; ++ui;
        if constexpr (ALIGN_EPI) { if (wr == 1) PG8_BAR; }
    }
    PG8_WAIT_V(0);
    if constexpr (!ALIGN_EPI) { if (wr == 0) PG8_BAR; }
    PG8_BAR;
    if constexpr (Epi::AFTER_DRAIN) { E.fused(acc, cur, wr, wc, fr, fq, lds, wid, lane); S.done(cur); }
#undef PG8_SA
#undef PG8_SB
#undef PG8_STAGE
#undef PG8_LDA
#undef PG8_LDB
#undef PG8_MMA
#undef PG8_WAIT_V
#undef PG8_WAIT_L
#undef PG8_BAR
#undef PG8_SCHED
}
}


template <int NW>
__device__ __forceinline__ void side16_dot(const float* AT, const float* W, int ldw, int K, const int (&col)[NW], const float* gk, LAS float* red, float (&res)[NW]) {
    const int tid = threadIdx.x, lane = tid & 63, w = tid >> 6, c = lane & 15, kq = lane >> 4;
    float acc[NW][16];
#pragma unroll
    for (int wi = 0; wi < NW; ++wi)
#pragma unroll
        for (int r = 0; r < 16; ++r) acc[wi][r] = 0.f;
    const int ks = K >> 3, kbeg = w * ks;
#pragma unroll 8
    for (int k = kbeg + kq; k < kbeg + ks; k += 4) {
        const f32x4 a0 = *(const f32x4*)(AT + (size_t)k * 16), a1 = *(const f32x4*)(AT + (size_t)k * 16 + 4), a2 = *(const f32x4*)(AT + (size_t)k * 16 + 8), a3 = *(const f32x4*)(AT + (size_t)k * 16 + 12);
        const float gs = gk ? gk[k] : 1.f;
#pragma unroll
        for (int wi = 0; wi < NW; ++wi) { const float wv = (col[wi] >= 0) ? W[(size_t)k * ldw + col[wi]] * gs : 0.f;
            acc[wi][0] += a0.x * wv; acc[wi][1] += a0.y * wv; acc[wi][2] += a0.z * wv; acc[wi][3] += a0.w * wv; acc[wi][4] += a1.x * wv; acc[wi][5] += a1.y * wv; acc[wi][6] += a1.z * wv; acc[wi][7] += a1.w * wv;
            acc[wi][8] += a2.x * wv; acc[wi][9] += a2.y * wv; acc[wi][10] += a2.z * wv; acc[wi][11] += a2.w * wv; acc[wi][12] += a3.x * wv; acc[wi][13] += a3.y * wv; acc[wi][14] += a3.z * wv; acc[wi][15] += a3.w * wv; }
    }
#pragma unroll
    for (int wi = 0; wi < NW; ++wi)
#pragma unroll
        for (int r = 0; r < 16; ++r) { float v = acc[wi][r]; v += __shfl_xor(v, 16); v += __shfl_xor(v, 32); if (kq == 0) red[((wi * 8 + w) * 16 + r) * 16 + c] = v; }
    __syncthreads();
    if (tid < 256) {
#pragma unroll
        for (int wi = 0; wi < NW; ++wi) { float v = 0.f;
#pragma unroll
            for (int ww = 0; ww < 8; ++ww) v += red[(wi * 8 + ww) * 256 + tid];
            res[wi] = v; }
    }
    __syncthreads();
}
__device__ __forceinline__ void side_stage1(const Params& P, LAS float* red, int t) {
    const int tid = threadIdx.x, c = tid & 15;
    const int col[2] = {16 * t + c, DFF + 16 * t + c}; float res[2];
    side16_dot<2>((const float*)(P.ws + WS_AT0), P.in[3], NGU, D, col, nullptr, red, res);
    if (tid < 256) { const int r = tid >> 4, cc = tid & 15; const float g = res[0], u = res[1]; ((float*)(P.ws + WS_ACTT))[(16 * t + cc) * 16 + r] = g * u / (1.f + __expf(-g)); }
}
__device__ __forceinline__ void side_stage2(const Params& P, LAS float* red, int t) {
    const int tid = threadIdx.x, c = tid & 15;
    const int col[1] = {16 * t + c}; float res[1];
    side16_dot<1>((const float*)(P.ws + WS_ACTT), P.in[4], D, DFF, col, nullptr, red, res);
    if (tid < 256) { const int r = tid >> 4, cc = tid & 15, n = 16 * t + cc; const float h1 = P.in[1][(size_t)r * D + n] + 0.5f * res[0];
        ((float*)(P.ws + WS_H1T))[n * 16 + r] = h1;
        float q = h1 * h1; q += __shfl_xor(q, 1); q += __shfl_xor(q, 2); q += __shfl_xor(q, 4); q += __shfl_xor(q, 8);
        if (cc == 0) unsafeAtomicAdd((float*)(P.ws + WS_SSQM) + r, q); }
}
__device__ __forceinline__ void side_stage3(const Params& P, LAS float* red, int t) {
    const int tid = threadIdx.x, c = tid & 15;
    const int kind = (t >= 128) ? 4 : (t >> 5);
    const int n0 = (kind == 0) ? 512 + 16 * t : (kind == 1) ? 1024 + 16 * (t - 32) : (kind == 2) ? 2048 + 16 * (t - 64) : (kind == 3) ? 2560 + 16 * (t - 96) : 3072;
    const int col[1] = {(n0 + c < NIN) ? n0 + c : -1}; float res[1];
    side16_dot<1>((const float*)(P.ws + WS_H1T), P.in[6], NIN, D, col, P.in[5], red, res);
    float v = 0.f; int r = 0, cc = 0;
    if (tid < 256) { r = tid >> 4; cc = tid & 15; v = res[0] * rsqrtf(((const float*)(P.ws + WS_SSQM))[r] * (1.0f / D) + RMS_EPS); red[tid] = v; }
    __syncthreads();
    if (tid < 256) {
        const int n = n0 + cc; const int p = NPAD + r;
        bf16_t* QK = (bf16_t*)(P.ws + WS_BIG); bf16_t* VT = (bf16_t*)(P.ws + WS_VT); float* logf = (float*)(P.ws + WS_LOGF);
        if (kind == 0 || kind == 2) {
            float o = v;
            if (kind == 0 && (n & 63) < 16) { const float pr = red[tid ^ 8]; const float* cs = (const float*)(P.ws + WS_ROPE) + (size_t)r * 16 + 2 * (n & 7);
                o = ((n & 63) < 8) ? v * cs[0] - pr * cs[1] : v * cs[0] + pr * cs[1]; }
            const int dst = (kind == 0) ? n : n - 512;
            for (int b = 0; b < BATCH; ++b) QK[((size_t)b * LP + p) * QKW + dst] = (bf16_t)f2bf(o);
        } else if (kind == 1 || kind == 3) {
            const int vcol = (kind == 1) ? n - 1024 : n - 2560 + 512;
            for (int b = 0; b < BATCH; ++b) VT[((size_t)b * 1024 + vcol) * LP + p] = (bf16_t)f2bf(v);
        } else if (cc < 8) {
            const float x = v + P.in[7][cc]; const float lf = fminf(x, 0.f) - log1pf(__expf(-fabsf(x)));
            for (int b = 0; b < BATCH; ++b) logf[((size_t)b * LP + p) * 8 + cc] = lf;
        }
    }
    __syncthreads();
}


__device__ __forceinline__ void gates_rows(const Params& P, int widx, int nw, int lane) {
    typedef short bf16x8 __attribute__((ext_vector_type(8))); typedef float f32x16 __attribute__((ext_vector_type(16)));
    const bf16_t* HB = (const bf16_t*)P.out; const bf16_t* WG = (const bf16_t*)(P.ws + WS_WIN) + (size_t)3072 * D;
    const float* ssq1 = (const float*)(P.ws + WS_SSQ) + TP; float* logf = (float*)(P.ws + WS_LOGF); const float* bfg = P.in[7];
    const int ql = lane & 31, hi = lane >> 5;
    for (int t = widx; t < 1024; t += nw) {
        const int lt = t >> 3, row0 = (lt + (lt >> 5) + 1) * 256 + (t & 7) * 32;
        const bf16_t* ap = WG + (size_t)ql * D + 8 * hi; const bf16_t* bp = HB + (size_t)(row0 + ql) * D + 8 * hi;
        f32x16 acc;
#pragma unroll
        for (int r = 0; r < 16; ++r) acc[r] = 0.f;
#pragma unroll 16
        for (int ks = 0; ks < 64; ++ks) { const bf16x8 a = *(const bf16x8*)(ap + 16 * ks), b = *(const bf16x8*)(bp + 16 * ks); acc = __builtin_amdgcn_mfma_f32_32x32x16_bf16(a, b, acc, 0, 0, 0); }
        const int row = row0 + ql; const float rstd = row_rstd(ssq1, row);
        f32x4 o;
#pragma unroll
        for (int j = 0; j < 4; ++j) { const float x = acc[j] * rstd + bfg[4 * hi + j]; o[j] = fminf(x, 0.f) - log1pf(__expf(-fabsf(x))); }
        *(f32x4*)(logf + (size_t)row * 8 + 4 * hi) = o;
    }
}

struct LiveOrder {
    pg8::StaticOrder S;
    __device__ void init(int N, int G, int c) { S.init(128 * 256, N, G, c); }
    __device__ bool next(int i, pg8::Unit& u) const { if (!S.next(i, u)) return false; u.pm = u.pm + (u.pm >> 5) + 1; return true; }
    __device__ __forceinline__ void a_ready(const pg8::Unit&) const {}
    __device__ __forceinline__ void done(const pg8::Unit&) const {}
};
__device__ __forceinline__ F8 acc8(const f32x4 (&acc)[2][2][4][2], int ai, int bj, int m) {
    F8 r; const f32x4 a = acc[ai][bj][m][0], b = acc[ai][bj][m][1];
    r.v[0] = a[0]; r.v[1] = a[1]; r.v[2] = a[2]; r.v[3] = a[3]; r.v[4] = b[0]; r.v[5] = b[1]; r.v[6] = b[2]; r.v[7] = b[3]; return r;
}
struct PgSwiglu {
    static constexpr bool PERM = true, AFTER_DRAIN = false;
    const float* ssq_in; bf16_t* ACT;
    __device__ __forceinline__ void operator()(const f32x4 (&acc)[2][2][4][2], const pg8::Unit& u, int wr, int wc, int fr, int fq) const {
        const EpiSwiglu E{nullptr, ACT};
        const int col = u.pn * 128 + wc * 32 + 8 * fq;
        float rs[2][4];
#pragma unroll
        for (int ai = 0; ai < 2; ++ai)
#pragma unroll
            for (int m = 0; m < 4; ++m) rs[ai][m] = ssq_in[u.pm * 256 + ai * 128 + wr * 64 + m * 16 + fr];
#pragma unroll
        for (int ai = 0; ai < 2; ++ai)
#pragma unroll
            for (int m = 0; m < 4; ++m) rs[ai][m] = rsqrtf(rs[ai][m] * (1.0f / D) + RMS_EPS);
#pragma unroll
        for (int ai = 0; ai < 2; ++ai)
#pragma unroll
            for (int m = 0; m < 4; ++m) { const int row = u.pm * 256 + ai * 128 + wr * 64 + m * 16 + fr;
                E(row, col, acc8(acc, ai, 0, m), acc8(acc, ai, 1, m), rs[ai][m]); }
    }
};
struct PgResid {
    static constexpr bool PERM = true, AFTER_DRAIN = false;
    EpiResid E; float* ssq_out;
    __device__ __forceinline__ void operator()(const f32x4 (&acc)[2][2][4][2], const pg8::Unit& u, int wr, int wc, int fr, int fq) const {
#pragma unroll
        for (int ai = 0; ai < 2; ++ai) {
            F8 bs[4][2];
#pragma unroll
            for (int m = 0; m < 4; ++m)
#pragma unroll
                for (int bj = 0; bj < 2; ++bj) bs[m][bj] = E.load(u.pm * 256 + ai * 128 + wr * 64 + m * 16 + fr, u.pn * 256 + bj * 128 + wc * 32 + 8 * fq);
#pragma unroll
            for (int m = 0; m < 4; ++m) { const int row = u.pm * 256 + ai * 128 + wr * 64 + m * 16 + fr; float s = 0.f;
#pragma unroll
                for (int bj = 0; bj < 2; ++bj) s += E.finish(row, u.pn * 256 + bj * 128 + wc * 32 + 8 * fq, acc8(acc, ai, bj, m), bs[m][bj]);
                s += __shfl_xor(s, 16); s += __shfl_xor(s, 32);
                if (fq == 0) unsafeAtomicAdd(ssq_out + row, s); }
        }
    }
};
struct PgInproj {
    static constexpr bool PERM = true, AFTER_DRAIN = false;
    EpiInproj E; const float* ssq_in;
    __device__ __forceinline__ void operator()(const f32x4 (&acc)[2][2][4][2], const pg8::Unit& u, int wr, int wc, int fr, int fq) const {
        const bool rope_tile = u.pn < 4;
        float rs[2][4];
#pragma unroll
        for (int ai = 0; ai < 2; ++ai)
#pragma unroll
            for (int m = 0; m < 4; ++m) rs[ai][m] = ssq_in[u.pm * 256 + ai * 128 + wr * 64 + m * 16 + fr];
#pragma unroll
        for (int ai = 0; ai < 2; ++ai)
#pragma unroll
            for (int m = 0; m < 4; ++m) rs[ai][m] = rsqrtf(rs[ai][m] * (1.0f / D) + RMS_EPS);
#pragma unroll
        for (int ai = 0; ai < 2; ++ai)
#pragma unroll
            for (int m = 0; m < 4; ++m) { const int row = u.pm * 256 + ai * 128 + wr * 64 + m * 16 + fr; const float rstd = rs[ai][m];
#pragma unroll
                for (int bj = 0; bj < 2; ++bj) { F8 v = acc8(acc, ai, bj, m), w;
#pragma unroll
                    for (int j = 0; j < 8; ++j) v.v[j] *= rstd;
                    if (rope_tile) {
#pragma unroll
                        for (int j = 0; j < 8; ++j) w.v[j] = __shfl_xor(v.v[j], 16);
                    } else w = v;
                    E(row, u.pn * 256 + bj * 128 + wc * 32 + 8 * fq, v, w); } }
    }
};


namespace fa {
typedef short bf16x8 __attribute__((ext_vector_type(8)));
typedef float f32x16 __attribute__((ext_vector_type(16)));
typedef unsigned u32x2 __attribute__((ext_vector_type(2)));
typedef float f32x2_t __attribute__((ext_vector_type(2))); typedef __bf16 bf16x2_t __attribute__((ext_vector_type(2)));
__device__ __forceinline__ unsigned cvtpk(float lo, float hi) { f32x2_t v = {lo, hi}; bf16x2_t b = __builtin_convertvector(v, bf16x2_t); return __builtin_bit_cast(unsigned, b); }
constexpr int KS = 272, VS = 272;
constexpr int OFF_K = 0, OFF_V = 128 * KS, OFF_CK = OFF_V + 128 * VS, BUF = OFF_CK + 1024;
constexpr int OFF_X = 0, OFF_UNIT = 2 * BUF;
constexpr int NUNITS = 64 * 32, KT0 = 3;
static_assert(65536 <= BUF && OFF_UNIT + 64 <= 147456, "fa LDS map");
#define FA_MFMA(a, b, c) __builtin_amdgcn_mfma_f32_32x32x16_bf16((a), (b), (c), 0, 0, 0)
__device__ __forceinline__ float max3f(float a, float b, float c) { return __builtin_fmaxf(__builtin_fmaxf(a, b), c); }

template <bool DIFF>
__device__ __forceinline__ void unit(const Params& P, LAS unsigned char* L, int b, int hu, int qb, float lam) {
    constexpr int NDB = DIFF ? 4 : 2;
    const int tid = threadIdx.x, lane = tid & 63, w = __builtin_amdgcn_readfirstlane(tid >> 6), g = w >> 2, wq = w & 3, ql = lane & 31, hi = lane >> 5;
    const bf16_t* QK = (const bf16_t*)(P.ws + WS_BIG); const bf16_t* VT = (const bf16_t*)(P.ws + WS_VT); const float* cum = (const float*)(P.ws + WS_CUM);
    bf16_t* AO = (bf16_t*)(P.ws + WS_AO);
    const int qbw = DIFF ? qb : 2 * qb + g;
    const int st_top = DIFF ? qb : 2 * qb + 1;
    const int qcol = DIFF ? hu * 128 + g * 64 : 1024 + hu * 64;
    const int kcol0 = DIFF ? 512 + hu * 128 : 1536 + hu * 64;
    const int vcol0 = DIFF ? hu * 128 : 512 + hu * 64;
    const int q_abs = 128 * qbw + 32 * wq + ql;
    const size_t qrow = (size_t)b * LP + q_abs;
    bf16x8 qf[4];
#pragma unroll
    for (int ds = 0; ds < 4; ++ds) qf[ds] = *(const bf16x8*)(QK + qrow * QKW + qcol + 16 * ds + 8 * hi);
    const float cq = DIFF ? 0.f : cum[((size_t)b * 8 + hu) * LP + q_abs];
    const bf16_t* kg = DIFF ? QK + ((size_t)b * LP + (tid >> 4)) * QKW + kcol0 + 8 * (tid & 15) : QK + ((size_t)b * LP + (tid >> 3)) * QKW + kcol0 + 8 * (tid & 7);
    const int kl = DIFF ? (tid >> 4) * KS + 16 * (tid & 15) : (tid >> 3) * KS + 16 * (tid & 7);
    const bf16_t* vg = VT + ((size_t)b * 1024 + vcol0 + (tid >> 4)) * LP + 8 * (tid & 15);
    const int vl = (tid >> 4) * VS + 16 * (tid & 15);
    const float* cgp = cum + ((size_t)b * 8 + hu) * LP + (tid & 127);
    u32x4 rk0, rk1, rk2, rk3, rv0, rv1, rv2, rv3; float rc = 0.f;
#define FA_LOAD(st) do { const bf16_t* kp_ = kg + (size_t)(128 * (st)) * QKW; const bf16_t* vp_ = vg + 128 * (st); \
        if (DIFF) { rk0 = *(const u32x4*)(kp_); rk1 = *(const u32x4*)(kp_ + (size_t)32 * QKW); rk2 = *(const u32x4*)(kp_ + (size_t)64 * QKW); rk3 = *(const u32x4*)(kp_ + (size_t)96 * QKW); \
            rv0 = *(const u32x4*)(vp_); rv1 = *(const u32x4*)(vp_ + (size_t)32 * LP); rv2 = *(const u32x4*)(vp_ + (size_t)64 * LP); rv3 = *(const u32x4*)(vp_ + (size_t)96 * LP); } \
        else { rk0 = *(const u32x4*)(kp_); rk1 = *(const u32x4*)(kp_ + (size_t)64 * QKW); rv0 = *(const u32x4*)(vp_); rv1 = *(const u32x4*)(vp_ + (size_t)32 * LP); if (tid < 128) rc = cgp[128 * (st)]; } } while (0)
#define FA_STORE(bo) do { LAS unsigned char* kd_ = L + (bo) + OFF_K + kl; LAS unsigned char* vd_ = L + (bo) + OFF_V + vl; \
        if (DIFF) { *(LAS u32x4*)(kd_) = rk0; *(LAS u32x4*)(kd_ + 32 * KS) = rk1; *(LAS u32x4*)(kd_ + 64 * KS) = rk2; *(LAS u32x4*)(kd_ + 96 * KS) = rk3; \
            *(LAS u32x4*)(vd_) = rv0; *(LAS u32x4*)(vd_ + 32 * VS) = rv1; *(LAS u32x4*)(vd_ + 64 * VS) = rv2; *(LAS u32x4*)(vd_ + 96 * VS) = rv3; } \
        else { *(LAS u32x4*)(kd_) = rk0; *(LAS u32x4*)(kd_ + 64 * KS) = rk1; *(LAS u32x4*)(vd_) = rv0; *(LAS u32x4*)(vd_ + 32 * VS) = rv1; if (tid < 128) *(LAS float*)(L + (bo) + OFF_CK + 4 * tid) = rc; } } while (0)
    const int pim = (ql & 0x13) | ((ql & 4) << 1) | ((ql & 8) >> 1);
    const int ka = pim * KS + ((DIFF ? 64 * g : 0) + 8 * hi) * 2;
    const int va = ql * VS + 16 * hi;
    float m_ref = 0.f, l = 0.f;
    bool first = true;
    f32x16 oacc[NDB];
#pragma unroll
    for (int db = 0; db < NDB; ++db)
#pragma unroll
        for (int r = 0; r < 16; ++r) oacc[db][r] = 0.f;
    f32x16 negm, lacc;
#pragma unroll
    for (int r = 0; r < 16; ++r) { negm[r] = 0.f; lacc[r] = 0.f; }
    bf16x8 onesf;
#pragma unroll
    for (int j = 0; j < 8; ++j) onesf[j] = (ql == 0) ? (short)0x3F80 : (short)0;
    LAS float* qnw = (LAS float*)(L + OFF_UNIT + 16);
    if (!DIFF) {
        float q2 = 0.f;
#pragma unroll
        for (int ds = 0; ds < 4; ++ds) { const u32x4 w = __builtin_bit_cast(u32x4, qf[ds]); const float a0 = bflo(w.x), a1 = bfhi(w.x), a2 = bflo(w.y), a3 = bfhi(w.y), a4 = bflo(w.z), a5 = bfhi(w.z), a6 = bflo(w.w), a7 = bfhi(w.w);
            q2 += (a0 * a0 + a1 * a1) + (a2 * a2 + a3 * a3) + (a4 * a4 + a5 * a5) + (a6 * a6 + a7 * a7); }
        q2 += __shfl_xor(q2, 32);
#pragma unroll
        for (int o = 1; o < 32; o <<= 1) q2 = fmaxf(q2, __shfl_xor(q2, o));
        if (lane == 0) qnw[w] = q2;
    }
    FA_LOAD(st_top); FA_STORE(0);
    __syncthreads();
    asm volatile("" : "+v"(qf[0]), "+v"(qf[1]), "+v"(qf[2]), "+v"(qf[3]));
    float cqp = cq; asm volatile("" : "+v"(cqp));
    int st_end = 0;
    if (!DIFF) {
        float qn2 = qnw[0];
#pragma unroll
        for (int i = 1; i < 8; ++i) qn2 = fmaxf(qn2, qnw[i]);
        const float* cs = cum + ((size_t)b * 8 + hu) * LP;
        const float base = 2.0f * 1.001f * sqrtf(qn2) * ((const float*)(P.ws + WS_KNMAX))[b * 8 + hu] + cs[256 * qb] + 2.0f;
        const int sti = st_top - lane;
        const bool dead = (sti >= 1) && (base - cs[128 * (sti > 0 ? sti : 1) + 127] < -150.0f);
        const unsigned long long mask = __ballot(dead);
        if (mask) st_end = st_top - (int)__builtin_ctzll(mask);
        st_end = __builtin_amdgcn_readfirstlane(st_end);
    }
    int bo = 0;
    for (int st = st_top; st > st_end; --st) {
        if (st - 1 > st_end) FA_LOAD(st - 1);
#pragma unroll
        for (int hh = 1; hh >= 0; --hh) {
        const int k0 = 128 * st + 64 * hh;
        if (k0 + 63 >= NPAD && k0 <= 128 * qbw + 32 * wq + 31) {
            const LAS unsigned char* Kb = L + bo + OFF_K + 64 * hh * KS; const LAS unsigned char* Vb = L + bo + OFF_V + 128 * hh;
            f32x16 s0, s1;
            __builtin_amdgcn_s_setprio(1);
            if (DIFF) {
                const bf16x8 a0 = *(const LAS bf16x8*)(Kb + ka), a1 = *(const LAS bf16x8*)(Kb + ka + 32 * KS);
                s0 = FA_MFMA(a0, qf[0], negm); s1 = FA_MFMA(a1, qf[0], negm);
            } else {
                const float cqm = cqp - m_ref;
                const LAS float* ck = (const LAS float*)(L + bo + OFF_CK) + 64 * hh + 8 * hi;
#pragma unroll
                for (int t = 0; t < 2; ++t) { const f32x4 a = *(const LAS f32x4*)(ck + 16 * t), c = *(const LAS f32x4*)(ck + 16 * t + 4), d = *(const LAS f32x4*)(ck + 32 + 16 * t), e = *(const LAS f32x4*)(ck + 32 + 16 * t + 4);
#pragma unroll
                    for (int j = 0; j < 4; ++j) { s0[8 * t + j] = cqm - a[j]; s0[8 * t + 4 + j] = cqm - c[j]; s1[8 * t + j] = cqm - d[j]; s1[8 * t + 4 + j] = cqm - e[j]; } }
                const bf16x8 a0 = *(const LAS bf16x8*)(Kb + ka), a1 = *(const LAS bf16x8*)(Kb + ka + 32 * KS);
                s0 = FA_MFMA(a0, qf[0], s0); s1 = FA_MFMA(a1, qf[0], s1);
            }
#pragma unroll
            for (int ds = 1; ds < 4; ++ds) { const bf16x8 a0 = *(const LAS bf16x8*)(Kb + ka + 32 * ds), a1 = *(const LAS bf16x8*)(Kb + ka + 32 * KS + 32 * ds);
                s0 = FA_MFMA(a0, qf[ds], s0); s1 = FA_MFMA(a1, qf[ds], s1); }
            __builtin_amdgcn_s_setprio(0);
            if (k0 < NPAD || k0 + 63 > 128 * qbw + 32 * wq) {
#pragma unroll
                for (int r = 0; r < 16; ++r) { const int key = k0 + 16 * (r >> 3) + 8 * hi + (r & 7);
                    if (key > q_abs || key < NPAD) s0[r] = NEGBIG;
                    if (key + 32 > q_abs || key + 32 < NPAD) s1[r] = NEGBIG; }
            }
            float tm = max3f(s0[0], s0[1], s1[0]), tm2 = max3f(s0[2], s0[3], s1[1]); tm = max3f(tm, s1[2], s1[3]);
#pragma unroll
            for (int r = 4; r < 16; r += 4) { tm = max3f(tm, s0[r], s0[r + 1]); tm2 = max3f(tm2, s0[r + 2], s0[r + 3]); tm = max3f(tm, s1[r], s1[r + 1]); tm2 = max3f(tm2, s1[r + 2], s1[r + 3]); }
            tm = fmaxf(tm, tm2);
            { const auto rr = __builtin_amdgcn_permlane32_swap(__float_as_uint(tm), __float_as_uint(tm), false, false); tm = fmaxf(__uint_as_float(rr[0]), __uint_as_float(rr[1])); }
            float tmpost = tm;
            if (first || __any(tm > 8.0f)) {
                const float dl = first ? tm : fmaxf(tm, 0.f);
                m_ref += dl; tmpost = tm - dl;
                if (!first) { const float f = __builtin_amdgcn_exp2f(-dl); l *= f; lacc[0] *= f;
#pragma unroll
                    for (int db = 0; db < NDB; ++db)
#pragma unroll
                        for (int r = 0; r < 16; ++r) oacc[db][r] *= f; }
#pragma unroll
                for (int r = 0; r < 16; ++r) { s0[r] -= dl; s1[r] -= dl; }
                if (DIFF) {
#pragma unroll
                    for (int r = 0; r < 16; ++r) negm[r] = -m_ref;
                }
                first = false;
            }
            if (!__all(tmpost < -150.0f)) {
            float ps = 0.f, ps2 = 0.f;
#pragma unroll
            for (int r = 0; r < 16; ++r) { s0[r] = __builtin_amdgcn_exp2f(s0[r]); s1[r] = __builtin_amdgcn_exp2f(s1[r]); if (DIFF) { ps += s0[r]; ps2 += s1[r]; asm volatile("" : "+v"(ps), "+v"(ps2)); } }
            if (DIFF) l += ps + ps2;
            bf16x8 pb[4];
            { u32x4 t0 = {cvtpk(s0[0], s0[1]), cvtpk(s0[2], s0[3]), cvtpk(s0[4], s0[5]), cvtpk(s0[6], s0[7])}; pb[0] = __builtin_bit_cast(bf16x8, t0);
              u32x4 t1 = {cvtpk(s0[8], s0[9]), cvtpk(s0[10], s0[11]), cvtpk(s0[12], s0[13]), cvtpk(s0[14], s0[15])}; pb[1] = __builtin_bit_cast(bf16x8, t1);
              u32x4 t2 = {cvtpk(s1[0], s1[1]), cvtpk(s1[2], s1[3]), cvtpk(s1[4], s1[5]), cvtpk(s1[6], s1[7])}; pb[2] = __builtin_bit_cast(bf16x8, t2);
              u32x4 t3 = {cvtpk(s1[8], s1[9]), cvtpk(s1[10], s1[11]), cvtpk(s1[12], s1[13]), cvtpk(s1[14], s1[15])}; pb[3] = __builtin_bit_cast(bf16x8, t3); }
            __builtin_amdgcn_s_setprio(1);
#pragma unroll
            for (int ks = 0; ks < 4; ++ks) {
#pragma unroll
                for (int db = 0; db < NDB; ++db) { const bf16x8 av = *(const LAS bf16x8*)(Vb + va + 32 * db * VS + 32 * ks); oacc[db] = FA_MFMA(av, pb[ks], oacc[db]); }
                if (!DIFF) lacc = FA_MFMA(onesf, pb[ks], lacc);
            }
            __builtin_amdgcn_s_setprio(0);
            }
        }
        }
        if (st - 1 > st_end) FA_STORE(bo ^ BUF);
        __syncthreads();
        bo ^= BUF;
    }
#undef FA_LOAD
#undef FA_STORE
    if (DIFF) l += __shfl_xor(l, 32); else l = __shfl(lacc[0], ql);
    const float inv = (q_abs >= NPAD) ? 1.0f / l : 0.f;
    if (DIFF) {
        LAS float* X = (LAS float*)(L + OFF_X);
        if (g == 1) {
#pragma unroll
            for (int db = 0; db < NDB; ++db)
#pragma unroll
                for (int r = 0; r < 16; ++r) X[((wq * 4 + db) * 16 + r) * 64 + lane] = oacc[db][r] * inv;
        }
        __syncthreads();
        if (g == 0) {
            float ss = 0.f;
#pragma unroll
            for (int db = 0; db < NDB; ++db)
#pragma unroll
                for (int r = 0; r < 16; ++r) { const float c = oacc[db][r] * inv - lam * X[((wq * 4 + db) * 16 + r) * 64 + lane]; oacc[db][r] = c; ss += c * c; }
            ss += __shfl_xor(ss, 32);
            const float rr = rsqrtf(ss * (1.0f / 128.f) + SUBLN_EPS);
            bf16_t* dst = AO + qrow * D + hu * 128;
#pragma unroll
            for (int db = 0; db < NDB; ++db)
#pragma unroll
                for (int t = 0; t < 4; ++t) { const int d = 32 * db + 8 * t + 4 * hi;
                    u32x2 o; o.x = cvtpk(oacc[db][4 * t] * rr, oacc[db][4 * t + 1] * rr); o.y = cvtpk(oacc[db][4 * t + 2] * rr, oacc[db][4 * t + 3] * rr);
                    *(u32x2*)(dst + d) = o; }
        }
    } else {
        bf16_t* dst = AO + qrow * D + 512 + hu * 64;
#pragma unroll
        for (int db = 0; db < NDB; ++db)
#pragma unroll
            for (int t = 0; t < 4; ++t) { const int d = 32 * db + 8 * t + 4 * hi;
                u32x2 o; o.x = cvtpk(oacc[db][4 * t] * inv, oacc[db][4 * t + 1] * inv); o.y = cvtpk(oacc[db][4 * t + 2] * inv, oacc[db][4 * t + 3] * inv);
                *(u32x2*)(dst + d) = o; }
    }
}

__device__ __forceinline__ void phase(const Params& P, LAS unsigned char* L) {
    const int tid = threadIdx.x;
    unsigned* ctr = (unsigned*)(P.ws + WS_CTL) + 64;
    LAS int* su = (LAS int*)(L + OFF_UNIT);
    const float lam = ((const float*)(P.ws + WS_CTL))[0];
    const int x0 = (int)(__builtin_amdgcn_s_getreg((3 << 11) | 20) & 7u);
    int a = 0, x = x0;
    int nxt = 0;
    if (tid == 0) nxt = (int)atomicAdd(ctr + 64 * x, 1u);
    for (;;) {
        if (tid == 0) *su = nxt;
        __syncthreads();
        const int i = __builtin_amdgcn_readfirstlane(*su);
        __syncthreads();
        if (i >= 256) { if (++a == 8) break; x = (x0 + a) & 7; if (tid == 0) nxt = (int)atomicAdd(ctr + 64 * x, 1u); continue; }
        if (tid == 0) nxt = (int)atomicAdd(ctr + 64 * x, 1u);
        if (i < 128) { const int d = 2 * x + (i & 1); unit<true>(P, L, d >> 2, d & 3, 65 - (i >> 1), lam); }
        else { const int j = i - 128; const int f = 4 * x + (j & 3); unit<false>(P, L, f >> 3, f & 7, 32 - (j >> 2), lam); }
    }
}
}

#ifndef FAST_ATTN
#define FAST_ATTN 1
#endif
template <bool DIFF> __global__ void __launch_bounds__(256) naive_attn(Params P) { naive_attn_body<DIFF>(P, threadIdx.x, blockIdx.x, blockIdx.y, blockIdx.z); }
#define XB_TMO      128
#define XB_XCNT(j)  (256  + 64 * (j))
#define XB_XSUB(j)  (1280 + 64 * (j))
#define XB_XGEN(j)  (2304 + 64 * (j))
#define XB_TOP      3328
#define XB_TOPGEN   3392
#define XCD_BAR_WORDS 3456
#define XB_SPIN_CAP (1u << 18)

__device__ __forceinline__ unsigned xb_ld(unsigned* p)              { return __hip_atomic_load(p, __ATOMIC_RELAXED, __HIP_MEMORY_SCOPE_AGENT); }
__device__ __forceinline__ unsigned xb_add(unsigned* p, unsigned v) { return __hip_atomic_fetch_add(p, v, __ATOMIC_RELAXED, __HIP_MEMORY_SCOPE_AGENT); }
__device__ __forceinline__ unsigned xb_xcc_id() { return (unsigned)__builtin_amdgcn_s_getreg((3 << 11) | 20) & 0xFu; }
#define XB_SPIN(cond, bar) do { unsigned _sp = 0; while (cond) { __builtin_amdgcn_s_sleep(1); \
    if ((++_sp & 255u) == 0u) { if (xb_ld(&(bar)[XB_TMO])) break; if (_sp > XB_SPIN_CAP) { atomicAdd(&(bar)[XB_TMO], 1u); break; } } } } while (0)

struct XcdBarrier {
    unsigned* bar; unsigned x;
    volatile LAS unsigned* st;
};

__device__ __forceinline__ XcdBarrier xcd_barrier_post(unsigned* bar, volatile LAS unsigned* st) {
    XcdBarrier b; b.bar = bar; b.x = xb_xcc_id(); b.st = st;
    if (threadIdx.x == 0) (void)xb_add(&bar[XB_XCNT(b.x)], 1u);
    return b;
}
__device__ __forceinline__ void xcd_barrier_complete(unsigned* bar, unsigned x, unsigned& nloc, unsigned& nx) {
    const unsigned G = gridDim.x * gridDim.y * gridDim.z;
    unsigned sum, cnt, mine, sp = 0u;
    for (;;) {
        sum = 0u; cnt = 0u; mine = 0u;
#pragma unroll
        for (unsigned j = 0; j < 16; ++j) { const unsigned c = xb_ld(&bar[XB_XCNT(j)]); sum += c; cnt += (c > 0u) ? 1u : 0u; mine = (j == x) ? c : mine; }
        if (sum == G) break;
        __builtin_amdgcn_s_sleep(1);
        if ((++sp & 255u) == 0u) { if (xb_ld(&bar[XB_TMO])) break; if (sp > XB_SPIN_CAP) { atomicAdd(&bar[XB_TMO], 1u); break; } }
    }
    nloc = mine > 0u ? mine : 1u; nx = cnt > 0u ? cnt : 1u;
}

__device__ __forceinline__ void xcd_barrier(const XcdBarrier& b) {
    asm volatile("s_waitcnt vmcnt(0)" ::: "memory");
    __syncthreads();
    if (threadIdx.x == 0) {
        unsigned* bar = b.bar;
        __builtin_amdgcn_s_waitcnt(0);
        unsigned nloc = b.st[0], nx = b.st[1];
        if (nloc == 0u) { xcd_barrier_complete(bar, b.x, nloc, nx); b.st[0] = nloc; b.st[1] = nx; }
        const unsigned old = xb_add(&bar[XB_XSUB(b.x)], 1u);
        const unsigned gen = old / nloc;
        if (old + 1u == (gen + 1u) * nloc) {
            __builtin_amdgcn_fence(__ATOMIC_RELEASE, "agent");
            asm volatile("s_waitcnt vmcnt(0)" ::: "memory");
            const unsigned og = xb_add(&bar[XB_TOP], 1u);
            const unsigned tg = og / nx;
            if (og + 1u == (tg + 1u) * nx) xb_add(&bar[XB_TOPGEN], 1u);
            else XB_SPIN(xb_ld(&bar[XB_TOPGEN]) == tg, bar);
            __builtin_amdgcn_fence(__ATOMIC_ACQUIRE, "agent");
            xb_add(&bar[XB_XGEN(b.x)], 1u);
            asm volatile("s_waitcnt vmcnt(0)" ::: "memory");
        } else {
            XB_SPIN(xb_ld(&bar[XB_XGEN(b.x)]) == gen, bar);
            __builtin_amdgcn_fence(__ATOMIC_ACQUIRE, "agent");
            asm volatile("s_waitcnt vmcnt(0)" ::: "memory");
        }
    }
    __syncthreads();
}

constexpr size_t WS_XBAR = 16 * 1024;
constexpr int LDS_XBST = 147456 - 64;
constexpr int LDS_BYTES = 147456;
constexpr int N_PHASES = 10;
#ifndef MK_PER_PHASE
#define MK_PER_PHASE 0
#endif

__global__ void __launch_bounds__(512, 2) mk(Params P) {
    extern __shared__ __attribute__((aligned(16))) unsigned char lds[];
    cg::grid_group grid = cg::this_grid();
    LAS unsigned char* L = (LAS unsigned char*)lds;
    const int tid = threadIdx.x, lane = tid & 63, wave = __builtin_amdgcn_readfirstlane(tid >> 6);
    const int G = gridDim.x, gw = blockIdx.x * 8 + wave, NGW = G * 8;
    unsigned char* ws = P.ws;
    float* ssq = (float*)(ws + WS_SSQ);
    bf16_t* HB = (bf16_t*)P.out; bf16_t* ACT = (bf16_t*)(ws + WS_BIG); bf16_t* QK = (bf16_t*)(ws + WS_BIG); bf16_t* VT = (bf16_t*)(ws + WS_VT); bf16_t* AO = (bf16_t*)(ws + WS_AO);
    float* H = (float*)(ws + WS_H);
    const int lo = P.ph_lo, hi = P.ph_hi;
#define IN(k) (lo <= (k) && (k) < hi)
    volatile LAS unsigned* xst = (volatile LAS unsigned*)(L + LDS_XBST);
    if (tid < 2) xst[tid] = 0u;
    __syncthreads();
    unsigned* xbar_words = (unsigned*)(ws + WS_XBAR);
    XcdBarrier xbar; xbar.bar = xbar_words; xbar.x = 0; xbar.st = xst;
    if (hi - lo > 1) xbar = xcd_barrier_post(xbar_words, xst);
    if (hi > 1000) grid.sync();
#define SEAM(k) do { if (IN(k) && IN((k) + 1)) xcd_barrier(xbar); } while (0)

    if (IN(0)) { p0_prologue(P, (LAS float*)(L + wave * 17408), gw, NGW, lane); }
    SEAM(0);
    if (IN(1)) {
        for (int t = blockIdx.x; t < DFF / 16; t += G) side_stage1(P, (LAS float*)L, t);
        pg8::Gemm g{HB, (const bf16_t*)(ws + WS_WGU1), TP, NGU, D}; LiveOrder S; S.init(NGU, G, (int)blockIdx.x);
        PgSwiglu E{ssq, ACT};
        pg8::gemm_phase<PgSwiglu, LiveOrder, true, true>(L, g, S, E);
    }
    SEAM(1);
    if (IN(2)) {
        for (int t = blockIdx.x; t < D / 16; t += G) side_stage2(P, (LAS float*)L, t);
        pg8::Gemm g{ACT, (const bf16_t*)(ws + WS_WD1), TP, D, DFF}; LiveOrder S; S.init(D, G, (int)blockIdx.x);
        PgResid E{EpiResid{&P, 1, 0.5f, nullptr, HB, nullptr}, ssq + (size_t)1 * TP};
        pg8::gemm_phase<PgResid, LiveOrder, true, true>(L, g, S, E);
    }
    SEAM(2);
    if (IN(3)) {
        zero_pad_kv(ws, gw, NGW, lane);
        for (int t = blockIdx.x; t < 129; t += G) side_stage3(P, (LAS float*)L, t);
        gates_rows(P, wave * G + (int)blockIdx.x, NGW, lane);
        pg8::Gemm g{HB, (const bf16_t*)(ws + WS_WIN), TP, 3072, D}; LiveOrder S; S.init(3072, G, (int)blockIdx.x);
        PgInproj E{EpiInproj{(const float*)(ws + WS_ROPE), P.in[7], QK, VT, (float*)(ws + WS_LOGF)}, ssq + (size_t)1 * TP};
        pg8::gemm_phase<PgInproj, LiveOrder, true, true>(L, g, S, E);
    }
    SEAM(3);
    if (IN(4)) {
        if (G >= 64) { if (blockIdx.x < 32) cum_scan_seq((const float*)(ws + WS_LOGF), (float*)(ws + WS_CUM), blockIdx.x, (LAS float*)L, tid);
                       else if (blockIdx.x < 64) key_norm_max(QK, (float*)(ws + WS_KNMAX), blockIdx.x - 32, (LAS float*)L, tid); }
        else { for (int bh = blockIdx.x; bh < 32; bh += G) { cum_scan_seq((const float*)(ws + WS_LOGF), (float*)(ws + WS_CUM), bh, (LAS float*)L, tid); key_norm_max(QK, (float*)(ws + WS_KNMAX), bh, (LAS float*)L, tid); } }
    }
    SEAM(4);
    if (IN(5)) {
#if FAST_ATTN
        fa::phase(P, L);
#endif
    }
    SEAM(5);
    if (IN(6)) {
        pg8::Gemm g{AO, (const bf16_t*)(ws + WS_WOUT), TP, D, D}; LiveOrder S; S.init(D, G, (int)blockIdx.x);
        PgResid E{EpiResid{&P, 0, 1.0f, nullptr, HB, HB}, ssq + (size_t)2 * TP};
        pg8::gemm_phase<PgResid, LiveOrder, true, true>(L, g, S, E);
    }
    SEAM(6);
    if (IN(7)) {
        pg8::Gemm g{HB, (const bf16_t*)(ws + WS_WGU2), TP, NGU, D}; LiveOrder S; S.init(NGU, G, (int)blockIdx.x);
        PgSwiglu E{ssq + (size_t)2 * TP, ACT};
        pg8::gemm_phase<PgSwiglu, LiveOrder, true, true>(L, g, S, E);
    }
    SEAM(7);
    if (IN(8)) {
        pg8::Gemm g{ACT, (const bf16_t*)(ws + WS_WD2), TP, D, DFF}; LiveOrder S; S.init(D, G, (int)blockIdx.x);
        PgResid E{EpiResid{&P, 0, 0.5f, H, nullptr, HB}, ssq + (size_t)3 * TP};
        pg8::gemm_phase<PgResid, LiveOrder, true, true>(L, g, S, E);
    }
    SEAM(8);
    if (IN(9)) final_norm_rows(P, gw, NGW, lane);
#undef IN
#undef SEAM
}

extern "C" void kernel_launch(void* const* d_in, const int* in_sizes, int n_in, void* d_out, int out_size, void* d_ws, size_t ws_size, hipStream_t stream) {
    if (n_in != 18 || out_size != BATCH * SEQ * D || ws_size < WS_END) { fprintf(stderr, "kernel_launch: unexpected shapes (n_in %d out %d ws %zu need %zu)\n", n_in, out_size, ws_size, (size_t)WS_END); return; }
    static int grid = 0;
    if (grid == 0) {
        int dev = 0, cus = 0, per_cu = 0;
        (void)hipGetDevice(&dev); (void)hipDeviceGetAttribute(&cus, hipDeviceAttributeMultiprocessorCount, dev);
        (void)hipFuncSetAttribute((const void*)mk, hipFuncAttributeMaxDynamicSharedMemorySize, LDS_BYTES);
        (void)hipOccupancyMaxActiveBlocksPerMultiprocessor(&per_cu, (const void*)mk, 512, LDS_BYTES);
        if (per_cu < 1) { fprintf(stderr, "kernel_launch: occupancy query says %d blocks per CU\n", per_cu); per_cu = 1; }
        grid = cus * per_cu;
    }
    Params P{};
    for (int i = 0; i < 18; ++i) P.in[i] = (const float*)d_in[i];
    P.out = (float*)d_out; P.ws = (unsigned char*)d_ws;
#if MK_PER_PHASE
    for (int ph = 0; ph < N_PHASES; ++ph) { P.ph_lo = ph; P.ph_hi = ph + 1;
        if (ph == 5 && !FAST_ATTN) { hipLaunchKernelGGL(naive_attn<true>, dim3(LP / 64, 4, BATCH), dim3(256), 0, stream, P); hipLaunchKernelGGL(naive_attn<false>, dim3(LP / 128, 8, BATCH), dim3(256), 0, stream, P); continue; }
        hipLaunchKernelGGL(mk, dim3(grid), dim3(512), LDS_BYTES, stream, P); }
#else
    P.ph_lo = 0; P.ph_hi = N_PHASES;
    if (hipMemsetAsync((unsigned char*)d_ws + WS_XBAR, 0, XCD_BAR_WORDS * 4, stream) != hipSuccess) { fprintf(stderr, "kernel_launch: memset of the barrier words failed\n"); return; }
    void* args[] = {&P};
    hipError_t e = hipLaunchCooperativeKernel((const void*)mk, dim3(grid), dim3(512), args, LDS_BYTES, stream);
    if (e != hipSuccess) fprintf(stderr, "cooperative launch failed: %s (grid %d)\n", hipGetErrorString(e), grid);
#endif
}
```

```cpp
#include <hip/hip_runtime.h>
#include <hip/hip_cooperative_groups.h>
namespace cg = cooperative_groups;
#include <cstdio>
#include <cstdint>

typedef unsigned short bf16_t;
typedef unsigned u32x4 __attribute__((ext_vector_type(4)));
typedef float f32x4 __attribute__((ext_vector_type(4)));
#define LAS __attribute__((address_space(3)))

constexpr int D = 1024, BATCH = 4, SEQ = 8192, NMETA = 16, NPAD = 240, REAL0 = 256, LP = 8448, TP = BATCH * LP;
constexpr int DFF = 2816, NGU = 2 * DFF, NIN = 3080, NINP = 3328;
constexpr int QKW = 2048;
constexpr float RMS_EPS = 1e-6f, SUBLN_EPS = 1e-5f, LAMBDA_INIT = 0.2f;
constexpr float QSCALE = 0.18033688011112042f;
constexpr float LOG2E = 1.4426950408889634f;
constexpr float NEGBIG = -1e30f;

constexpr size_t MiB = 1u << 20;
constexpr size_t WS_CTL = 0;
constexpr size_t WS_AT0 = 64 * 1024, WS_ACTT = 128 * 1024, WS_H1T = 320 * 1024, WS_SSQM = 384 * 1024;
constexpr size_t WS_SSQ = 1 * MiB;
constexpr size_t WS_LOGF = 4 * MiB;
constexpr size_t WS_CUM = 6 * MiB;
constexpr size_t WS_ROPE = 8 * MiB;
constexpr size_t WS_WGU1 = 9 * MiB, WS_WD1 = 20 * MiB, WS_WIN = 26 * MiB, WS_WOUT = 33 * MiB, WS_WGU2 = 35 * MiB, WS_WD2 = 46 * MiB;
constexpr size_t WS_H = 52 * MiB;
constexpr size_t WS_AO = 184 * MiB;
constexpr size_t WS_BIG = 250 * MiB;
constexpr size_t WS_VT = WS_BIG + 132 * MiB;
constexpr size_t WS_END = WS_BIG + 198 * MiB;

struct Params {
    const float* in[18];
    float* out; unsigned char* ws;
    int ph_lo, ph_hi;
};

__device__ __forceinline__ unsigned f2bf(float f) { unsigned u = __float_as_uint(f); return (u + 0x7fffu + ((u >> 16) & 1u)) >> 16; }
__device__ __forceinline__ unsigned pk2(float lo, float hi) { return f2bf(lo) | (f2bf(hi) << 16); }
__device__ __forceinline__ float bf2f(unsigned short b) { return __uint_as_float(((unsigned)b) << 16); }
__device__ __forceinline__ float bflo(unsigned w) { return __uint_as_float(w << 16); }
__device__ __forceinline__ float bfhi(unsigned w) { return __uint_as_float(w & 0xffff0000u); }
__device__ __forceinline__ float wave_sum(float v) {
#pragma unroll
    for (int o = 1; o < 64; o <<= 1) v += __shfl_xor(v, o);
    return v;
}
struct F8 { float v[8]; };

__device__ __forceinline__ void wconv_item(const float* W, const float* gvec, int K, int N, bf16_t* WT, int mode, LAS float* scr, int item, int nblk, int lane) {
    const int kb = item / nblk, nb = item % nblk, k0 = 64 * kb, n0 = 64 * nb;
    const int nl = 4 * (lane & 15);
    const int ng = n0 + nl;
    int sc; if (mode == 1) { const int pn = ng >> 8, w = ng & 255, bj = w >> 7, c = w & 127; sc = bj * DFF + 128 * pn + c; } else sc = ng;
    const bool valid = (mode != 2) || (ng < NIN);
#pragma unroll 8
    for (int i = 0; i < 16; ++i) { const int kk = 4 * i + (lane >> 4);
        f32x4 w = valid ? *(const f32x4*)(W + (size_t)(k0 + kk) * N + sc) : (f32x4){0.f, 0.f, 0.f, 0.f};
        if (gvec) { const int kx = k0 + kk; const float gs = (mode == 3) ? (kx < 512 ? gvec[kx & 127] * (1.0f - LAMBDA_INIT) : 1.0f) : gvec[kx]; w.x *= gs; w.y *= gs; w.z *= gs; w.w *= gs; }
        *(LAS f32x4*)(scr + kk * 68 + nl) = w; }
    asm volatile("s_waitcnt lgkmcnt(0)" ::: "memory");
    const int c = lane & 7;
#pragma unroll
    for (int j = 0; j < 8; ++j) { const int n = (lane >> 3) + 8 * j; const LAS float* sp = scr + (8 * c) * 68 + n;
        u32x4 o; o.x = pk2(sp[0 * 68], sp[1 * 68]); o.y = pk2(sp[2 * 68], sp[3 * 68]); o.z = pk2(sp[4 * 68], sp[5 * 68]); o.w = pk2(sp[6 * 68], sp[7 * 68]);
        *(u32x4*)(WT + (size_t)(n0 + n) * K + k0 + 8 * c) = o; }
    asm volatile("s_waitcnt lgkmcnt(0)" ::: "memory");
}

__device__ __forceinline__ const float* h0_row(const Params& P, int row) {
    const int b = row / LP, p = row % LP;
    if (p < NPAD) return nullptr;
    if (p < NPAD + NMETA) return P.in[1] + (size_t)(p - NPAD) * D;
    return P.in[0] + ((size_t)b * SEQ + (p - REAL0)) * D;
}

__device__ __forceinline__ void p0_prologue(const Params& P, LAS float* scr_wave, int gw, int NGW, int lane) {
    unsigned char* ws = P.ws;
    constexpr int I_GU = 16 * (NGU / 64), I_D = (DFF / 64) * (D / 64), I_IN = 16 * (NINP / 64), I_OUT = 16 * (D / 64);
    constexpr int NITEMS = 2 * I_GU + 2 * I_D + I_IN + I_OUT;
    for (int it = gw; it < NITEMS; it += NGW) {
        int r = it;
        if (r < I_GU) { wconv_item(P.in[3], P.in[2], D, NGU, (bf16_t*)(ws + WS_WGU1), 1, scr_wave, r, NGU / 64, lane); continue; } r -= I_GU;
        if (r < I_GU) { wconv_item(P.in[15], P.in[14], D, NGU, (bf16_t*)(ws + WS_WGU2), 1, scr_wave, r, NGU / 64, lane); continue; } r -= I_GU;
        if (r < I_D) { wconv_item(P.in[4], nullptr, DFF, D, (bf16_t*)(ws + WS_WD1), 0, scr_wave, r, D / 64, lane); continue; } r -= I_D;
        if (r < I_D) { wconv_item(P.in[16], nullptr, DFF, D, (bf16_t*)(ws + WS_WD2), 0, scr_wave, r, D / 64, lane); continue; } r -= I_D;
        if (r < I_IN) { wconv_item(P.in[6], P.in[5], D, NIN, (bf16_t*)(ws + WS_WIN), 2, scr_wave, r, NINP / 64, lane); continue; } r -= I_IN;
        wconv_item(P.in[13], P.in[12], D, D, (bf16_t*)(ws + WS_WOUT), 3, scr_wave, r, D / 64, lane);
    }
    float* ssq = (float*)(ws + WS_SSQ);
    bf16_t* HB = (bf16_t*)P.out;
    for (int row = gw; row < TP; row += 2 * NGW) {
        const int row2 = row + NGW; const bool has2 = row2 < TP;
        const float* src = h0_row(P, row); const float* src2 = has2 ? h0_row(P, row2) : nullptr;
        f32x4 v[4], u[4]; float s = 0.f, s2 = 0.f;
#pragma unroll
        for (int j = 0; j < 4; ++j) { v[j] = src ? *((const f32x4*)src + lane + 64 * j) : (f32x4){0.f, 0.f, 0.f, 0.f}; u[j] = src2 ? *((const f32x4*)src2 + lane + 64 * j) : (f32x4){0.f, 0.f, 0.f, 0.f}; }
#pragma unroll
        for (int j = 0; j < 4; ++j) { s += (v[j].x * v[j].x + v[j].y * v[j].y) + (v[j].z * v[j].z + v[j].w * v[j].w); s2 += (u[j].x * u[j].x + u[j].y * u[j].y) + (u[j].z * u[j].z + u[j].w * u[j].w); }
        s = wave_sum(s); s2 = wave_sum(s2);
        unsigned long long* o8 = (unsigned long long*)(HB + (size_t)row * D) + lane;
#pragma unroll
        for (int j = 0; j < 4; ++j) o8[64 * j] = (unsigned long long)pk2(v[j].x, v[j].y) | ((unsigned long long)pk2(v[j].z, v[j].w) << 32);
        if (lane < 4) ssq[(size_t)lane * TP + row] = (lane == 0) ? s : 0.f;
        if (has2) {
            unsigned long long* p8 = (unsigned long long*)(HB + (size_t)row2 * D) + lane;
#pragma unroll
            for (int j = 0; j < 4; ++j) p8[64 * j] = (unsigned long long)pk2(u[j].x, u[j].y) | ((unsigned long long)pk2(u[j].z, u[j].w) << 32);
            if (lane < 4) ssq[(size_t)lane * TP + row2] = (lane == 0) ? s2 : 0.f;
        }
    }
    float* rope = (float*)(ws + WS_ROPE);
    for (int e = gw * 64 + lane; e < (NMETA + SEQ) * 8; e += NGW * 64) {
        const int pos = e >> 3, i = e & 7;
        const double invf = (i == 0) ? 1.0 : (i == 1) ? 0.19392274474868576 : (i == 2) ? 0.03760603093086393 : (i == 3) ? 0.007292664737217109 :
                            (i == 4) ? 0.001414213562373095 : (i == 5) ? 0.0002742481756762073 : (i == 6) ? 5.318295896944988e-05 : 1.031338537721246e-05;
        double rev = (double)pos * invf * 0.15915494309189535; rev -= floor(rev);
        const float rf = (float)rev;
        rope[2 * e] = __builtin_amdgcn_cosf(rf); rope[2 * e + 1] = __builtin_amdgcn_sinf(rf);
    }
    if (gw >= 8 && gw < 8 + NMETA) {
        const int r = gw - 8; const float* src = P.in[1] + (size_t)r * D; const float* g1 = P.in[2]; float* AT0 = (float*)(ws + WS_AT0);
        float v[16]; float sq = 0.f;
#pragma unroll
        for (int j = 0; j < 16; ++j) { v[j] = src[lane + 64 * j]; sq += v[j] * v[j]; }
        const float rs = rsqrtf(wave_sum(sq) * (1.0f / D) + RMS_EPS);
#pragma unroll
        for (int j = 0; j < 16; ++j) { const int k = lane + 64 * j; AT0[k * 16 + r] = v[j] * rs * g1[k]; }
        if (lane == 0) ((float*)(ws + WS_SSQM))[r] = 0.f;
    }
    if (gw == 0) {
        const float a = wave_sum(P.in[8][lane] * P.in[9][lane]), b = wave_sum(P.in[10][lane] * P.in[11][lane]);
        if (lane == 0) { ((float*)(ws + WS_CTL))[0] = expf(a) - expf(b) + LAMBDA_INIT; ((unsigned*)(ws + WS_CTL))[16] = 0u; }
        if (lane < 8) ((unsigned*)(ws + WS_CTL))[64 + 64 * lane] = 0u;
    }
}

__device__ __forceinline__ void zero_pad_kv(unsigned char* ws, int gw, int NGW, int lane) {
    {
        float* logf = (float*)(ws + WS_LOGF); bf16_t* QKz = (bf16_t*)(ws + WS_BIG); bf16_t* VTz = (bf16_t*)(ws + WS_VT);
        for (int e = gw * 64 + lane; e < BATCH * NPAD * 8; e += NGW * 64) { const int b = e / (NPAD * 8), o = e % (NPAD * 8); logf[(size_t)b * LP * 8 + o] = 0.f; }
        for (int e = gw * 64 + lane; e < BATCH * 48 * (QKW / 8); e += NGW * 64) { const int b = e / (48 * (QKW / 8)), o = e % (48 * (QKW / 8)); *(u32x4*)(QKz + ((size_t)b * LP + 192) * QKW + (size_t)o * 8) = (u32x4){0u, 0u, 0u, 0u}; }
        for (int e = gw * 64 + lane; e < BATCH * 1024 * 6; e += NGW * 64) { const int bv = e / 6, o = e % 6; *(u32x4*)(VTz + (size_t)bv * LP + 192 + o * 8) = (u32x4){0u, 0u, 0u, 0u}; }
    }
}

__device__ __forceinline__ float row_rstd(const float* ssq, int row) { return rsqrtf(ssq[row] * (1.0f / D) + RMS_EPS); }

struct EpiSwiglu {
    const float* ssq; bf16_t* ACT;
    __device__ __forceinline__ void operator()(int row, int col, const F8& v, const F8& w, float rstd) const {
        float a[8];
#pragma unroll
        for (int j = 0; j < 8; ++j) { const float g = v.v[j] * rstd, u = w.v[j] * rstd; a[j] = g * u * __builtin_amdgcn_rcpf(1.f + __builtin_amdgcn_exp2f(-LOG2E * g)); }
        u32x4 o; o.x = pk2(a[0], a[1]); o.y = pk2(a[2], a[3]); o.z = pk2(a[4], a[5]); o.w = pk2(a[6], a[7]);
        *(u32x4*)(ACT + (size_t)row * DFF + col) = o;
    }
};
struct EpiResid {
    const Params* P; int from_x; float scale; float* H; bf16_t* HB; const bf16_t* HBin;
    __device__ __forceinline__ F8 load(int row, int col) const {
        F8 r;
        if (from_x) { const float* src = h0_row(*P, row); f32x4 b0 = {0.f, 0.f, 0.f, 0.f}, b1 = b0; if (src) { b0 = *(const f32x4*)(src + col); b1 = *(const f32x4*)(src + col + 4); }
            r.v[0] = b0.x; r.v[1] = b0.y; r.v[2] = b0.z; r.v[3] = b0.w; r.v[4] = b1.x; r.v[5] = b1.y; r.v[6] = b1.z; r.v[7] = b1.w; }
        else { const u32x4 w = *(const u32x4*)(HBin + (size_t)row * D + col);
            r.v[0] = bflo(w.x); r.v[1] = bfhi(w.x); r.v[2] = bflo(w.y); r.v[3] = bfhi(w.y); r.v[4] = bflo(w.z); r.v[5] = bfhi(w.z); r.v[6] = bflo(w.w); r.v[7] = bfhi(w.w); }
        return r;
    }
    __device__ __forceinline__ float finish(int row, int col, const F8& v, const F8& bs) const {
        f32x4 h0 = {bs.v[0] + scale * v.v[0], bs.v[1] + scale * v.v[1], bs.v[2] + scale * v.v[2], bs.v[3] + scale * v.v[3]};
        f32x4 h1 = {bs.v[4] + scale * v.v[4], bs.v[5] + scale * v.v[5], bs.v[6] + scale * v.v[6], bs.v[7] + scale * v.v[7]};
        if (H) { *(f32x4*)(H + (size_t)row * D + col) = h0; *(f32x4*)(H + (size_t)row * D + col + 4) = h1; }
        if (HB) { u32x4 o; o.x = pk2(h0.x, h0.y); o.y = pk2(h0.z, h0.w); o.z = pk2(h1.x, h1.y); o.w = pk2(h1.z, h1.w); *(u32x4*)(HB + (size_t)row * D + col) = o; }
        return (h0.x * h0.x + h0.y * h0.y) + (h0.z * h0.z + h0.w * h0.w) + (h1.x * h1.x + h1.y * h1.y) + (h1.z * h1.z + h1.w * h1.w);
    }
    __device__ __forceinline__ float operator()(int row, int col, const F8& v) const { return finish(row, col, v, load(row, col)); }
};
struct EpiInproj {
    const float* rope; const float* bforget; bf16_t* QK; bf16_t* VT; float* logf;
    __device__ __forceinline__ void qk_rope(int row, int col, const F8& v, const F8& w, const f32x4 (&cs4)[4]) const {
        const int d = col & 63; float a[8];
#pragma unroll
        for (int j = 0; j < 8; ++j) a[j] = v.v[j];
        if (d < 16) {
#pragma unroll
            for (int j = 0; j < 8; ++j) { const float c = cs4[j >> 1][2 * (j & 1)], sn = cs4[j >> 1][2 * (j & 1) + 1]; a[j] = (d < 8) ? v.v[j] * c - w.v[j] * sn : v.v[j] * c + w.v[j] * sn; }
        }
        if (col < 512) {
#pragma unroll
            for (int j = 0; j < 8; ++j) a[j] *= QSCALE;
        }
        u32x4 o; o.x = pk2(a[0], a[1]); o.y = pk2(a[2], a[3]); o.z = pk2(a[4], a[5]); o.w = pk2(a[6], a[7]);
        *(u32x4*)(QK + (size_t)row * QKW + col) = o;
    }
    __device__ __forceinline__ void operator()(int row, int col, const F8& v, const F8& w) const {
        const int b = row / LP, p = row % LP;
        if (col < 1024 || (col >= 1536 && col < 2560)) {
            float a[8]; int dst;
#pragma unroll
            for (int j = 0; j < 8; ++j) a[j] = v.v[j];
            if (col < 1024) {
                const int d = col & 63;
                if (d < 16 && p >= NPAD) {
                    const float* cs = rope + (size_t)(p - NPAD) * 16;
#pragma unroll
                    for (int j = 0; j < 8; ++j) { const float c = cs[2 * j], s = cs[2 * j + 1]; a[j] = (d < 8) ? v.v[j] * c - w.v[j] * s : v.v[j] * c + w.v[j] * s; }
                }
                if (col < 512) {
#pragma unroll
                    for (int j = 0; j < 8; ++j) a[j] *= QSCALE;
                }
                dst = col;
            } else {
                if (col < 2048) {
#pragma unroll
                    for (int j = 0; j < 8; ++j) a[j] *= QSCALE;
                }
                dst = col - 512;
            }
            u32x4 o; o.x = pk2(a[0], a[1]); o.y = pk2(a[2], a[3]); o.z = pk2(a[4], a[5]); o.w = pk2(a[6], a[7]);
            *(u32x4*)(QK + (size_t)row * QKW + dst) = o;
        } else if (col < 3072) {
            const int vcol = (col < 1536) ? col - 1024 : col - 2560 + 512;
            bf16_t* dstp = VT + ((size_t)b * 1024 + vcol) * LP + p;
#pragma unroll
            for (int j = 0; j < 8; ++j) dstp[(size_t)j * LP] = (bf16_t)f2bf(v.v[j]);
        } else if (col == 3072) {
            f32x4 o0, o1; float r[8];
#pragma unroll
            for (int j = 0; j < 8; ++j) { const float x = v.v[j] + bforget[j]; r[j] = (p >= NPAD) ? (fminf(x, 0.f) - log1pf(__expf(-fabsf(x)))) : 0.f; }
            o0 = (f32x4){r[0], r[1], r[2], r[3]}; o1 = (f32x4){r[4], r[5], r[6], r[7]};
            *(f32x4*)(logf + (size_t)row * 8) = o0; *(f32x4*)(logf + (size_t)row * 8 + 4) = o1;
        }
    }
};

template <int MODE  >
__global__ void __launch_bounds__(256) naive_gemm(Params P, const bf16_t* A, const bf16_t* Bt, int K, int norm_in, int norm_out, int from_x, float scale, int writeHB) {
    const int row = blockIdx.x * 256 + threadIdx.x;
    const int c16 = blockIdx.y * 16;
    int n0;
    if (MODE == 0) { const int pn = c16 >> 7, c = c16 & 127; n0 = pn * 256 + c; } else n0 = c16;
    constexpr int NACC = (MODE == 0) ? 32 : 16;
    float acc[NACC];
#pragma unroll
    for (int i = 0; i < NACC; ++i) acc[i] = 0.f;
    const bf16_t* ap = A + (size_t)row * K;
    for (int k = 0; k < K; k += 8) {
        const u32x4 av = *(const u32x4*)(ap + k);
        float a[8] = {bflo(av.x), bfhi(av.x), bflo(av.y), bfhi(av.y), bflo(av.z), bfhi(av.z), bflo(av.w), bfhi(av.w)};
#pragma unroll
        for (int i = 0; i < NACC; ++i) {
            const int n = n0 + (i & 15) + ((i >> 4) << 7);
            const u32x4 bv = *(const u32x4*)(Bt + (size_t)n * K + k);
            acc[i] += a[0] * bflo(bv.x) + a[1] * bfhi(bv.x) + a[2] * bflo(bv.y) + a[3] * bfhi(bv.y) + a[4] * bflo(bv.z) + a[5] * bfhi(bv.z) + a[6] * bflo(bv.w) + a[7] * bfhi(bv.w);
        }
    }
    float* ssq = (float*)(P.ws + WS_SSQ);
    if (MODE == 0) {
        const float rstd = row_rstd(ssq + (size_t)norm_in * TP, row);
        EpiSwiglu E{nullptr, (bf16_t*)(P.ws + WS_BIG)};
        F8 g0, g1, u0, u1;
#pragma unroll
        for (int j = 0; j < 8; ++j) { g0.v[j] = acc[j]; g1.v[j] = acc[8 + j]; u0.v[j] = acc[16 + j]; u1.v[j] = acc[24 + j]; }
        E(row, c16, g0, u0, rstd); E(row, c16 + 8, g1, u1, rstd);
    } else if (MODE == 1) {
        EpiResid E{&P, from_x, scale, (float*)(P.ws + WS_H), writeHB ? (bf16_t*)P.out : nullptr};
        F8 v0, v1;
#pragma unroll
        for (int j = 0; j < 8; ++j) { v0.v[j] = acc[j]; v1.v[j] = acc[8 + j]; }
        const float s = E(row, c16, v0) + E(row, c16 + 8, v1);
        atomicAdd(ssq + (size_t)norm_out * TP + row, s);
    } else {
        const float rstd = row_rstd(ssq + (size_t)norm_in * TP, row);
        EpiInproj E{(const float*)(P.ws + WS_ROPE), P.in[7], (bf16_t*)(P.ws + WS_BIG), (bf16_t*)(P.ws + WS_VT), (float*)(P.ws + WS_LOGF)};
        F8 v0, v1;
#pragma unroll
        for (int j = 0; j < 8; ++j) { v0.v[j] = acc[j] * rstd; v1.v[j] = acc[8 + j] * rstd; }
        E(row, c16, v0, v1); E(row, c16 + 8, v1, v0);
    }
}

constexpr size_t WS_KNMAX = 448 * 1024;
__device__ __forceinline__ void key_norm_max(const bf16_t* QK, float* knmax, int bh, LAS float* sh, int tid) {
    const int b = bh >> 3, h = bh & 7; float mx = 0.f;
    for (int p = NPAD + tid; p < LP; p += 512) { const bf16_t* kr = QK + ((size_t)b * LP + p) * QKW + 1536 + h * 64; float q = 0.f;
#pragma unroll
        for (int i = 0; i < 8; ++i) { const u32x4 w = *(const u32x4*)(kr + 8 * i); const float a0 = bflo(w.x), a1 = bfhi(w.x), a2 = bflo(w.y), a3 = bfhi(w.y), a4 = bflo(w.z), a5 = bfhi(w.z), a6 = bflo(w.w), a7 = bfhi(w.w);
            q += (a0 * a0 + a1 * a1) + (a2 * a2 + a3 * a3) + (a4 * a4 + a5 * a5) + (a6 * a6 + a7 * a7); }
        mx = fmaxf(mx, q); }
#pragma unroll
    for (int o = 1; o < 64; o <<= 1) mx = fmaxf(mx, __shfl_xor(mx, o));
    if ((tid & 63) == 0) sh[tid >> 6] = mx;
    __syncthreads();
    if (tid == 0) { float m = sh[0]; for (int i = 1; i < 8; ++i) m = fmaxf(m, sh[i]); knmax[bh] = sqrtf(m); }
    __syncthreads();
}
__device__ __forceinline__ void cum_scan_seq(const float* logf, float* cum, int bh, LAS float* sh  , int tid) {
    const int b = bh >> 3, h = bh & 7;
    constexpr int PER = 17;
    const int p0 = tid * PER;
    float v[PER]; float s = 0.f;
#pragma unroll
    for (int i = 0; i < PER; ++i) { const int p = p0 + i; v[i] = (p < LP) ? logf[((size_t)b * LP + p) * 8 + h] : 0.f; s += v[i]; v[i] = s; }
    sh[tid] = s;
    __syncthreads();
    for (int off = 1; off < 512; off <<= 1) {
        const float t = (tid >= off) ? sh[tid - off] : 0.f;
        __syncthreads();
        sh[tid] += t;
        __syncthreads();
    }
    const float base = sh[tid] - s;
#pragma unroll
    for (int i = 0; i < PER; ++i) { const int p = p0 + i; if (p < LP) cum[((size_t)b * 8 + h) * LP + p] = (base + v[i]) * LOG2E; }
    __syncthreads();
}

__device__ __forceinline__ void final_norm_rows(const Params& P, int gw, int NGW, int lane) {
    const float* H = (const float*)(P.ws + WS_H); const float* ssq = (const float*)(P.ws + WS_SSQ) + (size_t)3 * TP; const float* g = P.in[17];
    f32x4 gv[4];
#pragma unroll
    for (int j = 0; j < 4; ++j) gv[j] = *((const f32x4*)g + lane + 64 * j);
    for (int t = gw; t < BATCH * SEQ; t += 2 * NGW) {
        const int t2 = t + NGW; const bool has2 = t2 < BATCH * SEQ;
        const int row = (t / SEQ) * LP + REAL0 + (t % SEQ), row2 = has2 ? (t2 / SEQ) * LP + REAL0 + (t2 % SEQ) : row;
        const float rstd = rsqrtf(ssq[row] * (1.0f / D) + RMS_EPS), rstd2 = rsqrtf(ssq[row2] * (1.0f / D) + RMS_EPS);
        const f32x4* hr = (const f32x4*)(H + (size_t)row * D) + lane; const f32x4* hr2 = (const f32x4*)(H + (size_t)row2 * D) + lane;
        f32x4 hv[4], hw[4];
#pragma unroll
        for (int j = 0; j < 4; ++j) { hv[j] = hr[64 * j]; hw[j] = hr2[64 * j]; }
        f32x4* o = (f32x4*)(P.out + (size_t)t * D) + lane;
#pragma unroll
        for (int j = 0; j < 4; ++j) o[64 * j] = (f32x4){hv[j].x * rstd * gv[j].x, hv[j].y * rstd * gv[j].y, hv[j].z * rstd * gv[j].z, hv[j].w * rstd * gv[j].w};
        if (has2) { f32x4* o2 = (f32x4*)(P.out + (size_t)t2 * D) + lane;
#pragma unroll
            for (int j = 0; j < 4; ++j) o2[64 * j] = (f32x4){hw[j].x * rstd2 * gv[j].x, hw[j].y * rstd2 * gv[j].y, hw[j].z * rstd2 * gv[j].z, hw[j].w * rstd2 * gv[j].w}; }
    }
}

template <bool DIFF>
__device__ __forceinline__ void naive_attn_body(const Params& P, int tid, int bx, int h, int b) {
    constexpr int NS = DIFF ? 4 : 2, RPB = 256 / NS;
    const int ql = tid / NS, sub = tid % NS;
    const int pq = bx * RPB + ql;
    const size_t row = (size_t)b * LP + pq;
    const bf16_t* QK = (const bf16_t*)(P.ws + WS_BIG); const bf16_t* VT = (const bf16_t*)(P.ws + WS_VT); const float* cum = (const float*)(P.ws + WS_CUM) + ((size_t)b * 8 + h) * LP;
    bf16_t* AO = (bf16_t*)(P.ws + WS_AO);
    const float lam = ((const float*)(P.ws + WS_CTL))[0];
    float res[32];
#pragma unroll
    for (int j = 0; j < 32; ++j) res[j] = 0.f;
    const bool live = pq >= NPAD;
    for (int map = 0; map < (DIFF ? 2 : 1); ++map) {
        const int qcol = DIFF ? h * 128 + map * 64 : 1024 + h * 64, kcol = DIFF ? 512 + h * 128 + map * 64 : 1536 + h * 64;
        const int vcol0 = DIFF ? h * 128 + sub * 32 : 512 + h * 64 + sub * 32;
        float q[64];
#pragma unroll
        for (int i = 0; i < 8; ++i) { const u32x4 w = *(const u32x4*)(QK + row * QKW + qcol + 8 * i);
            q[8 * i] = bflo(w.x); q[8 * i + 1] = bfhi(w.x); q[8 * i + 2] = bflo(w.y); q[8 * i + 3] = bfhi(w.y); q[8 * i + 4] = bflo(w.z); q[8 * i + 5] = bfhi(w.z); q[8 * i + 6] = bflo(w.w); q[8 * i + 7] = bfhi(w.w); }
        const float cq = DIFF ? 0.f : cum[pq];
        float m = NEGBIG, l = 0.f, o[32];
#pragma unroll
        for (int j = 0; j < 32; ++j) o[j] = 0.f;
        if (live) for (int s0 = NPAD; s0 <= pq; s0 += 8) {
            float sc[8]; float gm = NEGBIG;
#pragma unroll
            for (int e = 0; e < 8; ++e) {
                const int s = s0 + e; const bf16_t* kr = QK + ((size_t)b * LP + s) * QKW + kcol; float d = 0.f;
#pragma unroll
                for (int i = 0; i < 8; ++i) { const u32x4 w = *(const u32x4*)(kr + 8 * i);
                    d += q[8 * i] * bflo(w.x) + q[8 * i + 1] * bfhi(w.x) + q[8 * i + 2] * bflo(w.y) + q[8 * i + 3] * bfhi(w.y) + q[8 * i + 4] * bflo(w.z) + q[8 * i + 5] * bfhi(w.z) + q[8 * i + 6] * bflo(w.w) + q[8 * i + 7] * bfhi(w.w); }
                if (!DIFF) d += cq - cum[s];
                sc[e] = (s <= pq) ? d : NEGBIG; gm = fmaxf(gm, sc[e]);
            }
            const float mn = fmaxf(m, gm), f = exp2f(m - mn);
            float pw[8]; float ps = 0.f;
#pragma unroll
            for (int e = 0; e < 8; ++e) { pw[e] = (s0 + e <= pq) ? exp2f(sc[e] - mn) : 0.f; ps += pw[e]; }
            l = l * f + ps; m = mn;
#pragma unroll
            for (int j = 0; j < 32; ++j) { const u32x4 w = *(const u32x4*)(VT + ((size_t)b * 1024 + vcol0 + j) * LP + s0);
                o[j] = o[j] * f + (pw[0] * bflo(w.x) + pw[1] * bfhi(w.x) + pw[2] * bflo(w.y) + pw[3] * bfhi(w.y) + pw[4] * bflo(w.z) + pw[5] * bfhi(w.z) + pw[6] * bflo(w.w) + pw[7] * bfhi(w.w)); }
        }
        const float il = (l > 0.f) ? 1.f / l : 0.f;
        if (DIFF) {
#pragma unroll
            for (int j = 0; j < 32; ++j) res[j] = (map == 0) ? o[j] * il : res[j] - lam * o[j] * il;
        } else {
#pragma unroll
            for (int j = 0; j < 32; ++j) res[j] = o[j] * il;
        }
    }
    if (DIFF) {
        float ss = 0.f;
#pragma unroll
        for (int j = 0; j < 32; ++j) ss += res[j] * res[j];
        ss += __shfl_xor(ss, 1); ss += __shfl_xor(ss, 2);
        const float r = rsqrtf(ss * (1.0f / 128.f) + SUBLN_EPS) * (1.0f - LAMBDA_INIT);
        const float* g = P.in[12] + sub * 32;
#pragma unroll
        for (int j = 0; j < 32; ++j) res[j] = res[j] * r * g[j];
    }
    bf16_t* dst = AO + row * D + (DIFF ? h * 128 + sub * 32 : 512 + h * 64 + sub * 32);
#pragma unroll
    for (int j = 0; j < 4; ++j) { u32x4 o4; o4.x = pk2(res[8 * j], res[8 * j + 1]); o4.y = pk2(res[8 * j + 2], res[8 * j + 3]); o4.z = pk2(res[8 * j + 4], res[8 * j + 5]); o4.w = pk2(res[8 * j + 6], res[8 * j + 7]);
        *(u32x4*)(dst + 8 * j) = live ? o4 : (u32x4){0u, 0u, 0u, 0u}; }
}


namespace pg8 {
#define PG8_LAS __attribute__((address_space(3)))
typedef unsigned short bf16_t;
typedef short bf16x8 __attribute__((ext_vector_type(8)));
typedef float f32x4 __attribute__((ext_vector_type(4)));
typedef unsigned u32x4 __attribute__((ext_vector_type(4)));
constexpr int BM = 256, BK = 64, HALF = 128, HTB = HALF * BK * 2  , STAGE_BYTES = 8 * HTB, NXCD = 8, WGM = 8;

__host__ __device__ __forceinline__ int lds_byte(int r, int c) { const int st = (r >> 4) * 2 + (c >> 5), rr = r & 15, cc = c & 31, ob = rr * 64 + cc * 2; return st * 1024 + (ob ^ (((ob >> 9) & 1) << 5)); }
__host__ __device__ __forceinline__ void stage_rc(int b, int& R, int& C) { const int st = b / 1024, sb = b % 1024, swz = sb ^ (((sb >> 9) & 1) << 5); R = (st >> 1) * 16 + swz / 64; C = (st & 1) * 32 + (swz % 64) / 2; }
__host__ __device__ __forceinline__ int perm32(int rho) { const int n = rho >> 4, i = rho & 15; return 8 * (i >> 2) + 4 * n + (i & 3); }

struct Unit { int pm, pn; };
struct Gemm { const bf16_t* A; const bf16_t* Bt; int M, N, K; };

struct StaticOrder {
    int nM, nN, nwg, G, c;
    __host__ __device__ void init(int M, int N, int G_, int c_) { nM = M / BM; nN = N / BM; nwg = nM * nN; G = G_; c = c_; }
    __host__ __device__ bool next(int i, Unit& u) const {
        const long L = (long)i * G + c; if (L >= nwg) return false;
        int wgid = (int)L; { const int q = nwg / NXCD, r = nwg % NXCD, xcd = wgid % NXCD, off = wgid / NXCD; wgid = (xcd < r ? xcd * (q + 1) : r * (q + 1) + (xcd - r) * q) + off; }
        const int nig = WGM * nN, gid = wgid / nig, fm = gid * WGM, gsz = (nM - fm) < WGM ? (nM - fm) : WGM;
        u.pm = fm + ((wgid % nig) % gsz); u.pn = (wgid % nig) / gsz; return true;
    }
    __device__ __forceinline__ void a_ready(const Unit&) const {}
    __device__ __forceinline__ void done(const Unit&) const {}
};

template <class Epi, class Sched, bool ALIGN_EPI = false, bool SP2 = false>
__device__ __forceinline__ void gemm_phase(PG8_LAS unsigned char* lds, const Gemm g, const Sched& S, const Epi& E) {
    const int tid = threadIdx.x, wid = __builtin_amdgcn_readfirstlane(tid >> 6), lane = tid & 63, wr = wid >> 2, wc = wid & 3, fr = lane & 15, fq = lane >> 4;
    const int K = g.K, nt = K / BK;
    unsigned voffA[2], voffB[2];
#pragma unroll
    for (int i = 0; i < 2; ++i) { int R, C; stage_rc(tid * 16 + i * 8192, R, C); const int Rb = Epi::PERM ? ((R & ~31) + perm32(R & 31)) : R;
        voffA[i] = (unsigned)(R * K + C) * 2u; voffB[i] = (unsigned)(Rb * K + C) * 2u; }
    const size_t kstep = (size_t)(BK * 2);
    const size_t hstep = (size_t)HALF * K * 2;
    const size_t tstep = 2 * hstep;
    const unsigned ldsw = (unsigned)wid * 1024u;
    const int aoff = lds_byte(wr * 64 + fr, fq * 8), boff = lds_byte(wc * 32 + fr, fq * 8);
#define PG8_SA(b, h) (((b) * 2 + (h)) * HTB)
#define PG8_SB(b, h) ((4 + (b) * 2 + (h)) * HTB)
#define PG8_STAGE(bufoff, gbase, voff) do { _Pragma("unroll") for (int _i = 0; _i < 2; ++_i) \
        __builtin_amdgcn_global_load_lds((const unsigned*)((const char*)(gbase) + (voff)[_i]), (PG8_LAS unsigned*)(lds + (bufoff) + ldsw + _i * 8192), 16, 0, 0); } while (0)
#define PG8_LDA(dst, b, h) do { _Pragma("unroll") for (int m = 0; m < 4; ++m) _Pragma("unroll") for (int k = 0; k < 2; ++k) dst[m][k] = *(const PG8_LAS bf16x8*)(lds + PG8_SA(b, h) + aoff + m * 2048 + k * 1024); } while (0)
#define PG8_LDB(dst, b, h) do { _Pragma("unroll") for (int n = 0; n < 2; ++n) _Pragma("unroll") for (int k = 0; k < 2; ++k) dst[n][k] = *(const PG8_LAS bf16x8*)(lds + PG8_SB(b, h) + boff + n * 2048 + k * 1024); } while (0)
#define PG8_MMA(ai, bj, At, Bt) do { __builtin_amdgcn_s_setprio(1); _Pragma("unroll") for (int m = 0; m < 4; ++m) _Pragma("unroll") for (int n = 0; n < 2; ++n) _Pragma("unroll") for (int k = 0; k < 2; ++k) \
        acc[ai][bj][m][n] = __builtin_amdgcn_mfma_f32_16x16x32_bf16(Bt[n][k], At[m][k], acc[ai][bj][m][n], 0, 0, 0); __builtin_amdgcn_s_setprio(0); } while (0)
#define PG8_WAIT_V(n) asm volatile("s_waitcnt vmcnt(" #n ")" ::: "memory")
#define PG8_WAIT_L(n) asm volatile("s_waitcnt lgkmcnt(" #n ")" ::: "memory")
#define PG8_BAR __builtin_amdgcn_s_barrier()
#define PG8_SCHED __builtin_amdgcn_sched_barrier(0)
    Unit cur, nxt; int ui = 0;
    if (!S.next(0, cur)) return;
    f32x4 acc[2][2][4][2];
#pragma unroll
    for (int a = 0; a < 2; ++a)
#pragma unroll
        for (int b = 0; b < 2; ++b)
#pragma unroll
            for (int m = 0; m < 4; ++m)
#pragma unroll
                for (int n = 0; n < 2; ++n) acc[a][b][m][n] = (f32x4){0.f, 0.f, 0.f, 0.f};
    bf16x8 At[4][2], B0[2][2], B1[2][2];
    const char* cA = (const char*)g.A + (size_t)cur.pm * tstep; const char* cB = (const char*)g.Bt + (size_t)cur.pn * tstep;
    S.a_ready(cur);
    if constexpr (SP2) {
        PG8_STAGE(PG8_SB(0, 0), cB, voffB); PG8_STAGE(PG8_SB(0, 1), cB + hstep, voffB); PG8_STAGE(PG8_SA(0, 0), cA, voffA); PG8_STAGE(PG8_SA(0, 1), cA + hstep, voffA);
        if (wr == 1) PG8_BAR;
        PG8_WAIT_V(2); PG8_BAR;
        PG8_STAGE(PG8_SB(1, 0), cB + kstep, voffB); PG8_STAGE(PG8_SA(1, 0), cA + kstep, voffA); PG8_STAGE(PG8_SB(1, 1), cB + hstep + kstep, voffB);
        PG8_WAIT_V(6); PG8_BAR;
    } else {
        PG8_STAGE(PG8_SB(0, 0), cB, voffB); PG8_STAGE(PG8_SA(0, 0), cA, voffA); PG8_STAGE(PG8_SB(0, 1), cB + hstep, voffB); PG8_STAGE(PG8_SA(0, 1), cA + hstep, voffA);
        if (wr == 1) PG8_BAR;
        PG8_WAIT_V(4); PG8_BAR;
        PG8_STAGE(PG8_SB(1, 0), cB + kstep, voffB); PG8_STAGE(PG8_SA(1, 0), cA + kstep, voffA); PG8_STAGE(PG8_SB(1, 1), cB + hstep + kstep, voffB);
        PG8_WAIT_V(6); PG8_BAR;
    }
    for (;;) {
        const bool has_next = S.next(ui + 1, nxt);
        const char* nA = has_next ? (const char*)g.A + (size_t)nxt.pm * tstep : cA; const char* nB = has_next ? (const char*)g.Bt + (size_t)nxt.pn * tstep : cB;
        for (int t = 0; t < nt; t += 2) {
            const bool last = (t == nt - 2);
            const char* a1 = cA + (size_t)(t + 1) * kstep;
            const char* a2 = last ? nA : cA + (size_t)(t + 2) * kstep; const char* b2 = last ? nB : cB + (size_t)(t + 2) * kstep;
            const char* a3 = a2 + kstep; const char* b3 = b2 + kstep;
            if (last && has_next) S.a_ready(nxt);
            if constexpr (SP2) {
            PG8_LDB(B0, 0, 0); PG8_LDB(B1, 0, 1); PG8_SCHED; PG8_LDA(At, 0, 0); PG8_STAGE(PG8_SA(1, 1), a1 + hstep, voffA);
            PG8_WAIT_V(8); PG8_WAIT_L(0); PG8_BAR; PG8_MMA(0, 0, At, B0); PG8_MMA(0, 1, At, B1); PG8_BAR; PG8_SCHED;
            PG8_LDA(At, 0, 1); PG8_STAGE(PG8_SB(0, 0), b2, voffB); PG8_STAGE(PG8_SB(0, 1), b2 + hstep, voffB); PG8_STAGE(PG8_SA(0, 0), a2, voffA);
            PG8_WAIT_V(8); PG8_WAIT_L(0); PG8_BAR; PG8_MMA(1, 0, At, B0); PG8_MMA(1, 1, At, B1); PG8_BAR; PG8_SCHED;
            PG8_LDB(B0, 1, 0); PG8_LDB(B1, 1, 1); PG8_SCHED; PG8_LDA(At, 1, 0); PG8_STAGE(PG8_SA(0, 1), a2 + hstep, voffA);
            PG8_WAIT_V(8); PG8_WAIT_L(0); PG8_BAR; PG8_MMA(0, 0, At, B0); PG8_MMA(0, 1, At, B1); PG8_BAR; PG8_SCHED;
            PG8_LDA(At, 1, 1); PG8_STAGE(PG8_SB(1, 0), b3, voffB); PG8_STAGE(PG8_SB(1, 1), b3 + hstep, voffB); PG8_STAGE(PG8_SA(1, 0), a3, voffA);
            PG8_WAIT_V(8); PG8_WAIT_L(0); PG8_BAR; PG8_MMA(1, 0, At, B0); PG8_MMA(1, 1, At, B1); PG8_BAR; PG8_SCHED;
            } else {
            PG8_LDB(B0, 0, 0); PG8_SCHED; PG8_LDA(At, 0, 0); PG8_STAGE(PG8_SA(1, 1), a1 + hstep, voffA);
            PG8_WAIT_L(8); PG8_BAR; PG8_WAIT_L(0); PG8_MMA(0, 0, At, B0); PG8_BAR; PG8_SCHED;
            PG8_LDB(B1, 0, 1); PG8_STAGE(PG8_SB(0, 0), b2, voffB);
            PG8_BAR; PG8_WAIT_L(0); PG8_MMA(0, 1, At, B1); PG8_BAR;
            PG8_LDA(At, 0, 1); PG8_STAGE(PG8_SA(0, 0), a2, voffA);
            PG8_BAR; PG8_WAIT_L(0); PG8_MMA(1, 0, At, B0); PG8_BAR; PG8_SCHED;
            PG8_STAGE(PG8_SB(0, 1), b2 + hstep, voffB);
            PG8_WAIT_V(6); PG8_BAR; PG8_MMA(1, 1, At, B1); PG8_BAR;
            PG8_LDB(B0, 1, 0); PG8_SCHED; PG8_LDA(At, 1, 0); PG8_STAGE(PG8_SA(0, 1), a2 + hstep, voffA);
            PG8_WAIT_L(8); PG8_BAR; PG8_WAIT_L(0); PG8_MMA(0, 0, At, B0); PG8_BAR; PG8_SCHED;
            PG8_LDB(B1, 1, 1); PG8_STAGE(PG8_SB(1, 0), b3, voffB);
            PG8_BAR; PG8_WAIT_L(0); PG8_MMA(0, 1, At, B1); PG8_BAR;
            PG8_LDA(At, 1, 1); PG8_STAGE(PG8_SA(1, 0), a3, voffA);
            PG8_BAR; PG8_WAIT_L(0); PG8_MMA(1, 0, At, B0); PG8_BAR; PG8_SCHED;
            PG8_STAGE(PG8_SB(1, 1), b3 + hstep, voffB);
            PG8_WAIT_V(6); PG8_BAR; PG8_MMA(1, 1, At, B1); PG8_BAR;
            }
        }
        if constexpr (ALIGN_EPI) { if (wr == 0) PG8_BAR; }
        if constexpr (!Epi::AFTER_DRAIN) { E(acc, cur, wr, wc, fr, fq); S.done(cur); }
        if (!has_next) break;
#pragma unroll
        for (int a = 0; a < 2; ++a)
#pragma unroll
            for (int b = 0; b < 2; ++b)
#pragma unroll
                for (int m = 0; m < 4; ++m)
#pragma unroll
                    for (int n = 0; n < 2; ++n) acc[a][b][m][n] = (f32x4){0.f, 0.f, 0.f, 0.f};
        cur = nxt; cA = nA; cB = nB; ++ui;
        if constexpr (ALIGN_EPI) { if (wr == 1) PG8_BAR; }
    }
    PG8_WAIT_V(0);
    if constexpr (!ALIGN_EPI) { if (wr == 0) PG8_BAR; }
    PG8_BAR;
    if constexpr (Epi::AFTER_DRAIN) { E.fused(acc, cur, wr, wc, fr, fq, lds, wid, lane); S.done(cur); }
#undef PG8_SA
#undef PG8_SB
#undef PG8_STAGE
#undef PG8_LDA
#undef PG8_LDB
#undef PG8_MMA
#undef PG8_WAIT_V
#undef PG8_WAIT_L
#undef PG8_BAR
#undef PG8_SCHED
}
}


template <int NW>
__device__ __forceinline__ void side16_dot(const float* AT, const float* W, int ldw, int K, const int (&col)[NW], const float* gk, LAS float* red, float (&res)[NW]) {
    const int tid = threadIdx.x, lane = tid & 63, w = tid >> 6, c = lane & 15, kq = lane >> 4;
    float acc[NW][16];
#pragma unroll
    for (int wi = 0; wi < NW; ++wi)
#pragma unroll
        for (int r = 0; r < 16; ++r) acc[wi][r] = 0.f;
    const int ks = K >> 3, kbeg = w * ks;
#pragma unroll 8
    for (int k = kbeg + kq; k < kbeg + ks; k += 4) {
        const f32x4 a0 = *(const f32x4*)(AT + (size_t)k * 16), a1 = *(const f32x4*)(AT + (size_t)k * 16 + 4), a2 = *(const f32x4*)(AT + (size_t)k * 16 + 8), a3 = *(const f32x4*)(AT + (size_t)k * 16 + 12);
        const float gs = gk ? gk[k] : 1.f;
#pragma unroll
        for (int wi = 0; wi < NW; ++wi) { const float wv = (col[wi] >= 0) ? W[(size_t)k * ldw + col[wi]] * gs : 0.f;
            acc[wi][0] += a0.x * wv; acc[wi][1] += a0.y * wv; acc[wi][2] += a0.z * wv; acc[wi][3] += a0.w * wv; acc[wi][4] += a1.x * wv; acc[wi][5] += a1.y * wv; acc[wi][6] += a1.z * wv; acc[wi][7] += a1.w * wv;
            acc[wi][8] += a2.x * wv; acc[wi][9] += a2.y * wv; acc[wi][10] += a2.z * wv; acc[wi][11] += a2.w * wv; acc[wi][12] += a3.x * wv; acc[wi][13] += a3.y * wv; acc[wi][14] += a3.z * wv; acc[wi][15] += a3.w * wv; }
    }
#pragma unroll
    for (int wi = 0; wi < NW; ++wi)
#pragma unroll
        for (int r = 0; r < 16; ++r) { float v = acc[wi][r]; v += __shfl_xor(v, 16); v += __shfl_xor(v, 32); if (kq == 0) red[((wi * 8 + w) * 16 + r) * 16 + c] = v; }
    __syncthreads();
    if (tid < 256) {
#pragma unroll
        for (int wi = 0; wi < NW; ++wi) { float v = 0.f;
#pragma unroll
            for (int ww = 0; ww < 8; ++ww) v += red[(wi * 8 + ww) * 256 + tid];
            res[wi] = v; }
    }
    __syncthreads();
}
__device__ __forceinline__ void side_stage1(const Params& P, LAS float* red, int t) {
    const int tid = threadIdx.x, c = tid & 15;
    const int col[2] = {16 * t + c, DFF + 16 * t + c}; float res[2];
    side16_dot<2>((const float*)(P.ws + WS_AT0), P.in[3], NGU, D, col, nullptr, red, res);
    if (tid < 256) { const int r = tid >> 4, cc = tid & 15; const float g = res[0], u = res[1]; ((float*)(P.ws + WS_ACTT))[(16 * t + cc) * 16 + r] = g * u / (1.f + __expf(-g)); }
}
__device__ __forceinline__ void side_stage2(const Params& P, LAS float* red, int t) {
    const int tid = threadIdx.x, c = tid & 15;
    const int col[1] = {16 * t + c}; float res[1];
    side16_dot<1>((const float*)(P.ws + WS_ACTT), P.in[4], D, DFF, col, nullptr, red, res);
    if (tid < 256) { const int r = tid >> 4, cc = tid & 15, n = 16 * t + cc; const float h1 = P.in[1][(size_t)r * D + n] + 0.5f * res[0];
        ((float*)(P.ws + WS_H1T))[n * 16 + r] = h1;
        float q = h1 * h1; q += __shfl_xor(q, 1); q += __shfl_xor(q, 2); q += __shfl_xor(q, 4); q += __shfl_xor(q, 8);
        if (cc == 0) unsafeAtomicAdd((float*)(P.ws + WS_SSQM) + r, q); }
}
__device__ __forceinline__ void side_stage3(const Params& P, LAS float* red, int t) {
    const int tid = threadIdx.x, c = tid & 15;
    const int kind = (t >= 128) ? 4 : (t >> 5);
    const int n0 = (kind == 0) ? 512 + 16 * t : (kind == 1) ? 1024 + 16 * (t - 32) : (kind == 2) ? 2048 + 16 * (t - 64) : (kind == 3) ? 2560 + 16 * (t - 96) : 3072;
    const int col[1] = {(n0 + c < NIN) ? n0 + c : -1}; float res[1];
    side16_dot<1>((const float*)(P.ws + WS_H1T), P.in[6], NIN, D, col, P.in[5], red, res);
    float v = 0.f; int r = 0, cc = 0;
    if (tid < 256) { r = tid >> 4; cc = tid & 15; v = res[0] * rsqrtf(((const float*)(P.ws + WS_SSQM))[r] * (1.0f / D) + RMS_EPS); red[tid] = v; }
    __syncthreads();
    if (tid < 256) {
        const int n = n0 + cc; const int p = NPAD + r;
        bf16_t* QK = (bf16_t*)(P.ws + WS_BIG); bf16_t* VT = (bf16_t*)(P.ws + WS_VT); float* logf = (float*)(P.ws + WS_LOGF);
        if (kind == 0 || kind == 2) {
            float o = v;
            if (kind == 0 && (n & 63) < 16) { const float pr = red[tid ^ 8]; const float* cs = (const float*)(P.ws + WS_ROPE) + (size_t)r * 16 + 2 * (n & 7);
                o = ((n & 63) < 8) ? v * cs[0] - pr * cs[1] : v * cs[0] + pr * cs[1]; }
            const int dst = (kind == 0) ? n : n - 512;
            for (int b = 0; b < BATCH; ++b) QK[((size_t)b * LP + p) * QKW + dst] = (bf16_t)f2bf(o);
        } else if (kind == 1 || kind == 3) {
            const int vcol = (kind == 1) ? n - 1024 : n - 2560 + 512;
            for (int b = 0; b < BATCH; ++b) VT[((size_t)b * 1024 + vcol) * LP + p] = (bf16_t)f2bf(v);
        } else if (cc < 8) {
            const float x = v + P.in[7][cc]; const float lf = fminf(x, 0.f) - log1pf(__expf(-fabsf(x)));
            for (int b = 0; b < BATCH; ++b) logf[((size_t)b * LP + p) * 8 + cc] = lf;
        }
    }
    __syncthreads();
}


__device__ __forceinline__ void gates_rows(const Params& P, int widx, int nw, int lane) {
    typedef short bf16x8 __attribute__((ext_vector_type(8))); typedef float f32x16 __attribute__((ext_vector_type(16)));
    const bf16_t* HB = (const bf16_t*)P.out; const bf16_t* WG = (const bf16_t*)(P.ws + WS_WIN) + (size_t)3072 * D;
    const float* ssq1 = (const float*)(P.ws + WS_SSQ) + TP; float* logf = (float*)(P.ws + WS_LOGF); const float* bfg = P.in[7];
    const int ql = lane & 31, hi = lane >> 5;
    for (int t = widx; t < 1024; t += nw) {
        const int lt = t >> 3, row0 = (lt + (lt >> 5) + 1) * 256 + (t & 7) * 32;
        const bf16_t* ap = WG + (size_t)ql * D + 8 * hi; const bf16_t* bp = HB + (size_t)(row0 + ql) * D + 8 * hi;
        f32x16 acc;
#pragma unroll
        for (int r = 0; r < 16; ++r) acc[r] = 0.f;
#pragma unroll 16
        for (int ks = 0; ks < 64; ++ks) { const bf16x8 a = *(const bf16x8*)(ap + 16 * ks), b = *(const bf16x8*)(bp + 16 * ks); acc = __builtin_amdgcn_mfma_f32_32x32x16_bf16(a, b, acc, 0, 0, 0); }
        const int row = row0 + ql; const float rstd = row_rstd(ssq1, row);
        f32x4 o;
#pragma unroll
        for (int j = 0; j < 4; ++j) { const float x = acc[j] * rstd + bfg[4 * hi + j]; o[j] = fminf(x, 0.f) - log1pf(__expf(-fabsf(x))); }
        *(f32x4*)(logf + (size_t)row * 8 + 4 * hi) = o;
    }
}

struct LiveOrder {
    pg8::StaticOrder S;
    __device__ void init(int N, int G, int c) { S.init(128 * 256, N, G, c); }
    __device__ bool next(int i, pg8::Unit& u) const { if (!S.next(i, u)) return false; u.pm = u.pm + (u.pm >> 5) + 1; return true; }
    __device__ __forceinline__ void a_ready(const pg8::Unit&) const {}
    __device__ __forceinline__ void done(const pg8::Unit&) const {}
};
__device__ __forceinline__ F8 acc8(const f32x4 (&acc)[2][2][4][2], int ai, int bj, int m) {
    F8 r; const f32x4 a = acc[ai][bj][m][0], b = acc[ai][bj][m][1];
    r.v[0] = a[0]; r.v[1] = a[1]; r.v[2] = a[2]; r.v[3] = a[3]; r.v[4] = b[0]; r.v[5] = b[1]; r.v[6] = b[2]; r.v[7] = b[3]; return r;
}
struct PgSwiglu {
    static constexpr bool PERM = true, AFTER_DRAIN = false;
    const float* ssq_in; bf16_t* ACT;
    __device__ __forceinline__ void operator()(const f32x4 (&acc)[2][2][4][2], const pg8::Unit& u, int wr, int wc, int fr, int fq) const {
        const EpiSwiglu E{nullptr, ACT};
        const int col = u.pn * 128 + wc * 32 + 8 * fq;
        float rs[2][4];
#pragma unroll
        for (int ai = 0; ai < 2; ++ai)
#pragma unroll
            for (int m = 0; m < 4; ++m) rs[ai][m] = ssq_in[u.pm * 256 + ai * 128 + wr * 64 + m * 16 + fr];
#pragma unroll
        for (int ai = 0; ai < 2; ++ai)
#pragma unroll
            for (int m = 0; m < 4; ++m) rs[ai][m] = rsqrtf(rs[ai][m] * (1.0f / D) + RMS_EPS);
#pragma unroll
        for (int ai = 0; ai < 2; ++ai)
#pragma unroll
            for (int m = 0; m < 4; ++m) { const int row = u.pm * 256 + ai * 128 + wr * 64 + m * 16 + fr;
                E(row, col, acc8(acc, ai, 0, m), acc8(acc, ai, 1, m), rs[ai][m]); }
    }
};
struct PgResid {
    static constexpr bool PERM = true, AFTER_DRAIN = false;
    EpiResid E; float* ssq_out;
    __device__ __forceinline__ void operator()(const f32x4 (&acc)[2][2][4][2], const pg8::Unit& u, int wr, int wc, int fr, int fq) const {
#pragma unroll
        for (int ai = 0; ai < 2; ++ai) {
            F8 bs[4][2];
#pragma unroll
            for (int m = 0; m < 4; ++m)
#pragma unroll
                for (int bj = 0; bj < 2; ++bj) bs[m][bj] = E.load(u.pm * 256 + ai * 128 + wr * 64 + m * 16 + fr, u.pn * 256 + bj * 128 + wc * 32 + 8 * fq);
#pragma unroll
            for (int m = 0; m < 4; ++m) { const int row = u.pm * 256 + ai * 128 + wr * 64 + m * 16 + fr; float s = 0.f;
#pragma unroll
                for (int bj = 0; bj < 2; ++bj) s += E.finish(row, u.pn * 256 + bj * 128 + wc * 32 + 8 * fq, acc8(acc, ai, bj, m), bs[m][bj]);
                s += __shfl_xor(s, 16); s += __shfl_xor(s, 32);
                if (fq == 0) unsafeAtomicAdd(ssq_out + row, s); }
        }
    }
};
struct PgInproj {
    static constexpr bool PERM = true, AFTER_DRAIN = false;
    EpiInproj E; const float* ssq_in;
    __device__ __forceinline__ void operator()(const f32x4 (&acc)[2][2][4][2], const pg8::Unit& u, int wr, int wc, int fr, int fq) const {
        const bool rope_tile = u.pn < 4;
        float rs[2][4];
        if (rope_tile) {
            const bool need = ((wc & 1) == 0) && (fq < 2);
            float rr[2][4];
#pragma unroll
            for (int ai = 0; ai < 2; ++ai)
#pragma unroll
                for (int m = 0; m < 4; ++m) rr[ai][m] = ssq_in[u.pm * 256 + ai * 128 + wr * 64 + m * 16 + fr];
#pragma unroll
            for (int ah = 0; ah < 4; ++ah) {
                const int ai = ah >> 1, m0 = (ah & 1) * 2;
                f32x4 cst[2][4];
#pragma unroll
                for (int mm = 0; mm < 2; ++mm) { const int p = (u.pm * 256 + ai * 128 + wr * 64 + (m0 + mm) * 16 + fr) % LP; const f32x4* cp = (const f32x4*)(E.rope + (size_t)(need ? p - NPAD : 0) * 16);
#pragma unroll
                    for (int i = 0; i < 4; ++i) cst[mm][i] = need ? cp[i] : (f32x4){0.f, 0.f, 0.f, 0.f}; }
#pragma unroll
                for (int mm = 0; mm < 2; ++mm) { const int m = m0 + mm; const int row = u.pm * 256 + ai * 128 + wr * 64 + m * 16 + fr; const float rstd = rsqrtf(rr[ai][m] * (1.0f / D) + RMS_EPS);
#pragma unroll
                    for (int bj = 0; bj < 2; ++bj) { F8 v = acc8(acc, ai, bj, m), w;
#pragma unroll
                        for (int j = 0; j < 8; ++j) v.v[j] *= rstd;
#pragma unroll
                        for (int j = 0; j < 8; ++j) w.v[j] = __shfl_xor(v.v[j], 16);
                        E.qk_rope(row, u.pn * 256 + bj * 128 + wc * 32 + 8 * fq, v, w, cst[mm]); } }
            }
            return;
        }
#pragma unroll
        for (int ai = 0; ai < 2; ++ai)
#pragma unroll
            for (int m = 0; m < 4; ++m) rs[ai][m] = ssq_in[u.pm * 256 + ai * 128 + wr * 64 + m * 16 + fr];
#pragma unroll
        for (int ai = 0; ai < 2; ++ai)
#pragma unroll
            for (int m = 0; m < 4; ++m) rs[ai][m] = rsqrtf(rs[ai][m] * (1.0f / D) + RMS_EPS);
#pragma unroll
        for (int ai = 0; ai < 2; ++ai)
#pragma unroll
            for (int m = 0; m < 4; ++m) { const int row = u.pm * 256 + ai * 128 + wr * 64 + m * 16 + fr; const float rstd = rs[ai][m];
#pragma unroll
                for (int bj = 0; bj < 2; ++bj) { F8 v = acc8(acc, ai, bj, m), w;
#pragma unroll
                    for (int j = 0; j < 8; ++j) v.v[j] *= rstd;
                    if (rope_tile) {
#pragma unroll
                        for (int j = 0; j < 8; ++j) w.v[j] = __shfl_xor(v.v[j], 16);
                    } else w = v;
                    E(row, u.pn * 256 + bj * 128 + wc * 32 + 8 * fq, v, w); } }
    }
};


namespace fa {
typedef short bf16x8 __attribute__((ext_vector_type(8)));
typedef float f32x16 __attribute__((ext_vector_type(16)));
typedef unsigned u32x2 __attribute__((ext_vector_type(2)));
typedef float f32x2_t __attribute__((ext_vector_type(2))); typedef __bf16 bf16x2_t __attribute__((ext_vector_type(2)));
__device__ __forceinline__ unsigned cvtpk(float lo, float hi) { f32x2_t v = {lo, hi}; bf16x2_t b = __builtin_convertvector(v, bf16x2_t); return __builtin_bit_cast(unsigned, b); }
constexpr int KS = 272, VS = 272;
constexpr int OFF_K = 0, OFF_V = 128 * KS, OFF_CK = OFF_V + 128 * VS, BUF = OFF_CK + 1024;
constexpr int OFF_X = 0, OFF_UNIT = 2 * BUF;
constexpr int NUNITS = 64 * 32, KT0 = 3;
static_assert(65536 <= BUF && OFF_UNIT + 64 <= 147456, "fa LDS map");
#define FA_MFMA(a, b, c) __builtin_amdgcn_mfma_f32_32x32x16_bf16((a), (b), (c), 0, 0, 0)
__device__ __forceinline__ float max3f(float a, float b, float c) { return __builtin_fmaxf(__builtin_fmaxf(a, b), c); }

template <bool DIFF>
__device__ __forceinline__ void unit(const Params& P, LAS unsigned char* L, int b, int hu, int qb, float lam) {
    constexpr int NDB = DIFF ? 4 : 2;
    const int tid = threadIdx.x, lane = tid & 63, w = __builtin_amdgcn_readfirstlane(tid >> 6), g = w >> 2, wq = w & 3, ql = lane & 31, hi = lane >> 5;
    const bf16_t* QK = (const bf16_t*)(P.ws + WS_BIG); const bf16_t* VT = (const bf16_t*)(P.ws + WS_VT); const float* cum = (const float*)(P.ws + WS_CUM);
    bf16_t* AO = (bf16_t*)(P.ws + WS_AO);
    const int qbw = DIFF ? qb : 2 * qb + g;
    const int st_top = DIFF ? qb : 2 * qb + 1;
    const int qcol = DIFF ? hu * 128 + g * 64 : 1024 + hu * 64;
    const int kcol0 = DIFF ? 512 + hu * 128 : 1536 + hu * 64;
    const int vcol0 = DIFF ? hu * 128 : 512 + hu * 64;
    const int q_abs = 128 * qbw + 32 * wq + ql;
    const size_t qrow = (size_t)b * LP + q_abs;
    bf16x8 qf[4];
#pragma unroll
    for (int ds = 0; ds < 4; ++ds) qf[ds] = *(const bf16x8*)(QK + qrow * QKW + qcol + 16 * ds + 8 * hi);
    const float cq = DIFF ? 0.f : cum[((size_t)b * 8 + hu) * LP + q_abs];
    const bf16_t* kg = DIFF ? QK + ((size_t)b * LP + (tid >> 4)) * QKW + kcol0 + 8 * (tid & 15) : QK + ((size_t)b * LP + (tid >> 3)) * QKW + kcol0 + 8 * (tid & 7);
    const int kl = DIFF ? (tid >> 4) * KS + 16 * (tid & 15) : (tid >> 3) * KS + 16 * (tid & 7);
    const bf16_t* vg = VT + ((size_t)b * 1024 + vcol0 + (tid >> 4)) * LP + 8 * (tid & 15);
    const int vl = (tid >> 4) * VS + 16 * (tid & 15);
    const float* cgp = cum + ((size_t)b * 8 + hu) * LP + (tid & 127);
    u32x4 rk0, rk1, rk2, rk3, rv0, rv1, rv2, rv3; float rc = 0.f;
#define FA_LOAD(st) do { const bf16_t* kp_ = kg + (size_t)(128 * (st)) * QKW; const bf16_t* vp_ = vg + 128 * (st); \
        if (DIFF) { rk0 = *(const u32x4*)(kp_); rk1 = *(const u32x4*)(kp_ + (size_t)32 * QKW); rk2 = *(const u32x4*)(kp_ + (size_t)64 * QKW); rk3 = *(const u32x4*)(kp_ + (size_t)96 * QKW); \
            rv0 = *(const u32x4*)(vp_); rv1 = *(const u32x4*)(vp_ + (size_t)32 * LP); rv2 = *(const u32x4*)(vp_ + (size_t)64 * LP); rv3 = *(const u32x4*)(vp_ + (size_t)96 * LP); } \
        else { rk0 = *(const u32x4*)(kp_); rk1 = *(const u32x4*)(kp_ + (size_t)64 * QKW); rv0 = *(const u32x4*)(vp_); rv1 = *(const u32x4*)(vp_ + (size_t)32 * LP); if (tid < 128) rc = cgp[128 * (st)]; } } while (0)
#define FA_STORE(bo) do { LAS unsigned char* kd_ = L + (bo) + OFF_K + kl; LAS unsigned char* vd_ = L + (bo) + OFF_V + vl; \
        if (DIFF) { *(LAS u32x4*)(kd_) = rk0; *(LAS u32x4*)(kd_ + 32 * KS) = rk1; *(LAS u32x4*)(kd_ + 64 * KS) = rk2; *(LAS u32x4*)(kd_ + 96 * KS) = rk3; \
            *(LAS u32x4*)(vd_) = rv0; *(LAS u32x4*)(vd_ + 32 * VS) = rv1; *(LAS u32x4*)(vd_ + 64 * VS) = rv2; *(LAS u32x4*)(vd_ + 96 * VS) = rv3; } \
        else { *(LAS u32x4*)(kd_) = rk0; *(LAS u32x4*)(kd_ + 64 * KS) = rk1; *(LAS u32x4*)(vd_) = rv0; *(LAS u32x4*)(vd_ + 32 * VS) = rv1; if (tid < 128) *(LAS float*)(L + (bo) + OFF_CK + 4 * tid) = rc; } } while (0)
    const int pim = (ql & 0x13) | ((ql & 4) << 1) | ((ql & 8) >> 1);
    const int ka = pim * KS + ((DIFF ? 64 * g : 0) + 8 * hi) * 2;
    const int va = ql * VS + 16 * hi;
    float m_ref = 0.f, l = 0.f;
    bool first = true;
    f32x16 oacc[NDB];
#pragma unroll
    for (int db = 0; db < NDB; ++db)
#pragma unroll
        for (int r = 0; r < 16; ++r) oacc[db][r] = 0.f;
    f32x16 negm, lacc;
#pragma unroll
    for (int r = 0; r < 16; ++r) { negm[r] = 0.f; lacc[r] = 0.f; }
    bf16x8 onesf;
#pragma unroll
    for (int j = 0; j < 8; ++j) onesf[j] = (ql == 0) ? (short)0x3F80 : (short)0;
    LAS float* qnw = (LAS float*)(L + OFF_UNIT + 16);
    if (!DIFF) {
        float q2 = 0.f;
#pragma unroll
        for (int ds = 0; ds < 4; ++ds) { const u32x4 w = __builtin_bit_cast(u32x4, qf[ds]); const float a0 = bflo(w.x), a1 = bfhi(w.x), a2 = bflo(w.y), a3 = bfhi(w.y), a4 = bflo(w.z), a5 = bfhi(w.z), a6 = bflo(w.w), a7 = bfhi(w.w);
            q2 += (a0 * a0 + a1 * a1) + (a2 * a2 + a3 * a3) + (a4 * a4 + a5 * a5) + (a6 * a6 + a7 * a7); }
        q2 += __shfl_xor(q2, 32);
#pragma unroll
        for (int o = 1; o < 32; o <<= 1) q2 = fmaxf(q2, __shfl_xor(q2, o));
        if (lane == 0) qnw[w] = q2;
    }
    FA_LOAD(st_top); FA_STORE(0);
    __syncthreads();
    asm volatile("" : "+v"(qf[0]), "+v"(qf[1]), "+v"(qf[2]), "+v"(qf[3]));
    float cqp = cq; asm volatile("" : "+v"(cqp));
    int st_end = 0;
    if (!DIFF) {
        float qn2 = qnw[0];
#pragma unroll
        for (int i = 1; i < 8; ++i) qn2 = fmaxf(qn2, qnw[i]);
        const float* cs = cum + ((size_t)b * 8 + hu) * LP;
        const float base = 2.0f * 1.001f * sqrtf(qn2) * ((const float*)(P.ws + WS_KNMAX))[b * 8 + hu] + cs[256 * qb] + 2.0f;
        const int sti = st_top - lane;
        const bool dead = (sti >= 1) && (base - cs[128 * (sti > 0 ? sti : 1) + 127] < -150.0f);
        const unsigned long long mask = __ballot(dead);
        if (mask) st_end = st_top - (int)__builtin_ctzll(mask);
        st_end = __builtin_amdgcn_readfirstlane(st_end);
    }
    int bo = 0;
    for (int st = st_top; st > st_end; --st) {
        if (st - 1 > st_end) FA_LOAD(st - 1);
#pragma unroll
        for (int hh = 1; hh >= 0; --hh) {
        const int k0 = 128 * st + 64 * hh;
        if (k0 + 63 >= NPAD && k0 <= 128 * qbw + 32 * wq + 31) {
            const LAS unsigned char* Kb = L + bo + OFF_K + 64 * hh * KS; const LAS unsigned char* Vb = L + bo + OFF_V + 128 * hh;
            f32x16 s0, s1;
            __builtin_amdgcn_s_setprio(1);
            if (DIFF) {
                const bf16x8 a0 = *(const LAS bf16x8*)(Kb + ka), a1 = *(const LAS bf16x8*)(Kb + ka + 32 * KS);
                s0 = FA_MFMA(a0, qf[0], negm); s1 = FA_MFMA(a1, qf[0], negm);
            } else {
                const float cqm = cqp - m_ref;
                const LAS float* ck = (const LAS float*)(L + bo + OFF_CK) + 64 * hh + 8 * hi;
#pragma unroll
                for (int t = 0; t < 2; ++t) { const f32x4 a = *(const LAS f32x4*)(ck + 16 * t), c = *(const LAS f32x4*)(ck + 16 * t + 4), d = *(const LAS f32x4*)(ck + 32 + 16 * t), e = *(const LAS f32x4*)(ck + 32 + 16 * t + 4);
#pragma unroll
                    for (int j = 0; j < 4; ++j) { s0[8 * t + j] = cqm - a[j]; s0[8 * t + 4 + j] = cqm - c[j]; s1[8 * t + j] = cqm - d[j]; s1[8 * t + 4 + j] = cqm - e[j]; } }
                const bf16x8 a0 = *(const LAS bf16x8*)(Kb + ka), a1 = *(const LAS bf16x8*)(Kb + ka + 32 * KS);
                s0 = FA_MFMA(a0, qf[0], s0); s1 = FA_MFMA(a1, qf[0], s1);
            }
#pragma unroll
            for (int ds = 1; ds < 4; ++ds) { const bf16x8 a0 = *(const LAS bf16x8*)(Kb + ka + 32 * ds), a1 = *(const LAS bf16x8*)(Kb + ka + 32 * KS + 32 * ds);
                s0 = FA_MFMA(a0, qf[ds], s0); s1 = FA_MFMA(a1, qf[ds], s1); }
            __builtin_amdgcn_s_setprio(0);
            if (k0 < NPAD || k0 + 63 > 128 * qbw + 32 * wq) {
#pragma unroll
                for (int r = 0; r < 16; ++r) { const int key = k0 + 16 * (r >> 3) + 8 * hi + (r & 7);
                    if (key > q_abs || key < NPAD) s0[r] = NEGBIG;
                    if (key + 32 > q_abs || key + 32 < NPAD) s1[r] = NEGBIG; }
            }
            float tm = max3f(s0[0], s0[1], s1[0]), tm2 = max3f(s0[2], s0[3], s1[1]); tm = max3f(tm, s1[2], s1[3]);
#pragma unroll
            for (int r = 4; r < 16; r += 4) { tm = max3f(tm, s0[r], s0[r + 1]); tm2 = max3f(tm2, s0[r + 2], s0[r + 3]); tm = max3f(tm, s1[r], s1[r + 1]); tm2 = max3f(tm2, s1[r + 2], s1[r + 3]); }
            tm = fmaxf(tm, tm2);
            { const auto rr = __builtin_amdgcn_permlane32_swap(__float_as_uint(tm), __float_as_uint(tm), false, false); tm = fmaxf(__uint_as_float(rr[0]), __uint_as_float(rr[1])); }
            float tmpost = tm;
            if (first || __any(tm > 8.0f)) {
                const float dl = first ? tm : fmaxf(tm, 0.f);
                m_ref += dl; tmpost = tm - dl;
                if (!first) { const float f = __builtin_amdgcn_exp2f(-dl); l *= f; lacc[0] *= f;
#pragma unroll
                    for (int db = 0; db < NDB; ++db)
#pragma unroll
                        for (int r = 0; r < 16; ++r) oacc[db][r] *= f; }
#pragma unroll
                for (int r = 0; r < 16; ++r) { s0[r] -= dl; s1[r] -= dl; }
                if (DIFF) {
#pragma unroll
                    for (int r = 0; r < 16; ++r) negm[r] = -m_ref;
                }
                first = false;
            }
            if (!__all(tmpost < -150.0f)) {
            float ps = 0.f, ps2 = 0.f;
#pragma unroll
            for (int r = 0; r < 16; ++r) { s0[r] = __builtin_amdgcn_exp2f(s0[r]); s1[r] = __builtin_amdgcn_exp2f(s1[r]); if (DIFF) { ps += s0[r]; ps2 += s1[r]; asm volatile("" : "+v"(ps), "+v"(ps2)); } }
            if (DIFF) l += ps + ps2;
            bf16x8 pb[4];
            { u32x4 t0 = {cvtpk(s0[0], s0[1]), cvtpk(s0[2], s0[3]), cvtpk(s0[4], s0[5]), cvtpk(s0[6], s0[7])}; pb[0] = __builtin_bit_cast(bf16x8, t0);
              u32x4 t1 = {cvtpk(s0[8], s0[9]), cvtpk(s0[10], s0[11]), cvtpk(s0[12], s0[13]), cvtpk(s0[14], s0[15])}; pb[1] = __builtin_bit_cast(bf16x8, t1);
              u32x4 t2 = {cvtpk(s1[0], s1[1]), cvtpk(s1[2], s1[3]), cvtpk(s1[4], s1[5]), cvtpk(s1[6], s1[7])}; pb[2] = __builtin_bit_cast(bf16x8, t2);
              u32x4 t3 = {cvtpk(s1[8], s1[9]), cvtpk(s1[10], s1[11]), cvtpk(s1[12], s1[13]), cvtpk(s1[14], s1[15])}; pb[3] = __builtin_bit_cast(bf16x8, t3); }
            __builtin_amdgcn_s_setprio(1);
#pragma unroll
            for (int ks = 0; ks < 4; ++ks) {
#pragma unroll
                for (int db = 0; db < NDB; ++db) { const bf16x8 av = *(const LAS bf16x8*)(Vb + va + 32 * db * VS + 32 * ks); oacc[db] = FA_MFMA(av, pb[ks], oacc[db]); }
                if (!DIFF) lacc = FA_MFMA(onesf, pb[ks], lacc);
            }
            __builtin_amdgcn_s_setprio(0);
            }
        }
        }
        if (st - 1 > st_end) FA_STORE(bo ^ BUF);
        __syncthreads();
        bo ^= BUF;
    }
#undef FA_LOAD
#undef FA_STORE
    if (DIFF) l += __shfl_xor(l, 32); else l = __shfl(lacc[0], ql);
    const float inv = (q_abs >= NPAD) ? 1.0f / l : 0.f;
    if (DIFF) {
        LAS float* X = (LAS float*)(L + OFF_X);
        if (g == 1) {
#pragma unroll
            for (int db = 0; db < NDB; ++db)
#pragma unroll
                for (int r = 0; r < 16; ++r) X[((wq * 4 + db) * 16 + r) * 64 + lane] = oacc[db][r] * inv;
        }
        __syncthreads();
        if (g == 0) {
            float ss = 0.f;
#pragma unroll
            for (int db = 0; db < NDB; ++db)
#pragma unroll
                for (int r = 0; r < 16; ++r) { const float c = oacc[db][r] * inv - lam * X[((wq * 4 + db) * 16 + r) * 64 + lane]; oacc[db][r] = c; ss += c * c; }
            ss += __shfl_xor(ss, 32);
            const float rr = rsqrtf(ss * (1.0f / 128.f) + SUBLN_EPS);
            bf16_t* dst = AO + qrow * D + hu * 128;
#pragma unroll
            for (int db = 0; db < NDB; ++db)
#pragma unroll
                for (int t = 0; t < 4; ++t) { const int d = 32 * db + 8 * t + 4 * hi;
                    u32x2 o; o.x = cvtpk(oacc[db][4 * t] * rr, oacc[db][4 * t + 1] * rr); o.y = cvtpk(oacc[db][4 * t + 2] * rr, oacc[db][4 * t + 3] * rr);
                    *(u32x2*)(dst + d) = o; }
        }
    } else {
        bf16_t* dst = AO + qrow * D + 512 + hu * 64;
#pragma unroll
        for (int db = 0; db < NDB; ++db)
#pragma unroll
            for (int t = 0; t < 4; ++t) { const int d = 32 * db + 8 * t + 4 * hi;
                u32x2 o; o.x = cvtpk(oacc[db][4 * t] * inv, oacc[db][4 * t + 1] * inv); o.y = cvtpk(oacc[db][4 * t + 2] * inv, oacc[db][4 * t + 3] * inv);
                *(u32x2*)(dst + d) = o; }
    }
}

__device__ __forceinline__ void phase(const Params& P, LAS unsigned char* L) {
    const int tid = threadIdx.x;
    unsigned* ctr = (unsigned*)(P.ws + WS_CTL) + 64;
    LAS int* su = (LAS int*)(L + OFF_UNIT);
    const float lam = ((const float*)(P.ws + WS_CTL))[0];
    const int x0 = (int)(__builtin_amdgcn_s_getreg((3 << 11) | 20) & 7u);
    int a = 0;
    for (;;) {
        const int x = (x0 + a) & 7;
        if (tid == 0) *su = (int)atomicAdd(ctr + 64 * x, 1u);
        __syncthreads();
        const int i = __builtin_amdgcn_readfirstlane(*su);
        __syncthreads();
        if (i >= 256) { if (++a == 8) break; continue; }
        if (i < 128) { const int d = 2 * x + (i & 1); unit<true>(P, L, d >> 2, d & 3, 65 - (i >> 1), lam); }
        else { const int j = i - 128; const int f = 4 * x + (j & 3); unit<false>(P, L, f >> 3, f & 7, 32 - (j >> 2), lam); }
    }
}
}

#ifndef FAST_ATTN
#define FAST_ATTN 1
#endif
template <bool DIFF> __global__ void __launch_bounds__(256) naive_attn(Params P) { naive_attn_body<DIFF>(P, threadIdx.x, blockIdx.x, blockIdx.y, blockIdx.z); }
#define XB_TMO      128
#define XB_XCNT(j)  (256  + 64 * (j))
#define XB_XSUB(j)  (1280 + 64 * (j))
#define XB_XGEN(j)  (2304 + 64 * (j))
#define XB_TOP      3328
#define XB_TOPGEN   3392
#define XCD_BAR_WORDS 3456
#define XB_SPIN_CAP (1u << 18)

__device__ __forceinline__ unsigned xb_ld(unsigned* p)              { return __hip_atomic_load(p, __ATOMIC_RELAXED, __HIP_MEMORY_SCOPE_AGENT); }
__device__ __forceinline__ unsigned xb_add(unsigned* p, unsigned v) { return __hip_atomic_fetch_add(p, v, __ATOMIC_RELAXED, __HIP_MEMORY_SCOPE_AGENT); }
__device__ __forceinline__ unsigned xb_xcc_id() { return (unsigned)__builtin_amdgcn_s_getreg((3 << 11) | 20) & 0xFu; }
#define XB_SPIN(cond, bar) do { unsigned _sp = 0; while (cond) { __builtin_amdgcn_s_sleep(1); \
    if ((++_sp & 255u) == 0u) { if (xb_ld(&(bar)[XB_TMO])) break; if (_sp > XB_SPIN_CAP) { atomicAdd(&(bar)[XB_TMO], 1u); break; } } } } while (0)

struct XcdBarrier {
    unsigned* bar; unsigned x;
    volatile LAS unsigned* st;
};

__device__ __forceinline__ XcdBarrier xcd_barrier_post(unsigned* bar, volatile LAS unsigned* st) {
    XcdBarrier b; b.bar = bar; b.x = xb_xcc_id(); b.st = st;
    if (threadIdx.x == 0) (void)xb_add(&bar[XB_XCNT(b.x)], 1u);
    return b;
}
__device__ __forceinline__ void xcd_barrier_complete(unsigned* bar, unsigned x, unsigned& nloc, unsigned& nx) {
    const unsigned G = gridDim.x * gridDim.y * gridDim.z;
    unsigned sum, cnt, mine, sp = 0u;
    for (;;) {
        sum = 0u; cnt = 0u; mine = 0u;
#pragma unroll
        for (unsigned j = 0; j < 16; ++j) { const unsigned c = xb_ld(&bar[XB_XCNT(j)]); sum += c; cnt += (c > 0u) ? 1u : 0u; mine = (j == x) ? c : mine; }
        if (sum == G) break;
        __builtin_amdgcn_s_sleep(1);
        if ((++sp & 255u) == 0u) { if (xb_ld(&bar[XB_TMO])) break; if (sp > XB_SPIN_CAP) { atomicAdd(&bar[XB_TMO], 1u); break; } }
    }
    nloc = mine > 0u ? mine : 1u; nx = cnt > 0u ? cnt : 1u;
}

__device__ __forceinline__ void xcd_barrier(const XcdBarrier& b) {
    asm volatile("s_waitcnt vmcnt(0)" ::: "memory");
    __syncthreads();
    if (threadIdx.x == 0) {
        unsigned* bar = b.bar;
        __builtin_amdgcn_s_waitcnt(0);
        unsigned nloc = b.st[0], nx = b.st[1];
        if (nloc == 0u) { xcd_barrier_complete(bar, b.x, nloc, nx); b.st[0] = nloc; b.st[1] = nx; }
        const unsigned old = xb_add(&bar[XB_XSUB(b.x)], 1u);
        const unsigned gen = old / nloc;
        if (old + 1u == (gen + 1u) * nloc) {
            __builtin_amdgcn_fence(__ATOMIC_RELEASE, "agent");
            asm volatile("s_waitcnt vmcnt(0)" ::: "memory");
            const unsigned og = xb_add(&bar[XB_TOP], 1u);
            const unsigned tg = og / nx;
            if (og + 1u == (tg + 1u) * nx) xb_add(&bar[XB_TOPGEN], 1u);
            else XB_SPIN(xb_ld(&bar[XB_TOPGEN]) == tg, bar);
            __builtin_amdgcn_fence(__ATOMIC_ACQUIRE, "agent");
            xb_add(&bar[XB_XGEN(b.x)], 1u);
            asm volatile("s_waitcnt vmcnt(0)" ::: "memory");
        } else {
            XB_SPIN(xb_ld(&bar[XB_XGEN(b.x)]) == gen, bar);
            __builtin_amdgcn_fence(__ATOMIC_ACQUIRE, "agent");
            asm volatile("s_waitcnt vmcnt(0)" ::: "memory");
        }
    }
    __syncthreads();
}

constexpr size_t WS_XBAR = 16 * 1024;
constexpr int LDS_XBST = 147456 - 64;
constexpr int LDS_BYTES = 147456;
constexpr int N_PHASES = 10;
#ifndef MK_PER_PHASE
#define MK_PER_PHASE 0
#endif

__global__ void __launch_bounds__(512, 2) mk(Params P) {
    extern __shared__ __attribute__((aligned(16))) unsigned char lds[];
    cg::grid_group grid = cg::this_grid();
    LAS unsigned char* L = (LAS unsigned char*)lds;
    const int tid = threadIdx.x, lane = tid & 63, wave = __builtin_amdgcn_readfirstlane(tid >> 6);
    const int G = gridDim.x, gw = blockIdx.x * 8 + wave, NGW = G * 8;
    unsigned char* ws = P.ws;
    float* ssq = (float*)(ws + WS_SSQ);
    bf16_t* HB = (bf16_t*)P.out; bf16_t* ACT = (bf16_t*)(ws + WS_BIG); bf16_t* QK = (bf16_t*)(ws + WS_BIG); bf16_t* VT = (bf16_t*)(ws + WS_VT); bf16_t* AO = (bf16_t*)(ws + WS_AO);
    float* H = (float*)(ws + WS_H);
    const int lo = P.ph_lo, hi = P.ph_hi;
#define IN(k) (lo <= (k) && (k) < hi)
    volatile LAS unsigned* xst = (volatile LAS unsigned*)(L + LDS_XBST);
    if (tid < 2) xst[tid] = 0u;
    __syncthreads();
    unsigned* xbar_words = (unsigned*)(ws + WS_XBAR);
    XcdBarrier xbar; xbar.bar = xbar_words; xbar.x = 0; xbar.st = xst;
    if (hi - lo > 1) xbar = xcd_barrier_post(xbar_words, xst);
    if (hi > 1000) grid.sync();
#define SEAM(k) do { if (IN(k) && IN((k) + 1)) xcd_barrier(xbar); } while (0)

    if (IN(0)) { p0_prologue(P, (LAS float*)(L + wave * 17408), gw, NGW, lane); }
    SEAM(0);
    if (IN(1)) {
        for (int t = blockIdx.x; t < DFF / 16; t += G) side_stage1(P, (LAS float*)L, t);
        pg8::Gemm g{HB, (const bf16_t*)(ws + WS_WGU1), TP, NGU, D}; LiveOrder S; S.init(NGU, G, (int)blockIdx.x);
        PgSwiglu E{ssq, ACT};
        pg8::gemm_phase<PgSwiglu, LiveOrder, true, true>(L, g, S, E);
    }
    SEAM(1);
    if (IN(2)) {
        for (int t = blockIdx.x; t < D / 16; t += G) side_stage2(P, (LAS float*)L, t);
        pg8::Gemm g{ACT, (const bf16_t*)(ws + WS_WD1), TP, D, DFF}; LiveOrder S; S.init(D, G, (int)blockIdx.x);
        PgResid E{EpiResid{&P, 1, 0.5f, nullptr, HB, nullptr}, ssq + (size_t)1 * TP};
        pg8::gemm_phase<PgResid, LiveOrder, true, true>(L, g, S, E);
    }
    SEAM(2);
    if (IN(3)) {
        zero_pad_kv(ws, gw, NGW, lane);
        for (int t = blockIdx.x; t < 129; t += G) side_stage3(P, (LAS float*)L, t);
        gates_rows(P, wave * G + (int)blockIdx.x, NGW, lane);
        pg8::Gemm g{HB, (const bf16_t*)(ws + WS_WIN), TP, 3072, D}; LiveOrder S; S.init(3072, G, (int)blockIdx.x);
        PgInproj E{EpiInproj{(const float*)(ws + WS_ROPE), P.in[7], QK, VT, (float*)(ws + WS_LOGF)}, ssq + (size_t)1 * TP};
        pg8::gemm_phase<PgInproj, LiveOrder, true, true>(L, g, S, E);
    }
    SEAM(3);
    if (IN(4)) {
        if (G >= 64) { if (blockIdx.x < 32) cum_scan_seq((const float*)(ws + WS_LOGF), (float*)(ws + WS_CUM), blockIdx.x, (LAS float*)L, tid);
                       else if (blockIdx.x < 64) key_norm_max(QK, (float*)(ws + WS_KNMAX), blockIdx.x - 32, (LAS float*)L, tid); }
        else { for (int bh = blockIdx.x; bh < 32; bh += G) { cum_scan_seq((const float*)(ws + WS_LOGF), (float*)(ws + WS_CUM), bh, (LAS float*)L, tid); key_norm_max(QK, (float*)(ws + WS_KNMAX), bh, (LAS float*)L, tid); } }
    }
    SEAM(4);
    if (IN(5)) {
#if FAST_ATTN
        fa::phase(P, L);
#endif
    }
    SEAM(5);
    if (IN(6)) {
        pg8::Gemm g{AO, (const bf16_t*)(ws + WS_WOUT), TP, D, D}; LiveOrder S; S.init(D, G, (int)blockIdx.x);
        PgResid E{EpiResid{&P, 0, 1.0f, nullptr, HB, HB}, ssq + (size_t)2 * TP};
        pg8::gemm_phase<PgResid, LiveOrder, true, true>(L, g, S, E);
    }
    SEAM(6);
    if (IN(7)) {
        pg8::Gemm g{HB, (const bf16_t*)(ws + WS_WGU2), TP, NGU, D}; LiveOrder S; S.init(NGU, G, (int)blockIdx.x);
        PgSwiglu E{ssq + (size_t)2 * TP, ACT};
        pg8::gemm_phase<PgSwiglu, LiveOrder, true, true>(L, g, S, E);
    }
    SEAM(7);
    if (IN(8)) {
        pg8::Gemm g{ACT, (const bf16_t*)(ws + WS_WD2), TP, D, DFF}; LiveOrder S; S.init(D, G, (int)blockIdx.x);
        PgResid E{EpiResid{&P, 0, 0.5f, H, nullptr, HB}, ssq + (size_t)3 * TP};
        pg8::gemm_phase<PgResid, LiveOrder, true, true>(L, g, S, E);
    }
    SEAM(8);
    if (IN(9)) final_norm_rows(P, gw, NGW, lane);
#undef IN
#undef SEAM
}

extern "C" void kernel_launch(void* const* d_in, const int* in_sizes, int n_in, void* d_out, int out_size, void* d_ws, size_t ws_size, hipStream_t stream) {
    if (n_in != 18 || out_size != BATCH * SEQ * D || ws_size < WS_END) { fprintf(stderr, "kernel_launch: unexpected shapes (n_in %d out %d ws %zu need %zu)\n", n_in, out_size, ws_size, (size_t)WS_END); return; }
    static int grid = 0;
    if (grid == 0) {
        int dev = 0, cus = 0, per_cu = 0;
        (void)hipGetDevice(&dev); (void)hipDeviceGetAttribute(&cus, hipDeviceAttributeMultiprocessorCount, dev);
        (void)hipFuncSetAttribute((const void*)mk, hipFuncAttributeMaxDynamicSharedMemorySize, LDS_BYTES);
        (void)hipOccupancyMaxActiveBlocksPerMultiprocessor(&per_cu, (const void*)mk, 512, LDS_BYTES);
        if (per_cu < 1) { fprintf(stderr, "kernel_launch: occupancy query says %d blocks per CU\n", per_cu); per_cu = 1; }
        grid = cus * per_cu;
    }
    Params P{};
    for (int i = 0; i < 18; ++i) P.in[i] = (const float*)d_in[i];
    P.out = (float*)d_out; P.ws = (unsigned char*)d_ws;
#if MK_PER_PHASE
    for (int ph = 0; ph < N_PHASES; ++ph) { P.ph_lo = ph; P.ph_hi = ph + 1;
        if (ph == 5 && !FAST_ATTN) { hipLaunchKernelGGL(naive_attn<true>, dim3(LP / 64, 4, BATCH), dim3(256), 0, stream, P); hipLaunchKernelGGL(naive_attn<false>, dim3(LP / 128, 8, BATCH), dim3(256), 0, stream, P); continue; }
        hipLaunchKernelGGL(mk, dim3(grid), dim3(512), LDS_BYTES, stream, P); }
#else
    P.ph_lo = 0; P.ph_hi = N_PHASES;
    if (hipMemsetAsync((unsigned char*)d_ws + WS_XBAR, 0, XCD_BAR_WORDS * 4, stream) != hipSuccess) { fprintf(stderr, "kernel_launch: memset of the barrier words failed\n"); return; }
    void* args[] = {&P};
    hipError_t e = hipLaunchCooperativeKernel((const void*)mk, dim3(grid), dim3(512), args, LDS_BYTES, stream);
    if (e != hipSuccess) fprintf(stderr, "cooperative launch failed: %s (grid %d)\n", hipGetErrorString(e), grid);
#endif
}
```

```cpp
#include <hip/hip_runtime.h>
#include <hip/hip_cooperative_groups.h>
namespace cg = cooperative_groups;
#include <cstdio>
#include <cstdint>

typedef unsigned short bf16_t;
typedef unsigned u32x4 __attribute__((ext_vector_type(4)));
typedef float f32x4 __attribute__((ext_vector_type(4)));
#define LAS __attribute__((address_space(3)))

constexpr int D = 1024, BATCH = 4, SEQ = 8192, NMETA = 16, NPAD = 240, REAL0 = 256, LP = 8448, TP = BATCH * LP;
constexpr int DFF = 2816, NGU = 2 * DFF, NIN = 3080, NINP = 3328;
constexpr int QKW = 2048;
constexpr float RMS_EPS = 1e-6f, SUBLN_EPS = 1e-5f, LAMBDA_INIT = 0.2f;
constexpr float QSCALE = 0.18033688011112042f;
constexpr float LOG2E = 1.4426950408889634f;
constexpr float NEGBIG = -1e30f;

constexpr size_t MiB = 1u << 20;
constexpr size_t WS_CTL = 0;
constexpr size_t WS_AT0 = 64 * 1024, WS_ACTT = 128 * 1024, WS_H1T = 320 * 1024, WS_SSQM = 384 * 1024;
constexpr size_t WS_SSQ = 1 * MiB;
constexpr size_t WS_LOGF = 4 * MiB;
constexpr size_t WS_CUM = 6 * MiB;
constexpr size_t WS_ROPE = 8 * MiB;
constexpr size_t WS_WGU1 = 9 * MiB, WS_WD1 = 20 * MiB, WS_WIN = 26 * MiB, WS_WOUT = 33 * MiB, WS_WGU2 = 35 * MiB, WS_WD2 = 46 * MiB;
constexpr size_t WS_H = 52 * MiB;
constexpr size_t WS_AO = 184 * MiB;
constexpr size_t WS_BIG = 250 * MiB;
constexpr size_t WS_VT = WS_BIG + 132 * MiB;
constexpr size_t WS_END = WS_BIG + 198 * MiB;

struct Params {
    const float* in[18];
    float* out; unsigned char* ws;
    int ph_lo, ph_hi;
};

__device__ __forceinline__ unsigned f2bf(float f) { unsigned u = __float_as_uint(f); return (u + 0x7fffu + ((u >> 16) & 1u)) >> 16; }
__device__ __forceinline__ unsigned pk2(float lo, float hi) { return f2bf(lo) | (f2bf(hi) << 16); }
__device__ __forceinline__ float bf2f(unsigned short b) { return __uint_as_float(((unsigned)b) << 16); }
__device__ __forceinline__ float bflo(unsigned w) { return __uint_as_float(w << 16); }
__device__ __forceinline__ float bfhi(unsigned w) { return __uint_as_float(w & 0xffff0000u); }
__device__ __forceinline__ float wave_sum(float v) {
#pragma unroll
    for (int o = 1; o < 64; o <<= 1) v += __shfl_xor(v, o);
    return v;
}
struct F8 { float v[8]; };

__device__ __forceinline__ void wconv_item(const float* W, const float* gvec, int K, int N, bf16_t* WT, int mode, LAS float* scr, int item, int nblk, int lane) {
    const int kb = item / nblk, nb = item % nblk, k0 = 64 * kb, n0 = 64 * nb;
    const int nl = 4 * (lane & 15);
    const int ng = n0 + nl;
    int sc; if (mode == 1) { const int pn = ng >> 8, w = ng & 255, bj = w >> 7, c = w & 127; sc = bj * DFF + 128 * pn + c; } else sc = ng;
    const bool valid = (mode != 2) || (ng < NIN);
#pragma unroll 8
    for (int i = 0; i < 16; ++i) { const int kk = 4 * i + (lane >> 4);
        f32x4 w = valid ? *(const f32x4*)(W + (size_t)(k0 + kk) * N + sc) : (f32x4){0.f, 0.f, 0.f, 0.f};
        if (gvec) { const int kx = k0 + kk; const float gs = (mode == 3) ? (kx < 512 ? gvec[kx & 127] * (1.0f - LAMBDA_INIT) : 1.0f) : gvec[kx]; w.x *= gs; w.y *= gs; w.z *= gs; w.w *= gs; }
        *(LAS f32x4*)(scr + kk * 68 + nl) = w; }
    asm volatile("s_waitcnt lgkmcnt(0)" ::: "memory");
    const int c = lane & 7;
#pragma unroll
    for (int j = 0; j < 8; ++j) { const int n = (lane >> 3) + 8 * j; const LAS float* sp = scr + (8 * c) * 68 + n;
        u32x4 o; o.x = pk2(sp[0 * 68], sp[1 * 68]); o.y = pk2(sp[2 * 68], sp[3 * 68]); o.z = pk2(sp[4 * 68], sp[5 * 68]); o.w = pk2(sp[6 * 68], sp[7 * 68]);
        *(u32x4*)(WT + (size_t)(n0 + n) * K + k0 + 8 * c) = o; }
    asm volatile("s_waitcnt lgkmcnt(0)" ::: "memory");
}

__device__ __forceinline__ const float* h0_row(const Params& P, int row) {
    const int b = row / LP, p = row % LP;
    if (p < NPAD) return nullptr;
    if (p < NPAD + NMETA) return P.in[1] + (size_t)(p - NPAD) * D;
    return P.in[0] + ((size_t)b * SEQ + (p - REAL0)) * D;
}

__device__ __forceinline__ void p0_prologue(const Params& P, LAS float* scr_wave, int gw, int NGW, int lane) {
    unsigned char* ws = P.ws;
    constexpr int I_GU = 16 * (NGU / 64), I_D = (DFF / 64) * (D / 64), I_IN = 16 * (NINP / 64), I_OUT = 16 * (D / 64);
    constexpr int NITEMS = 2 * I_GU + 2 * I_D + I_IN + I_OUT;
    for (int it = gw; it < NITEMS; it += NGW) {
        int r = it;
        if (r < I_GU) { wconv_item(P.in[3], P.in[2], D, NGU, (bf16_t*)(ws + WS_WGU1), 1, scr_wave, r, NGU / 64, lane); continue; } r -= I_GU;
        if (r < I_GU) { wconv_item(P.in[15], P.in[14], D, NGU, (bf16_t*)(ws + WS_WGU2), 1, scr_wave, r, NGU / 64, lane); continue; } r -= I_GU;
        if (r < I_D) { wconv_item(P.in[4], nullptr, DFF, D, (bf16_t*)(ws + WS_WD1), 0, scr_wave, r, D / 64, lane); continue; } r -= I_D;
        if (r < I_D) { wconv_item(P.in[16], nullptr, DFF, D, (bf16_t*)(ws + WS_WD2), 0, scr_wave, r, D / 64, lane); continue; } r -= I_D;
        if (r < I_IN) { wconv_item(P.in[6], P.in[5], D, NIN, (bf16_t*)(ws + WS_WIN), 2, scr_wave, r, NINP / 64, lane); continue; } r -= I_IN;
        wconv_item(P.in[13], P.in[12], D, D, (bf16_t*)(ws + WS_WOUT), 3, scr_wave, r, D / 64, lane);
    }
    float* ssq = (float*)(ws + WS_SSQ);
    bf16_t* HB = (bf16_t*)P.out;
    for (int row = gw; row < TP; row += 2 * NGW) {
        const int row2 = row + NGW; const bool has2 = row2 < TP;
        const float* src = h0_row(P, row); const float* src2 = has2 ? h0_row(P, row2) : nullptr;
        f32x4 v[4], u[4]; float s = 0.f, s2 = 0.f;
#pragma unroll
        for (int j = 0; j < 4; ++j) { v[j] = src ? *((const f32x4*)src + lane + 64 * j) : (f32x4){0.f, 0.f, 0.f, 0.f}; u[j] = src2 ? *((const f32x4*)src2 + lane + 64 * j) : (f32x4){0.f, 0.f, 0.f, 0.f}; }
#pragma unroll
        for (int j = 0; j < 4; ++j) { s += (v[j].x * v[j].x + v[j].y * v[j].y) + (v[j].z * v[j].z + v[j].w * v[j].w); s2 += (u[j].x * u[j].x + u[j].y * u[j].y) + (u[j].z * u[j].z + u[j].w * u[j].w); }
        s = wave_sum(s); s2 = wave_sum(s2);
        unsigned long long* o8 = (unsigned long long*)(HB + (size_t)row * D) + lane;
#pragma unroll
        for (int j = 0; j < 4; ++j) o8[64 * j] = (unsigned long long)pk2(v[j].x, v[j].y) | ((unsigned long long)pk2(v[j].z, v[j].w) << 32);
        if (lane < 4) ssq[(size_t)lane * TP + row] = (lane == 0) ? s : 0.f;
        if (has2) {
            unsigned long long* p8 = (unsigned long long*)(HB + (size_t)row2 * D) + lane;
#pragma unroll
            for (int j = 0; j < 4; ++j) p8[64 * j] = (unsigned long long)pk2(u[j].x, u[j].y) | ((unsigned long long)pk2(u[j].z, u[j].w) << 32);
            if (lane < 4) ssq[(size_t)lane * TP + row2] = (lane == 0) ? s2 : 0.f;
        }
    }
    float* rope = (float*)(ws + WS_ROPE);
    for (int e = gw * 64 + lane; e < (NMETA + SEQ) * 8; e += NGW * 64) {
        const int pos = e >> 3, i = e & 7;
        const double invf = (i == 0) ? 1.0 : (i == 1) ? 0.19392274474868576 : (i == 2) ? 0.03760603093086393 : (i == 3) ? 0.007292664737217109 :
                            (i == 4) ? 0.001414213562373095 : (i == 5) ? 0.0002742481756762073 : (i == 6) ? 5.318295896944988e-05 : 1.031338537721246e-05;
        double rev = (double)pos * invf * 0.15915494309189535; rev -= floor(rev);
        const float rf = (float)rev;
        rope[2 * e] = __builtin_amdgcn_cosf(rf); rope[2 * e + 1] = __builtin_amdgcn_sinf(rf);
    }
    if (gw >= 8 && gw < 8 + NMETA) {
        const int r = gw - 8; const float* src = P.in[1] + (size_t)r * D; const float* g1 = P.in[2]; float* AT0 = (float*)(ws + WS_AT0);
        float v[16]; float sq = 0.f;
#pragma unroll
        for (int j = 0; j < 16; ++j) { v[j] = src[lane + 64 * j]; sq += v[j] * v[j]; }
        const float rs = rsqrtf(wave_sum(sq) * (1.0f / D) + RMS_EPS);
#pragma unroll
        for (int j = 0; j < 16; ++j) { const int k = lane + 64 * j; AT0[k * 16 + r] = v[j] * rs * g1[k]; }
        if (lane == 0) ((float*)(ws + WS_SSQM))[r] = 0.f;
    }
    if (gw == 0) {
        const float a = wave_sum(P.in[8][lane] * P.in[9][lane]), b = wave_sum(P.in[10][lane] * P.in[11][lane]);
        if (lane == 0) { ((float*)(ws + WS_CTL))[0] = expf(a) - expf(b) + LAMBDA_INIT; ((unsigned*)(ws + WS_CTL))[16] = 0u; }
        if (lane < 8) ((unsigned*)(ws + WS_CTL))[64 + 64 * lane] = 0u;
    }
}

__device__ __forceinline__ void zero_pad_kv(unsigned char* ws, int gw, int NGW, int lane) {
    {
        float* logf = (float*)(ws + WS_LOGF); bf16_t* QKz = (bf16_t*)(ws + WS_BIG); bf16_t* VTz = (bf16_t*)(ws + WS_VT);
        for (int e = gw * 64 + lane; e < BATCH * NPAD * 8; e += NGW * 64) { const int b = e / (NPAD * 8), o = e % (NPAD * 8); logf[(size_t)b * LP * 8 + o] = 0.f; }
        for (int e = gw * 64 + lane; e < BATCH * 48 * (QKW / 8); e += NGW * 64) { const int b = e / (48 * (QKW / 8)), o = e % (48 * (QKW / 8)); *(u32x4*)(QKz + ((size_t)b * LP + 192) * QKW + (size_t)o * 8) = (u32x4){0u, 0u, 0u, 0u}; }
        for (int e = gw * 64 + lane; e < BATCH * 1024 * 6; e += NGW * 64) { const int bv = e / 6, o = e % 6; *(u32x4*)(VTz + (size_t)bv * LP + 192 + o * 8) = (u32x4){0u, 0u, 0u, 0u}; }
    }
}

__device__ __forceinline__ float row_rstd(const float* ssq, int row) { return rsqrtf(ssq[row] * (1.0f / D) + RMS_EPS); }

struct EpiSwiglu {
    const float* ssq; bf16_t* ACT;
    __device__ __forceinline__ void operator()(int row, int col, const F8& v, const F8& w, float rstd) const {
        float a[8];
        const float k1 = -LOG2E * rstd, k2 = rstd * rstd;
#pragma unroll
        for (int j = 0; j < 8; ++j) a[j] = (v.v[j] * w.v[j]) * (k2 * __builtin_amdgcn_rcpf(1.f + __builtin_amdgcn_exp2f(v.v[j] * k1)));
        u32x4 o; o.x = pk2(a[0], a[1]); o.y = pk2(a[2], a[3]); o.z = pk2(a[4], a[5]); o.w = pk2(a[6], a[7]);
        *(u32x4*)(ACT + (size_t)row * DFF + col) = o;
    }
};
struct EpiResid {
    const Params* P; int from_x; float scale; float* H; bf16_t* HB; const bf16_t* HBin;
    __device__ __forceinline__ F8 load(int row, int col) const {
        F8 r;
        if (from_x) { const float* src = h0_row(*P, row); f32x4 b0 = {0.f, 0.f, 0.f, 0.f}, b1 = b0; if (src) { b0 = *(const f32x4*)(src + col); b1 = *(const f32x4*)(src + col + 4); }
            r.v[0] = b0.x; r.v[1] = b0.y; r.v[2] = b0.z; r.v[3] = b0.w; r.v[4] = b1.x; r.v[5] = b1.y; r.v[6] = b1.z; r.v[7] = b1.w; }
        else { const u32x4 w = *(const u32x4*)(HBin + (size_t)row * D + col);
            r.v[0] = bflo(w.x); r.v[1] = bfhi(w.x); r.v[2] = bflo(w.y); r.v[3] = bfhi(w.y); r.v[4] = bflo(w.z); r.v[5] = bfhi(w.z); r.v[6] = bflo(w.w); r.v[7] = bfhi(w.w); }
        return r;
    }
    __device__ __forceinline__ float finish(int row, int col, const F8& v, const F8& bs) const {
        f32x4 h0 = {bs.v[0] + scale * v.v[0], bs.v[1] + scale * v.v[1], bs.v[2] + scale * v.v[2], bs.v[3] + scale * v.v[3]};
        f32x4 h1 = {bs.v[4] + scale * v.v[4], bs.v[5] + scale * v.v[5], bs.v[6] + scale * v.v[6], bs.v[7] + scale * v.v[7]};
        if (H) { *(f32x4*)(H + (size_t)row * D + col) = h0; *(f32x4*)(H + (size_t)row * D + col + 4) = h1; }
        if (HB) { u32x4 o; o.x = pk2(h0.x, h0.y); o.y = pk2(h0.z, h0.w); o.z = pk2(h1.x, h1.y); o.w = pk2(h1.z, h1.w); *(u32x4*)(HB + (size_t)row * D + col) = o; }
        return (h0.x * h0.x + h0.y * h0.y) + (h0.z * h0.z + h0.w * h0.w) + (h1.x * h1.x + h1.y * h1.y) + (h1.z * h1.z + h1.w * h1.w);
    }
    __device__ __forceinline__ float operator()(int row, int col, const F8& v) const { return finish(row, col, v, load(row, col)); }
};
struct EpiInproj {
    const float* rope; const float* bforget; bf16_t* QK; bf16_t* VT; float* logf;
    __device__ __forceinline__ void qk_rope(int row, int col, const F8& v, const F8& w, const f32x4 (&cs4)[4]) const {
        const int d = col & 63; float a[8];
#pragma unroll
        for (int j = 0; j < 8; ++j) a[j] = v.v[j];
        if (d < 16) {
#pragma unroll
            for (int j = 0; j < 8; ++j) { const float c = cs4[j >> 1][2 * (j & 1)], sn = cs4[j >> 1][2 * (j & 1) + 1]; a[j] = (d < 8) ? v.v[j] * c - w.v[j] * sn : v.v[j] * c + w.v[j] * sn; }
        }
        if (col < 512) {
#pragma unroll
            for (int j = 0; j < 8; ++j) a[j] *= QSCALE;
        }
        u32x4 o; o.x = pk2(a[0], a[1]); o.y = pk2(a[2], a[3]); o.z = pk2(a[4], a[5]); o.w = pk2(a[6], a[7]);
        *(u32x4*)(QK + (size_t)row * QKW + col) = o;
    }
    __device__ __forceinline__ void operator()(int row, int col, const F8& v, const F8& w) const {
        const int b = row / LP, p = row % LP;
        if (col < 1024 || (col >= 1536 && col < 2560)) {
            float a[8]; int dst;
#pragma unroll
            for (int j = 0; j < 8; ++j) a[j] = v.v[j];
            if (col < 1024) {
                const int d = col & 63;
                if (d < 16 && p >= NPAD) {
                    const float* cs = rope + (size_t)(p - NPAD) * 16;
#pragma unroll
                    for (int j = 0; j < 8; ++j) { const float c = cs[2 * j], s = cs[2 * j + 1]; a[j] = (d < 8) ? v.v[j] * c - w.v[j] * s : v.v[j] * c + w.v[j] * s; }
                }
                if (col < 512) {
#pragma unroll
                    for (int j = 0; j < 8; ++j) a[j] *= QSCALE;
                }
                dst = col;
            } else {
                if (col < 2048) {
#pragma unroll
                    for (int j = 0; j < 8; ++j) a[j] *= QSCALE;
                }
                dst = col - 512;
            }
            u32x4 o; o.x = pk2(a[0], a[1]); o.y = pk2(a[2], a[3]); o.z = pk2(a[4], a[5]); o.w = pk2(a[6], a[7]);
            *(u32x4*)(QK + (size_t)row * QKW + dst) = o;
        } else if (col < 3072) {
            const int vcol = (col < 1536) ? col - 1024 : col - 2560 + 512;
            bf16_t* dstp = VT + ((size_t)b * 1024 + vcol) * LP + p;
#pragma unroll
            for (int j = 0; j < 8; ++j) dstp[(size_t)j * LP] = (bf16_t)f2bf(v.v[j]);
        } else if (col == 3072) {
            f32x4 o0, o1; float r[8];
#pragma unroll
            for (int j = 0; j < 8; ++j) { const float x = v.v[j] + bforget[j]; r[j] = (p >= NPAD) ? (fminf(x, 0.f) - log1pf(__expf(-fabsf(x)))) : 0.f; }
            o0 = (f32x4){r[0], r[1], r[2], r[3]}; o1 = (f32x4){r[4], r[5], r[6], r[7]};
            *(f32x4*)(logf + (size_t)row * 8) = o0; *(f32x4*)(logf + (size_t)row * 8 + 4) = o1;
        }
    }
};

template <int MODE  >
__global__ void __launch_bounds__(256) naive_gemm(Params P, const bf16_t* A, const bf16_t* Bt, int K, int norm_in, int norm_out, int from_x, float scale, int writeHB) {
    const int row = blockIdx.x * 256 + threadIdx.x;
    const int c16 = blockIdx.y * 16;
    int n0;
    if (MODE == 0) { const int pn = c16 >> 7, c = c16 & 127; n0 = pn * 256 + c; } else n0 = c16;
    constexpr int NACC = (MODE == 0) ? 32 : 16;
    float acc[NACC];
#pragma unroll
    for (int i = 0; i < NACC; ++i) acc[i] = 0.f;
    const bf16_t* ap = A + (size_t)row * K;
    for (int k = 0; k < K; k += 8) {
        const u32x4 av = *(const u32x4*)(ap + k);
        float a[8] = {bflo(av.x), bfhi(av.x), bflo(av.y), bfhi(av.y), bflo(av.z), bfhi(av.z), bflo(av.w), bfhi(av.w)};
#pragma unroll
        for (int i = 0; i < NACC; ++i) {
            const int n = n0 + (i & 15) + ((i >> 4) << 7);
            const u32x4 bv = *(const u32x4*)(Bt + (size_t)n * K + k);
            acc[i] += a[0] * bflo(bv.x) + a[1] * bfhi(bv.x) + a[2] * bflo(bv.y) + a[3] * bfhi(bv.y) + a[4] * bflo(bv.z) + a[5] * bfhi(bv.z) + a[6] * bflo(bv.w) + a[7] * bfhi(bv.w);
        }
    }
    float* ssq = (float*)(P.ws + WS_SSQ);
    if (MODE == 0) {
        const float rstd = row_rstd(ssq + (size_t)norm_in * TP, row);
        EpiSwiglu E{nullptr, (bf16_t*)(P.ws + WS_BIG)};
        F8 g0, g1, u0, u1;
#pragma unroll
        for (int j = 0; j < 8; ++j) { g0.v[j] = acc[j]; g1.v[j] = acc[8 + j]; u0.v[j] = acc[16 + j]; u1.v[j] = acc[24 + j]; }
        E(row, c16, g0, u0, rstd); E(row, c16 + 8, g1, u1, rstd);
    } else if (MODE == 1) {
        EpiResid E{&P, from_x, scale, (float*)(P.ws + WS_H), writeHB ? (bf16_t*)P.out : nullptr};
        F8 v0, v1;
#pragma unroll
        for (int j = 0; j < 8; ++j) { v0.v[j] = acc[j]; v1.v[j] = acc[8 + j]; }
        const float s = E(row, c16, v0) + E(row, c16 + 8, v1);
        atomicAdd(ssq + (size_t)norm_out * TP + row, s);
    } else {
        const float rstd = row_rstd(ssq + (size_t)norm_in * TP, row);
        EpiInproj E{(const float*)(P.ws + WS_ROPE), P.in[7], (bf16_t*)(P.ws + WS_BIG), (bf16_t*)(P.ws + WS_VT), (float*)(P.ws + WS_LOGF)};
        F8 v0, v1;
#pragma unroll
        for (int j = 0; j < 8; ++j) { v0.v[j] = acc[j] * rstd; v1.v[j] = acc[8 + j] * rstd; }
        E(row, c16, v0, v1); E(row, c16 + 8, v1, v0);
    }
}

constexpr size_t WS_KNMAX = 448 * 1024;
__device__ __forceinline__ void key_norm_max(const bf16_t* QK, float* knmax, int bh, LAS float* sh, int tid) {
    const int b = bh >> 3, h = bh & 7; float mx = 0.f;
    for (int p = NPAD + tid; p < LP; p += 512) { const bf16_t* kr = QK + ((size_t)b * LP + p) * QKW + 1536 + h * 64; float q = 0.f;
#pragma unroll
        for (int i = 0; i < 8; ++i) { const u32x4 w = *(const u32x4*)(kr + 8 * i); const float a0 = bflo(w.x), a1 = bfhi(w.x), a2 = bflo(w.y), a3 = bfhi(w.y), a4 = bflo(w.z), a5 = bfhi(w.z), a6 = bflo(w.w), a7 = bfhi(w.w);
            q += (a0 * a0 + a1 * a1) + (a2 * a2 + a3 * a3) + (a4 * a4 + a5 * a5) + (a6 * a6 + a7 * a7); }
        mx = fmaxf(mx, q); }
#pragma unroll
    for (int o = 1; o < 64; o <<= 1) mx = fmaxf(mx, __shfl_xor(mx, o));
    if ((tid & 63) == 0) sh[tid >> 6] = mx;
    __syncthreads();
    if (tid == 0) { float m = sh[0]; for (int i = 1; i < 8; ++i) m = fmaxf(m, sh[i]); knmax[bh] = sqrtf(m); }
    __syncthreads();
}
__device__ __forceinline__ void cum_scan_seq(const float* logf, float* cum, int bh, LAS float* sh  , int tid) {
    const int b = bh >> 3, h = bh & 7;
    constexpr int PER = 17;
    const int p0 = tid * PER;
    float v[PER]; float s = 0.f;
#pragma unroll
    for (int i = 0; i < PER; ++i) { const int p = p0 + i; v[i] = (p < LP) ? logf[((size_t)b * LP + p) * 8 + h] : 0.f; s += v[i]; v[i] = s; }
    sh[tid] = s;
    __syncthreads();
    for (int off = 1; off < 512; off <<= 1) {
        const float t = (tid >= off) ? sh[tid - off] : 0.f;
        __syncthreads();
        sh[tid] += t;
        __syncthreads();
    }
    const float base = sh[tid] - s;
#pragma unroll
    for (int i = 0; i < PER; ++i) { const int p = p0 + i; if (p < LP) cum[((size_t)b * 8 + h) * LP + p] = (base + v[i]) * LOG2E; }
    __syncthreads();
}

__device__ __forceinline__ void final_norm_rows(const Params& P, int gw, int NGW, int lane) {
    const float* H = (const float*)(P.ws + WS_H); const float* ssq = (const float*)(P.ws + WS_SSQ) + (size_t)3 * TP; const float* g = P.in[17];
    f32x4 gv[4];
#pragma unroll
    for (int j = 0; j < 4; ++j) gv[j] = *((const f32x4*)g + lane + 64 * j);
    for (int t = gw; t < BATCH * SEQ; t += 2 * NGW) {
        const int t2 = t + NGW; const bool has2 = t2 < BATCH * SEQ;
        const int row = (t / SEQ) * LP + REAL0 + (t % SEQ), row2 = has2 ? (t2 / SEQ) * LP + REAL0 + (t2 % SEQ) : row;
        const float rstd = rsqrtf(ssq[row] * (1.0f / D) + RMS_EPS), rstd2 = rsqrtf(ssq[row2] * (1.0f / D) + RMS_EPS);
        const f32x4* hr = (const f32x4*)(H + (size_t)row * D) + lane; const f32x4* hr2 = (const f32x4*)(H + (size_t)row2 * D) + lane;
        f32x4 hv[4], hw[4];
#pragma unroll
        for (int j = 0; j < 4; ++j) { hv[j] = hr[64 * j]; hw[j] = hr2[64 * j]; }
        f32x4* o = (f32x4*)(P.out + (size_t)t * D) + lane;
#pragma unroll
        for (int j = 0; j < 4; ++j) o[64 * j] = (f32x4){hv[j].x * rstd * gv[j].x, hv[j].y * rstd * gv[j].y, hv[j].z * rstd * gv[j].z, hv[j].w * rstd * gv[j].w};
        if (has2) { f32x4* o2 = (f32x4*)(P.out + (size_t)t2 * D) + lane;
#pragma unroll
            for (int j = 0; j < 4; ++j) o2[64 * j] = (f32x4){hw[j].x * rstd2 * gv[j].x, hw[j].y * rstd2 * gv[j].y, hw[j].z * rstd2 * gv[j].z, hw[j].w * rstd2 * gv[j].w}; }
    }
}

template <bool DIFF>
__device__ __forceinline__ void naive_attn_body(const Params& P, int tid, int bx, int h, int b) {
    constexpr int NS = DIFF ? 4 : 2, RPB = 256 / NS;
    const int ql = tid / NS, sub = tid % NS;
    const int pq = bx * RPB + ql;
    const size_t row = (size_t)b * LP + pq;
    const bf16_t* QK = (const bf16_t*)(P.ws + WS_BIG); const bf16_t* VT = (const bf16_t*)(P.ws + WS_VT); const float* cum = (const float*)(P.ws + WS_CUM) + ((size_t)b * 8 + h) * LP;
    bf16_t* AO = (bf16_t*)(P.ws + WS_AO);
    const float lam = ((const float*)(P.ws + WS_CTL))[0];
    float res[32];
#pragma unroll
    for (int j = 0; j < 32; ++j) res[j] = 0.f;
    const bool live = pq >= NPAD;
    for (int map = 0; map < (DIFF ? 2 : 1); ++map) {
        const int qcol = DIFF ? h * 128 + map * 64 : 1024 + h * 64, kcol = DIFF ? 512 + h * 128 + map * 64 : 1536 + h * 64;
        const int vcol0 = DIFF ? h * 128 + sub * 32 : 512 + h * 64 + sub * 32;
        float q[64];
#pragma unroll
        for (int i = 0; i < 8; ++i) { const u32x4 w = *(const u32x4*)(QK + row * QKW + qcol + 8 * i);
            q[8 * i] = bflo(w.x); q[8 * i + 1] = bfhi(w.x); q[8 * i + 2] = bflo(w.y); q[8 * i + 3] = bfhi(w.y); q[8 * i + 4] = bflo(w.z); q[8 * i + 5] = bfhi(w.z); q[8 * i + 6] = bflo(w.w); q[8 * i + 7] = bfhi(w.w); }
        const float cq = DIFF ? 0.f : cum[pq];
        float m = NEGBIG, l = 0.f, o[32];
#pragma unroll
        for (int j = 0; j < 32; ++j) o[j] = 0.f;
        if (live) for (int s0 = NPAD; s0 <= pq; s0 += 8) {
            float sc[8]; float gm = NEGBIG;
#pragma unroll
            for (int e = 0; e < 8; ++e) {
                const int s = s0 + e; const bf16_t* kr = QK + ((size_t)b * LP + s) * QKW + kcol; float d = 0.f;
#pragma unroll
                for (int i = 0; i < 8; ++i) { const u32x4 w = *(const u32x4*)(kr + 8 * i);
                    d += q[8 * i] * bflo(w.x) + q[8 * i + 1] * bfhi(w.x) + q[8 * i + 2] * bflo(w.y) + q[8 * i + 3] * bfhi(w.y) + q[8 * i + 4] * bflo(w.z) + q[8 * i + 5] * bfhi(w.z) + q[8 * i + 6] * bflo(w.w) + q[8 * i + 7] * bfhi(w.w); }
                if (!DIFF) d += cq - cum[s];
                sc[e] = (s <= pq) ? d : NEGBIG; gm = fmaxf(gm, sc[e]);
            }
            const float mn = fmaxf(m, gm), f = exp2f(m - mn);
            float pw[8]; float ps = 0.f;
#pragma unroll
            for (int e = 0; e < 8; ++e) { pw[e] = (s0 + e <= pq) ? exp2f(sc[e] - mn) : 0.f; ps += pw[e]; }
            l = l * f + ps; m = mn;
#pragma unroll
            for (int j = 0; j < 32; ++j) { const u32x4 w = *(const u32x4*)(VT + ((size_t)b * 1024 + vcol0 + j) * LP + s0);
                o[j] = o[j] * f + (pw[0] * bflo(w.x) + pw[1] * bfhi(w.x) + pw[2] * bflo(w.y) + pw[3] * bfhi(w.y) + pw[4] * bflo(w.z) + pw[5] * bfhi(w.z) + pw[6] * bflo(w.w) + pw[7] * bfhi(w.w)); }
        }
        const float il = (l > 0.f) ? 1.f / l : 0.f;
        if (DIFF) {
#pragma unroll
            for (int j = 0; j < 32; ++j) res[j] = (map == 0) ? o[j] * il : res[j] - lam * o[j] * il;
        } else {
#pragma unroll
            for (int j = 0; j < 32; ++j) res[j] = o[j] * il;
        }
    }
    if (DIFF) {
        float ss = 0.f;
#pragma unroll
        for (int j = 0; j < 32; ++j) ss += res[j] * res[j];
        ss += __shfl_xor(ss, 1); ss += __shfl_xor(ss, 2);
        const float r = rsqrtf(ss * (1.0f / 128.f) + SUBLN_EPS) * (1.0f - LAMBDA_INIT);
        const float* g = P.in[12] + sub * 32;
#pragma unroll
        for (int j = 0; j < 32; ++j) res[j] = res[j] * r * g[j];
    }
    bf16_t* dst = AO + row * D + (DIFF ? h * 128 + sub * 32 : 512 + h * 64 + sub * 32);
#pragma unroll
    for (int j = 0; j < 4; ++j) { u32x4 o4; o4.x = pk2(res[8 * j], res[8 * j + 1]); o4.y = pk2(res[8 * j + 2], res[8 * j + 3]); o4.z = pk2(res[8 * j + 4], res[8 * j + 5]); o4.w = pk2(res[8 * j + 6], res[8 * j + 7]);
        *(u32x4*)(dst + 8 * j) = live ? o4 : (u32x4){0u, 0u, 0u, 0u}; }
}


namespace pg8 {
#define PG8_LAS __attribute__((address_space(3)))
typedef unsigned short bf16_t;
typedef short bf16x8 __attribute__((ext_vector_type(8)));
typedef float f32x4 __attribute__((ext_vector_type(4)));
typedef unsigned u32x4 __attribute__((ext_vector_type(4)));
constexpr int BM = 256, BK = 64, HALF = 128, HTB = HALF * BK * 2  , STAGE_BYTES = 8 * HTB, NXCD = 8, WGM = 8;

__host__ __device__ __forceinline__ int lds_byte(int r, int c) { const int st = (r >> 4) * 2 + (c >> 5), rr = r & 15, cc = c & 31, ob = rr * 64 + cc * 2; return st * 1024 + (ob ^ (((ob >> 9) & 1) << 5)); }
__host__ __device__ __forceinline__ void stage_rc(int b, int& R, int& C) { const int st = b / 1024, sb = b % 1024, swz = sb ^ (((sb >> 9) & 1) << 5); R = (st >> 1) * 16 + swz / 64; C = (st & 1) * 32 + (swz % 64) / 2; }
__host__ __device__ __forceinline__ int perm32(int rho) { const int n = rho >> 4, i = rho & 15; return 8 * (i >> 2) + 4 * n + (i & 3); }

struct Unit { int pm, pn; };
struct Gemm { const bf16_t* A; const bf16_t* Bt; int M, N, K; };

struct StaticOrder {
    int nM, nN, nwg, G, c;
    __host__ __device__ void init(int M, int N, int G_, int c_) { nM = M / BM; nN = N / BM; nwg = nM * nN; G = G_; c = c_; }
    __host__ __device__ bool next(int i, Unit& u) const {
        const long L = (long)i * G + c; if (L >= nwg) return false;
        int wgid = (int)L; { const int q = nwg / NXCD, r = nwg % NXCD, xcd = wgid % NXCD, off = wgid / NXCD; wgid = (xcd < r ? xcd * (q + 1) : r * (q + 1) + (xcd - r) * q) + off; }
        const int nig = WGM * nN, gid = wgid / nig, fm = gid * WGM, gsz = (nM - fm) < WGM ? (nM - fm) : WGM;
        u.pm = fm + ((wgid % nig) % gsz); u.pn = (wgid % nig) / gsz; return true;
    }
    __device__ __forceinline__ void a_ready(const Unit&) const {}
    __device__ __forceinline__ void done(const Unit&) const {}
};

template <class Epi, class Sched, bool ALIGN_EPI = false, bool SP2 = false>
__device__ __forceinline__ void gemm_phase(PG8_LAS unsigned char* lds, const Gemm g, const Sched& S, const Epi& E) {
    const int tid = threadIdx.x, wid = __builtin_amdgcn_readfirstlane(tid >> 6), lane = tid & 63, wr = wid >> 2, wc = wid & 3, fr = lane & 15, fq = lane >> 4;
    const int K = g.K, nt = K / BK;
    unsigned voffA[2], voffB[2];
#pragma unroll
    for (int i = 0; i < 2; ++i) { int R, C; stage_rc(tid * 16 + i * 8192, R, C); const int Rb = Epi::PERM ? ((R & ~31) + perm32(R & 31)) : R;
        voffA[i] = (unsigned)(R * K + C) * 2u; voffB[i] = (unsigned)(Rb * K + C) * 2u; }
    const size_t kstep = (size_t)(BK * 2);
    const size_t hstep = (size_t)HALF * K * 2;
    const size_t tstep = 2 * hstep;
    const unsigned ldsw = (unsigned)wid * 1024u;
    const int aoff = lds_byte(wr * 64 + fr, fq * 8), boff = lds_byte(wc * 32 + fr, fq * 8);
#define PG8_SA(b, h) (((b) * 2 + (h)) * HTB)
#define PG8_SB(b, h) ((4 + (b) * 2 + (h)) * HTB)
#define PG8_STAGE(bufoff, gbase, voff) do { _Pragma("unroll") for (int _i = 0; _i < 2; ++_i) \
        __builtin_amdgcn_global_load_lds((const unsigned*)((const char*)(gbase) + (voff)[_i]), (PG8_LAS unsigned*)(lds + (bufoff) + ldsw + _i * 8192), 16, 0, 0); } while (0)
#define PG8_LDA(dst, b, h) do { _Pragma("unroll") for (int m = 0; m < 4; ++m) _Pragma("unroll") for (int k = 0; k < 2; ++k) dst[m][k] = *(const PG8_LAS bf16x8*)(lds + PG8_SA(b, h) + aoff + m * 2048 + k * 1024); } while (0)
#define PG8_LDB(dst, b, h) do { _Pragma("unroll") for (int n = 0; n < 2; ++n) _Pragma("unroll") for (int k = 0; k < 2; ++k) dst[n][k] = *(const PG8_LAS bf16x8*)(lds + PG8_SB(b, h) + boff + n * 2048 + k * 1024); } while (0)
#define PG8_MMA(ai, bj, At, Bt) do { __builtin_amdgcn_s_setprio(1); _Pragma("unroll") for (int m = 0; m < 4; ++m) _Pragma("unroll") for (int n = 0; n < 2; ++n) _Pragma("unroll") for (int k = 0; k < 2; ++k) \
        acc[ai][bj][m][n] = __builtin_amdgcn_mfma_f32_16x16x32_bf16(Bt[n][k], At[m][k], acc[ai][bj][m][n], 0, 0, 0); __builtin_amdgcn_s_setprio(0); } while (0)
#define PG8_WAIT_V(n) asm volatile("s_waitcnt vmcnt(" #n ")" ::: "memory")
#define PG8_WAIT_L(n) asm volatile("s_waitcnt lgkmcnt(" #n ")" ::: "memory")
#define PG8_BAR __builtin_amdgcn_s_barrier()
#define PG8_SCHED __builtin_amdgcn_sched_barrier(0)
    Unit cur, nxt; int ui = 0;
    if (!S.next(0, cur)) return;
    f32x4 acc[2][2][4][2];
#pragma unroll
    for (int a = 0; a < 2; ++a)
#pragma unroll
        for (int b = 0; b < 2; ++b)
#pragma unroll
            for (int m = 0; m < 4; ++m)
#pragma unroll
                for (int n = 0; n < 2; ++n) acc[a][b][m][n] = (f32x4){0.f, 0.f, 0.f, 0.f};
    bf16x8 At[4][2], B0[2][2], B1[2][2];
    const char* cA = (const char*)g.A + (size_t)cur.pm * tstep; const char* cB = (const char*)g.Bt + (size_t)cur.pn * tstep;
    S.a_ready(cur);
    if constexpr (SP2) {
        PG8_STAGE(PG8_SB(0, 0), cB, voffB); PG8_STAGE(PG8_SB(0, 1), cB + hstep, voffB); PG8_STAGE(PG8_SA(0, 0), cA, voffA); PG8_STAGE(PG8_SA(0, 1), cA + hstep, voffA);
        if (wr == 1) PG8_BAR;
        PG8_WAIT_V(2); PG8_BAR;
        PG8_STAGE(PG8_SB(1, 0), cB + kstep, voffB); PG8_STAGE(PG8_SA(1, 0), cA + kstep, voffA); PG8_STAGE(PG8_SB(1, 1), cB + hstep + kstep, voffB);
        PG8_WAIT_V(6); PG8_BAR;
    } else {
        PG8_STAGE(PG8_SB(0, 0), cB, voffB); PG8_STAGE(PG8_SA(0, 0), cA, voffA); PG8_STAGE(PG8_SB(0, 1), cB + hstep, voffB); PG8_STAGE(PG8_SA(0, 1), cA + hstep, voffA);
        if (wr == 1) PG8_BAR;
        PG8_WAIT_V(4); PG8_BAR;
        PG8_STAGE(PG8_SB(1, 0), cB + kstep, voffB); PG8_STAGE(PG8_SA(1, 0), cA + kstep, voffA); PG8_STAGE(PG8_SB(1, 1), cB + hstep + kstep, voffB);
        PG8_WAIT_V(6); PG8_BAR;
    }
    for (;;) {
        const bool has_next = S.next(ui + 1, nxt);
        const char* nA = has_next ? (const char*)g.A + (size_t)nxt.pm * tstep : cA; const char* nB = has_next ? (const char*)g.Bt + (size_t)nxt.pn * tstep : cB;
        for (int t = 0; t < nt; t += 2) {
            const bool last = (t == nt - 2);
            const char* a1 = cA + (size_t)(t + 1) * kstep;
            const char* a2 = last ? nA : cA + (size_t)(t + 2) * kstep; const char* b2 = last ? nB : cB + (size_t)(t + 2) * kstep;
            const char* a3 = a2 + kstep; const char* b3 = b2 + kstep;
            if (last && has_next) S.a_ready(nxt);
            if constexpr (SP2) {
            PG8_LDB(B0, 0, 0); PG8_LDB(B1, 0, 1); PG8_SCHED; PG8_LDA(At, 0, 0); PG8_STAGE(PG8_SA(1, 1), a1 + hstep, voffA);
            PG8_WAIT_V(8); PG8_WAIT_L(0); PG8_BAR; PG8_MMA(0, 0, At, B0); PG8_MMA(0, 1, At, B1); PG8_BAR; PG8_SCHED;
            PG8_LDA(At, 0, 1); PG8_STAGE(PG8_SB(0, 0), b2, voffB); PG8_STAGE(PG8_SB(0, 1), b2 + hstep, voffB); PG8_STAGE(PG8_SA(0, 0), a2, voffA);
            PG8_WAIT_V(8); PG8_WAIT_L(0); PG8_BAR; PG8_MMA(1, 0, At, B0); PG8_MMA(1, 1, At, B1); PG8_BAR; PG8_SCHED;
            PG8_LDB(B0, 1, 0); PG8_LDB(B1, 1, 1); PG8_SCHED; PG8_LDA(At, 1, 0); PG8_STAGE(PG8_SA(0, 1), a2 + hstep, voffA);
            PG8_WAIT_V(8); PG8_WAIT_L(0); PG8_BAR; PG8_MMA(0, 0, At, B0); PG8_MMA(0, 1, At, B1); PG8_BAR; PG8_SCHED;
            PG8_LDA(At, 1, 1); PG8_STAGE(PG8_SB(1, 0), b3, voffB); PG8_STAGE(PG8_SB(1, 1), b3 + hstep, voffB); PG8_STAGE(PG8_SA(1, 0), a3, voffA);
            PG8_WAIT_V(8); PG8_WAIT_L(0); PG8_BAR; PG8_MMA(1, 0, At, B0); PG8_MMA(1, 1, At, B1); PG8_BAR; PG8_SCHED;
            } else {
            PG8_LDB(B0, 0, 0); PG8_SCHED; PG8_LDA(At, 0, 0); PG8_STAGE(PG8_SA(1, 1), a1 + hstep, voffA);
            PG8_WAIT_L(8); PG8_BAR; PG8_WAIT_L(0); PG8_MMA(0, 0, At, B0); PG8_BAR; PG8_SCHED;
            PG8_LDB(B1, 0, 1); PG8_STAGE(PG8_SB(0, 0), b2, voffB);
            PG8_BAR; PG8_WAIT_L(0); PG8_MMA(0, 1, At, B1); PG8_BAR;
            PG8_LDA(At, 0, 1); PG8_STAGE(PG8_SA(0, 0), a2, voffA);
            PG8_BAR; PG8_WAIT_L(0); PG8_MMA(1, 0, At, B0); PG8_BAR; PG8_SCHED;
            PG8_STAGE(PG8_SB(0, 1), b2 + hstep, voffB);
            PG8_WAIT_V(6); PG8_BAR; PG8_MMA(1, 1, At, B1); PG8_BAR;
            PG8_LDB(B0, 1, 0); PG8_SCHED; PG8_LDA(At, 1, 0); PG8_STAGE(PG8_SA(0, 1), a2 + hstep, voffA);
            PG8_WAIT_L(8); PG8_BAR; PG8_WAIT_L(0); PG8_MMA(0, 0, At, B0); PG8_BAR; PG8_SCHED;
            PG8_LDB(B1, 1, 1); PG8_STAGE(PG8_SB(1, 0), b3, voffB);
            PG8_BAR; PG8_WAIT_L(0); PG8_MMA(0, 1, At, B1); PG8_BAR;
            PG8_LDA(At, 1, 1); PG8_STAGE(PG8_SA(1, 0), a3, voffA);
            PG8_BAR; PG8_WAIT_L(0); PG8_MMA(1, 0, At, B0); PG8_BAR; PG8_SCHED;
            PG8_STAGE(PG8_SB(1, 1), b3 + hstep, voffB);
            PG8_WAIT_V(6); PG8_BAR; PG8_MMA(1, 1, At, B1); PG8_BAR;
            }
        }
        if constexpr (ALIGN_EPI) { if (wr == 0) PG8_BAR; }
        if constexpr (!Epi::AFTER_DRAIN) { E(acc, cur, wr, wc, fr, fq); S.done(cur); }
        if (!has_next) break;
#pragma unroll
        for (int a = 0; a < 2; ++a)
#pragma unroll
            for (int b = 0; b < 2; ++b)
#pragma unroll
                for (int m = 0; m < 4; ++m)
#pragma unroll
                    for (int n = 0; n < 2; ++n) acc[a][b][m][n] = (f32x4){0.f, 0.f, 0.f, 0.f};
        cur = nxt; cA = nA; cB = nB; ++ui;
        if constexpr (ALIGN_EPI) { if (wr == 1) PG8_BAR; }
    }
    PG8_WAIT_V(0);
    if constexpr (!ALIGN_EPI) { if (wr == 0) PG8_BAR; }
    PG8_BAR;
    if constexpr (Epi::AFTER_DRAIN) { E.fused(acc, cur, wr, wc, fr, fq, lds, wid, lane); S.done(cur); }
#undef PG8_SA
#undef PG8_SB
#undef PG8_STAGE
#undef PG8_LDA
#undef PG8_LDB
#undef PG8_MMA
#undef PG8_WAIT_V
#undef PG8_WAIT_L
#undef PG8_BAR
#undef PG8_SCHED
}
}


template <int NW>
__device__ __forceinline__ void side16_dot(const float* AT, const float* W, int ldw, int K, const int (&col)[NW], const float* gk, LAS float* red, float (&res)[NW]) {
    const int tid = threadIdx.x, lane = tid & 63, w = tid >> 6, c = lane & 15, kq = lane >> 4;
    float acc[NW][16];
#pragma unroll
    for (int wi = 0; wi < NW; ++wi)
#pragma unroll
        for (int r = 0; r < 16; ++r) acc[wi][r] = 0.f;
    const int ks = K >> 3, kbeg = w * ks;
#pragma unroll 8
    for (int k = kbeg + kq; k < kbeg + ks; k += 4) {
        const f32x4 a0 = *(const f32x4*)(AT + (size_t)k * 16), a1 = *(const f32x4*)(AT + (size_t)k * 16 + 4), a2 = *(const f32x4*)(AT + (size_t)k * 16 + 8), a3 = *(const f32x4*)(AT + (size_t)k * 16 + 12);
        const float gs = gk ? gk[k] : 1.f;
#pragma unroll
        for (int wi = 0; wi < NW; ++wi) { const float wv = (col[wi] >= 0) ? W[(size_t)k * ldw + col[wi]] * gs : 0.f;
            acc[wi][0] += a0.x * wv; acc[wi][1] += a0.y * wv; acc[wi][2] += a0.z * wv; acc[wi][3] += a0.w * wv; acc[wi][4] += a1.x * wv; acc[wi][5] += a1.y * wv; acc[wi][6] += a1.z * wv; acc[wi][7] += a1.w * wv;
            acc[wi][8] += a2.x * wv; acc[wi][9] += a2.y * wv; acc[wi][10] += a2.z * wv; acc[wi][11] += a2.w * wv; acc[wi][12] += a3.x * wv; acc[wi][13] += a3.y * wv; acc[wi][14] += a3.z * wv; acc[wi][15] += a3.w * wv; }
    }
#pragma unroll
    for (int wi = 0; wi < NW; ++wi)
#pragma unroll
        for (int r = 0; r < 16; ++r) { float v = acc[wi][r]; v += __shfl_xor(v, 16); v += __shfl_xor(v, 32); if (kq == 0) red[((wi * 8 + w) * 16 + r) * 16 + c] = v; }
    __syncthreads();
    if (tid < 256) {
#pragma unroll
        for (int wi = 0; wi < NW; ++wi) { float v = 0.f;
#pragma unroll
            for (int ww = 0; ww < 8; ++ww) v += red[(wi * 8 + ww) * 256 + tid];
            res[wi] = v; }
    }
    __syncthreads();
}
__device__ __forceinline__ void side_stage1(const Params& P, LAS float* red, int t) {
    const int tid = threadIdx.x, c = tid & 15;
    const int col[2] = {16 * t + c, DFF + 16 * t + c}; float res[2];
    side16_dot<2>((const float*)(P.ws + WS_AT0), P.in[3], NGU, D, col, nullptr, red, res);
    if (tid < 256) { const int r = tid >> 4, cc = tid & 15; const float g = res[0], u = res[1]; ((float*)(P.ws + WS_ACTT))[(16 * t + cc) * 16 + r] = g * u / (1.f + __expf(-g)); }
}
__device__ __forceinline__ void side_stage2(const Params& P, LAS float* red, int t) {
    const int tid = threadIdx.x, c = tid & 15;
    const int col[1] = {16 * t + c}; float res[1];
    side16_dot<1>((const float*)(P.ws + WS_ACTT), P.in[4], D, DFF, col, nullptr, red, res);
    if (tid < 256) { const int r = tid >> 4, cc = tid & 15, n = 16 * t + cc; const float h1 = P.in[1][(size_t)r * D + n] + 0.5f * res[0];
        ((float*)(P.ws + WS_H1T))[n * 16 + r] = h1;
        float q = h1 * h1; q += __shfl_xor(q, 1); q += __shfl_xor(q, 2); q += __shfl_xor(q, 4); q += __shfl_xor(q, 8);
        if (cc == 0) unsafeAtomicAdd((float*)(P.ws + WS_SSQM) + r, q); }
}
__device__ __forceinline__ void side_stage3(const Params& P, LAS float* red, int t) {
    const int tid = threadIdx.x, c = tid & 15;
    const int kind = (t >= 128) ? 4 : (t >> 5);
    const int n0 = (kind == 0) ? 512 + 16 * t : (kind == 1) ? 1024 + 16 * (t - 32) : (kind == 2) ? 2048 + 16 * (t - 64) : (kind == 3) ? 2560 + 16 * (t - 96) : 3072;
    const int col[1] = {(n0 + c < NIN) ? n0 + c : -1}; float res[1];
    side16_dot<1>((const float*)(P.ws + WS_H1T), P.in[6], NIN, D, col, P.in[5], red, res);
    float v = 0.f; int r = 0, cc = 0;
    if (tid < 256) { r = tid >> 4; cc = tid & 15; v = res[0] * rsqrtf(((const float*)(P.ws + WS_SSQM))[r] * (1.0f / D) + RMS_EPS); red[tid] = v; }
    __syncthreads();
    if (tid < 256) {
        const int n = n0 + cc; const int p = NPAD + r;
        bf16_t* QK = (bf16_t*)(P.ws + WS_BIG); bf16_t* VT = (bf16_t*)(P.ws + WS_VT); float* logf = (float*)(P.ws + WS_LOGF);
        if (kind == 0 || kind == 2) {
            float o = v;
            if (kind == 0 && (n & 63) < 16) { const float pr = red[tid ^ 8]; const float* cs = (const float*)(P.ws + WS_ROPE) + (size_t)r * 16 + 2 * (n & 7);
                o = ((n & 63) < 8) ? v * cs[0] - pr * cs[1] : v * cs[0] + pr * cs[1]; }
            const int dst = (kind == 0) ? n : n - 512;
            for (int b = 0; b < BATCH; ++b) QK[((size_t)b * LP + p) * QKW + dst] = (bf16_t)f2bf(o);
        } else if (kind == 1 || kind == 3) {
            const int vcol = (kind == 1) ? n - 1024 : n - 2560 + 512;
            for (int b = 0; b < BATCH; ++b) VT[((size_t)b * 1024 + vcol) * LP + p] = (bf16_t)f2bf(v);
        } else if (cc < 8) {
            const float x = v + P.in[7][cc]; const float lf = fminf(x, 0.f) - log1pf(__expf(-fabsf(x)));
            for (int b = 0; b < BATCH; ++b) logf[((size_t)b * LP + p) * 8 + cc] = lf;
        }
    }
    __syncthreads();
}


__device__ __forceinline__ void gates_rows(const Params& P, int widx, int nw, int lane) {
    typedef short bf16x8 __attribute__((ext_vector_type(8))); typedef float f32x16 __attribute__((ext_vector_type(16)));
    const bf16_t* HB = (const bf16_t*)P.out; const bf16_t* WG = (const bf16_t*)(P.ws + WS_WIN) + (size_t)3072 * D;
    const float* ssq1 = (const float*)(P.ws + WS_SSQ) + TP; float* logf = (float*)(P.ws + WS_LOGF); const float* bfg = P.in[7];
    const int ql = lane & 31, hi = lane >> 5;
    for (int t = widx; t < 1024; t += nw) {
        const int lt = t >> 3, row0 = (lt + (lt >> 5) + 1) * 256 + (t & 7) * 32;
        const bf16_t* ap = WG + (size_t)ql * D + 8 * hi; const bf16_t* bp = HB + (size_t)(row0 + ql) * D + 8 * hi;
        f32x16 acc;
#pragma unroll
        for (int r = 0; r < 16; ++r) acc[r] = 0.f;
#pragma unroll 16
        for (int ks = 0; ks < 64; ++ks) { const bf16x8 a = *(const bf16x8*)(ap + 16 * ks), b = *(const bf16x8*)(bp + 16 * ks); acc = __builtin_amdgcn_mfma_f32_32x32x16_bf16(a, b, acc, 0, 0, 0); }
        const int row = row0 + ql; const float rstd = row_rstd(ssq1, row);
        f32x4 o;
#pragma unroll
        for (int j = 0; j < 4; ++j) { const float x = acc[j] * rstd + bfg[4 * hi + j]; o[j] = fminf(x, 0.f) - log1pf(__expf(-fabsf(x))); }
        *(f32x4*)(logf + (size_t)row * 8 + 4 * hi) = o;
    }
}

struct LiveOrder {
    pg8::StaticOrder S;
    __device__ void init(int N, int G, int c) { S.init(128 * 256, N, G, c); }
    __device__ bool next(int i, pg8::Unit& u) const { if (!S.next(i, u)) return false; u.pm = u.pm + (u.pm >> 5) + 1; return true; }
    __device__ __forceinline__ void a_ready(const pg8::Unit&) const {}
    __device__ __forceinline__ void done(const pg8::Unit&) const {}
};
__device__ __forceinline__ F8 acc8(const f32x4 (&acc)[2][2][4][2], int ai, int bj, int m) {
    F8 r; const f32x4 a = acc[ai][bj][m][0], b = acc[ai][bj][m][1];
    r.v[0] = a[0]; r.v[1] = a[1]; r.v[2] = a[2]; r.v[3] = a[3]; r.v[4] = b[0]; r.v[5] = b[1]; r.v[6] = b[2]; r.v[7] = b[3]; return r;
}
struct PgSwiglu {
    static constexpr bool PERM = true, AFTER_DRAIN = false;
    const float* ssq_in; bf16_t* ACT;
    __device__ __forceinline__ void operator()(const f32x4 (&acc)[2][2][4][2], const pg8::Unit& u, int wr, int wc, int fr, int fq) const {
        const EpiSwiglu E{nullptr, ACT};
        const int col = u.pn * 128 + wc * 32 + 8 * fq;
        float rs[2][4];
#pragma unroll
        for (int ai = 0; ai < 2; ++ai)
#pragma unroll
            for (int m = 0; m < 4; ++m) rs[ai][m] = ssq_in[u.pm * 256 + ai * 128 + wr * 64 + m * 16 + fr];
#pragma unroll
        for (int ai = 0; ai < 2; ++ai)
#pragma unroll
            for (int m = 0; m < 4; ++m) rs[ai][m] = rsqrtf(rs[ai][m] * (1.0f / D) + RMS_EPS);
#pragma unroll
        for (int ai = 0; ai < 2; ++ai)
#pragma unroll
            for (int m = 0; m < 4; ++m) { const int row = u.pm * 256 + ai * 128 + wr * 64 + m * 16 + fr;
                E(row, col, acc8(acc, ai, 0, m), acc8(acc, ai, 1, m), rs[ai][m]); }
    }
};
struct PgResid {
    static constexpr bool PERM = true, AFTER_DRAIN = false;
    EpiResid E; float* ssq_out;
    __device__ __forceinline__ void operator()(const f32x4 (&acc)[2][2][4][2], const pg8::Unit& u, int wr, int wc, int fr, int fq) const {
#pragma unroll
        for (int ai = 0; ai < 2; ++ai) {
            F8 bs[4][2];
#pragma unroll
            for (int m = 0; m < 4; ++m)
#pragma unroll
                for (int bj = 0; bj < 2; ++bj) bs[m][bj] = E.load(u.pm * 256 + ai * 128 + wr * 64 + m * 16 + fr, u.pn * 256 + bj * 128 + wc * 32 + 8 * fq);
#pragma unroll
            for (int m = 0; m < 4; ++m) { const int row = u.pm * 256 + ai * 128 + wr * 64 + m * 16 + fr; float s = 0.f;
#pragma unroll
                for (int bj = 0; bj < 2; ++bj) s += E.finish(row, u.pn * 256 + bj * 128 + wc * 32 + 8 * fq, acc8(acc, ai, bj, m), bs[m][bj]);
                s += __shfl_xor(s, 16); s += __shfl_xor(s, 32);
                if (fq == 0) unsafeAtomicAdd(ssq_out + row, s); }
        }
    }
};
struct PgInproj {
    static constexpr bool PERM = true, AFTER_DRAIN = false;
    EpiInproj E; const float* ssq_in;
    __device__ __forceinline__ void operator()(const f32x4 (&acc)[2][2][4][2], const pg8::Unit& u, int wr, int wc, int fr, int fq) const {
        const bool rope_tile = u.pn < 4;
        float rs[2][4];
        if (rope_tile) {
            const bool need = ((wc & 1) == 0) && (fq < 2);
            float rr[2][4];
#pragma unroll
            for (int ai = 0; ai < 2; ++ai)
#pragma unroll
                for (int m = 0; m < 4; ++m) rr[ai][m] = ssq_in[u.pm * 256 + ai * 128 + wr * 64 + m * 16 + fr];
#pragma unroll
            for (int ah = 0; ah < 4; ++ah) {
                const int ai = ah >> 1, m0 = (ah & 1) * 2;
                f32x4 cst[2][4];
#pragma unroll
                for (int mm = 0; mm < 2; ++mm) { const int p = (u.pm * 256 + ai * 128 + wr * 64 + (m0 + mm) * 16 + fr) % LP; const f32x4* cp = (const f32x4*)(E.rope + (size_t)(need ? p - NPAD : 0) * 16);
#pragma unroll
                    for (int i = 0; i < 4; ++i) cst[mm][i] = need ? cp[i] : (f32x4){0.f, 0.f, 0.f, 0.f}; }
#pragma unroll
                for (int mm = 0; mm < 2; ++mm) { const int m = m0 + mm; const int row = u.pm * 256 + ai * 128 + wr * 64 + m * 16 + fr; const float rstd = rsqrtf(rr[ai][m] * (1.0f / D) + RMS_EPS);
#pragma unroll
                    for (int bj = 0; bj < 2; ++bj) { F8 v = acc8(acc, ai, bj, m), w;
#pragma unroll
                        for (int j = 0; j < 8; ++j) v.v[j] *= rstd;
#pragma unroll
                        for (int j = 0; j < 8; ++j) w.v[j] = __shfl_xor(v.v[j], 16);
                        E.qk_rope(row, u.pn * 256 + bj * 128 + wc * 32 + 8 * fq, v, w, cst[mm]); } }
            }
            return;
        }
#pragma unroll
        for (int ai = 0; ai < 2; ++ai)
#pragma unroll
            for (int m = 0; m < 4; ++m) rs[ai][m] = ssq_in[u.pm * 256 + ai * 128 + wr * 64 + m * 16 + fr];
#pragma unroll
        for (int ai = 0; ai < 2; ++ai)
#pragma unroll
            for (int m = 0; m < 4; ++m) rs[ai][m] = rsqrtf(rs[ai][m] * (1.0f / D) + RMS_EPS);
#pragma unroll
        for (int ai = 0; ai < 2; ++ai)
#pragma unroll
            for (int m = 0; m < 4; ++m) { const int row = u.pm * 256 + ai * 128 + wr * 64 + m * 16 + fr; const float rstd = rs[ai][m];
#pragma unroll
                for (int bj = 0; bj < 2; ++bj) { F8 v = acc8(acc, ai, bj, m), w;
#pragma unroll
                    for (int j = 0; j < 8; ++j) v.v[j] *= rstd;
                    if (rope_tile) {
#pragma unroll
                        for (int j = 0; j < 8; ++j) w.v[j] = __shfl_xor(v.v[j], 16);
                    } else w = v;
                    E(row, u.pn * 256 + bj * 128 + wc * 32 + 8 * fq, v, w); } }
    }
};


namespace fa {
typedef short bf16x8 __attribute__((ext_vector_type(8)));
typedef float f32x16 __attribute__((ext_vector_type(16)));
typedef unsigned u32x2 __attribute__((ext_vector_type(2)));
typedef float f32x2_t __attribute__((ext_vector_type(2))); typedef __bf16 bf16x2_t __attribute__((ext_vector_type(2)));
__device__ __forceinline__ unsigned cvtpk(float lo, float hi) { f32x2_t v = {lo, hi}; bf16x2_t b = __builtin_convertvector(v, bf16x2_t); return __builtin_bit_cast(unsigned, b); }
constexpr int KS = 272, VS = 272;
constexpr int OFF_K = 0, OFF_V = 128 * KS, OFF_CK = OFF_V + 128 * VS, BUF = OFF_CK + 1024;
constexpr int OFF_X = 0, OFF_UNIT = 2 * BUF;
constexpr int NUNITS = 64 * 32, KT0 = 3;
static_assert(65536 <= BUF && OFF_UNIT + 64 <= 147456, "fa LDS map");
#define FA_MFMA(a, b, c) __builtin_amdgcn_mfma_f32_32x32x16_bf16((a), (b), (c), 0, 0, 0)
__device__ __forceinline__ float max3f(float a, float b, float c) { return __builtin_fmaxf(__builtin_fmaxf(a, b), c); }

template <bool DIFF>
__device__ __forceinline__ void unit(const Params& P, LAS unsigned char* L, int b, int hu, int qb, float lam) {
    constexpr int NDB = DIFF ? 4 : 2;
    const int tid = threadIdx.x, lane = tid & 63, w = __builtin_amdgcn_readfirstlane(tid >> 6), g = w >> 2, wq = w & 3, ql = lane & 31, hi = lane >> 5;
    const bf16_t* QK = (const bf16_t*)(P.ws + WS_BIG); const bf16_t* VT = (const bf16_t*)(P.ws + WS_VT); const float* cum = (const float*)(P.ws + WS_CUM);
    bf16_t* AO = (bf16_t*)(P.ws + WS_AO);
    const int qbw = DIFF ? qb : 2 * qb + g;
    const int st_top = DIFF ? qb : 2 * qb + 1;
    const int qcol = DIFF ? hu * 128 + g * 64 : 1024 + hu * 64;
    const int kcol0 = DIFF ? 512 + hu * 128 : 1536 + hu * 64;
    const int vcol0 = DIFF ? hu * 128 : 512 + hu * 64;
    const int q_abs = 128 * qbw + 32 * wq + ql;
    const size_t qrow = (size_t)b * LP + q_abs;
    bf16x8 qf[4];
#pragma unroll
    for (int ds = 0; ds < 4; ++ds) qf[ds] = *(const bf16x8*)(QK + qrow * QKW + qcol + 16 * ds + 8 * hi);
    const float cq = DIFF ? 0.f : cum[((size_t)b * 8 + hu) * LP + q_abs];
    const bf16_t* kg = DIFF ? QK + ((size_t)b * LP + (tid >> 4)) * QKW + kcol0 + 8 * (tid & 15) : QK + ((size_t)b * LP + (tid >> 3)) * QKW + kcol0 + 8 * (tid & 7);
    const int kl = DIFF ? (tid >> 4) * KS + 16 * (tid & 15) : (tid >> 3) * KS + 16 * (tid & 7);
    const bf16_t* vg = VT + ((size_t)b * 1024 + vcol0 + (tid >> 4)) * LP + 8 * (tid & 15);
    const int vl = (tid >> 4) * VS + 16 * (tid & 15);
    const float* cgp = cum + ((size_t)b * 8 + hu) * LP + (tid & 127);
    u32x4 rk0, rk1, rk2, rk3, rv0, rv1, rv2, rv3; float rc = 0.f;
#define FA_LOAD(st) do { const bf16_t* kp_ = kg + (size_t)(128 * (st)) * QKW; const bf16_t* vp_ = vg + 128 * (st); \
        if (DIFF) { rk0 = *(const u32x4*)(kp_); rk1 = *(const u32x4*)(kp_ + (size_t)32 * QKW); rk2 = *(const u32x4*)(kp_ + (size_t)64 * QKW); rk3 = *(const u32x4*)(kp_ + (size_t)96 * QKW); \
            rv0 = *(const u32x4*)(vp_); rv1 = *(const u32x4*)(vp_ + (size_t)32 * LP); rv2 = *(const u32x4*)(vp_ + (size_t)64 * LP); rv3 = *(const u32x4*)(vp_ + (size_t)96 * LP); } \
        else { rk0 = *(const u32x4*)(kp_); rk1 = *(const u32x4*)(kp_ + (size_t)64 * QKW); rv0 = *(const u32x4*)(vp_); rv1 = *(const u32x4*)(vp_ + (size_t)32 * LP); if (tid < 128) rc = cgp[128 * (st)]; } } while (0)
#define FA_STORE(bo) do { LAS unsigned char* kd_ = L + (bo) + OFF_K + kl; LAS unsigned char* vd_ = L + (bo) + OFF_V + vl; \
        if (DIFF) { *(LAS u32x4*)(kd_) = rk0; *(LAS u32x4*)(kd_ + 32 * KS) = rk1; *(LAS u32x4*)(kd_ + 64 * KS) = rk2; *(LAS u32x4*)(kd_ + 96 * KS) = rk3; \
            *(LAS u32x4*)(vd_) = rv0; *(LAS u32x4*)(vd_ + 32 * VS) = rv1; *(LAS u32x4*)(vd_ + 64 * VS) = rv2; *(LAS u32x4*)(vd_ + 96 * VS) = rv3; } \
        else { *(LAS u32x4*)(kd_) = rk0; *(LAS u32x4*)(kd_ + 64 * KS) = rk1; *(LAS u32x4*)(vd_) = rv0; *(LAS u32x4*)(vd_ + 32 * VS) = rv1; if (tid < 128) *(LAS float*)(L + (bo) + OFF_CK + 4 * tid) = rc; } } while (0)
    const int pim = (ql & 0x13) | ((ql & 4) << 1) | ((ql & 8) >> 1);
    const int ka = pim * KS + ((DIFF ? 64 * g : 0) + 8 * hi) * 2;
    const int va = ql * VS + 16 * hi;
    float m_ref = 0.f, l = 0.f;
    bool first = true;
    f32x16 oacc[NDB];
#pragma unroll
    for (int db = 0; db < NDB; ++db)
#pragma unroll
        for (int r = 0; r < 16; ++r) oacc[db][r] = 0.f;
    f32x16 negm, lacc;
#pragma unroll
    for (int r = 0; r < 16; ++r) { negm[r] = 0.f; lacc[r] = 0.f; }
    bf16x8 onesf;
#pragma unroll
    for (int j = 0; j < 8; ++j) onesf[j] = (ql == 0) ? (short)0x3F80 : (short)0;
    LAS float* qnw = (LAS float*)(L + OFF_UNIT + 16);
    if (!DIFF) {
        float q2 = 0.f;
#pragma unroll
        for (int ds = 0; ds < 4; ++ds) { const u32x4 w = __builtin_bit_cast(u32x4, qf[ds]); const float a0 = bflo(w.x), a1 = bfhi(w.x), a2 = bflo(w.y), a3 = bfhi(w.y), a4 = bflo(w.z), a5 = bfhi(w.z), a6 = bflo(w.w), a7 = bfhi(w.w);
            q2 += (a0 * a0 + a1 * a1) + (a2 * a2 + a3 * a3) + (a4 * a4 + a5 * a5) + (a6 * a6 + a7 * a7); }
        q2 += __shfl_xor(q2, 32);
#pragma unroll
        for (int o = 1; o < 32; o <<= 1) q2 = fmaxf(q2, __shfl_xor(q2, o));
        if (lane == 0) qnw[w] = q2;
    }
    FA_LOAD(st_top); FA_STORE(0);
    __syncthreads();
    asm volatile("" : "+v"(qf[0]), "+v"(qf[1]), "+v"(qf[2]), "+v"(qf[3]));
    float cqp = cq; asm volatile("" : "+v"(cqp));
    int st_end = 0;
    if (!DIFF) {
        float qn2 = qnw[0];
#pragma unroll
        for (int i = 1; i < 8; ++i) qn2 = fmaxf(qn2, qnw[i]);
        const float* cs = cum + ((size_t)b * 8 + hu) * LP;
        const float base = 2.0f * 1.001f * sqrtf(qn2) * ((const float*)(P.ws + WS_KNMAX))[b * 8 + hu] + cs[256 * qb] + 2.0f;
        const int sti = st_top - lane;
        const bool dead = (sti >= 1) && (base - cs[128 * (sti > 0 ? sti : 1) + 127] < -150.0f);
        const unsigned long long mask = __ballot(dead);
        if (mask) st_end = st_top - (int)__builtin_ctzll(mask);
        st_end = __builtin_amdgcn_readfirstlane(st_end);
    }
    int bo = 0;
    for (int st = st_top; st > st_end; --st) {
        if (st - 1 > st_end) FA_LOAD(st - 1);
#pragma unroll
        for (int hh = 1; hh >= 0; --hh) {
        const int k0 = 128 * st + 64 * hh;
        if (k0 + 63 >= NPAD && k0 <= 128 * qbw + 32 * wq + 31) {
            const LAS unsigned char* Kb = L + bo + OFF_K + 64 * hh * KS; const LAS unsigned char* Vb = L + bo + OFF_V + 128 * hh;
            f32x16 s0, s1;
            __builtin_amdgcn_s_setprio(1);
            if (DIFF) {
                const bf16x8 a0 = *(const LAS bf16x8*)(Kb + ka), a1 = *(const LAS bf16x8*)(Kb + ka + 32 * KS);
                s0 = FA_MFMA(a0, qf[0], negm); s1 = FA_MFMA(a1, qf[0], negm);
            } else {
                const float cqm = cqp - m_ref;
                const LAS float* ck = (const LAS float*)(L + bo + OFF_CK) + 64 * hh + 8 * hi;
#pragma unroll
                for (int t = 0; t < 2; ++t) { const f32x4 a = *(const LAS f32x4*)(ck + 16 * t), c = *(const LAS f32x4*)(ck + 16 * t + 4), d = *(const LAS f32x4*)(ck + 32 + 16 * t), e = *(const LAS f32x4*)(ck + 32 + 16 * t + 4);
#pragma unroll
                    for (int j = 0; j < 4; ++j) { s0[8 * t + j] = cqm - a[j]; s0[8 * t + 4 + j] = cqm - c[j]; s1[8 * t + j] = cqm - d[j]; s1[8 * t + 4 + j] = cqm - e[j]; } }
                const bf16x8 a0 = *(const LAS bf16x8*)(Kb + ka), a1 = *(const LAS bf16x8*)(Kb + ka + 32 * KS);
                s0 = FA_MFMA(a0, qf[0], s0); s1 = FA_MFMA(a1, qf[0], s1);
            }
#pragma unroll
            for (int ds = 1; ds < 4; ++ds) { const bf16x8 a0 = *(const LAS bf16x8*)(Kb + ka + 32 * ds), a1 = *(const LAS bf16x8*)(Kb + ka + 32 * KS + 32 * ds);
                s0 = FA_MFMA(a0, qf[ds], s0); s1 = FA_MFMA(a1, qf[ds], s1); }
            __builtin_amdgcn_s_setprio(0);
            if (k0 < NPAD || k0 + 63 > 128 * qbw + 32 * wq) {
#pragma unroll
                for (int r = 0; r < 16; ++r) { const int key = k0 + 16 * (r >> 3) + 8 * hi + (r & 7);
                    if (key > q_abs || key < NPAD) s0[r] = NEGBIG;
                    if (key + 32 > q_abs || key + 32 < NPAD) s1[r] = NEGBIG; }
            }
            float tm = max3f(s0[0], s0[1], s1[0]), tm2 = max3f(s0[2], s0[3], s1[1]); tm = max3f(tm, s1[2], s1[3]);
#pragma unroll
            for (int r = 4; r < 16; r += 4) { tm = max3f(tm, s0[r], s0[r + 1]); tm2 = max3f(tm2, s0[r + 2], s0[r + 3]); tm = max3f(tm, s1[r], s1[r + 1]); tm2 = max3f(tm2, s1[r + 2], s1[r + 3]); }
            tm = fmaxf(tm, tm2);
            { const auto rr = __builtin_amdgcn_permlane32_swap(__float_as_uint(tm), __float_as_uint(tm), false, false); tm = fmaxf(__uint_as_float(rr[0]), __uint_as_float(rr[1])); }
            float tmpost = tm;
            if (first || __any(tm > 8.0f)) {
                const float dl = first ? tm : fmaxf(tm, 0.f);
                m_ref += dl; tmpost = tm - dl;
                if (!first) { const float f = __builtin_amdgcn_exp2f(-dl); l *= f; lacc[0] *= f;
#pragma unroll
                    for (int db = 0; db < NDB; ++db)
#pragma unroll
                        for (int r = 0; r < 16; ++r) oacc[db][r] *= f; }
#pragma unroll
                for (int r = 0; r < 16; ++r) { s0[r] -= dl; s1[r] -= dl; }
                if (DIFF) {
#pragma unroll
                    for (int r = 0; r < 16; ++r) negm[r] = -m_ref;
                }
                first = false;
            }
            if (!__all(tmpost < -150.0f)) {
            float ps = 0.f, ps2 = 0.f;
#pragma unroll
            for (int r = 0; r < 16; ++r) { s0[r] = __builtin_amdgcn_exp2f(s0[r]); s1[r] = __builtin_amdgcn_exp2f(s1[r]); if (DIFF) { ps += s0[r]; ps2 += s1[r]; asm volatile("" : "+v"(ps), "+v"(ps2)); } }
            if (DIFF) l += ps + ps2;
            bf16x8 pb[4];
            { u32x4 t0 = {cvtpk(s0[0], s0[1]), cvtpk(s0[2], s0[3]), cvtpk(s0[4], s0[5]), cvtpk(s0[6], s0[7])}; pb[0] = __builtin_bit_cast(bf16x8, t0);
              u32x4 t1 = {cvtpk(s0[8], s0[9]), cvtpk(s0[10], s0[11]), cvtpk(s0[12], s0[13]), cvtpk(s0[14], s0[15])}; pb[1] = __builtin_bit_cast(bf16x8, t1);
              u32x4 t2 = {cvtpk(s1[0], s1[1]), cvtpk(s1[2], s1[3]), cvtpk(s1[4], s1[5]), cvtpk(s1[6], s1[7])}; pb[2] = __builtin_bit_cast(bf16x8, t2);
              u32x4 t3 = {cvtpk(s1[8], s1[9]), cvtpk(s1[10], s1[11]), cvtpk(s1[12], s1[13]), cvtpk(s1[14], s1[15])}; pb[3] = __builtin_bit_cast(bf16x8, t3); }
            __builtin_amdgcn_s_setprio(1);
#pragma unroll
            for (int ks = 0; ks < 4; ++ks) {
#pragma unroll
                for (int db = 0; db < NDB; ++db) { const bf16x8 av = *(const LAS bf16x8*)(Vb + va + 32 * db * VS + 32 * ks); oacc[db] = FA_MFMA(av, pb[ks], oacc[db]); }
                if (!DIFF) lacc = FA_MFMA(onesf, pb[ks], lacc);
            }
            __builtin_amdgcn_s_setprio(0);
            }
        }
        }
        if (st - 1 > st_end) FA_STORE(bo ^ BUF);
        __syncthreads();
        bo ^= BUF;
    }
#undef FA_LOAD
#undef FA_STORE
    if (DIFF) l += __shfl_xor(l, 32); else l = __shfl(lacc[0], ql);
    const float inv = (q_abs >= NPAD) ? 1.0f / l : 0.f;
    if (DIFF) {
        LAS float* X = (LAS float*)(L + OFF_X);
        if (g == 1) {
#pragma unroll
            for (int db = 0; db < NDB; ++db)
#pragma unroll
                for (int r = 0; r < 16; ++r) X[((wq * 4 + db) * 16 + r) * 64 + lane] = oacc[db][r] * inv;
        }
        __syncthreads();
        if (g == 0) {
            float ss = 0.f;
#pragma unroll
            for (int db = 0; db < NDB; ++db)
#pragma unroll
                for (int r = 0; r < 16; ++r) { const float c = oacc[db][r] * inv - lam * X[((wq * 4 + db) * 16 + r) * 64 + lane]; oacc[db][r] = c; ss += c * c; }
            ss += __shfl_xor(ss, 32);
            const float rr = rsqrtf(ss * (1.0f / 128.f) + SUBLN_EPS);
            bf16_t* dst = AO + qrow * D + hu * 128;
#pragma unroll
            for (int db = 0; db < NDB; ++db)
#pragma unroll
                for (int t = 0; t < 4; ++t) { const int d = 32 * db + 8 * t + 4 * hi;
                    u32x2 o; o.x = cvtpk(oacc[db][4 * t] * rr, oacc[db][4 * t + 1] * rr); o.y = cvtpk(oacc[db][4 * t + 2] * rr, oacc[db][4 * t + 3] * rr);
                    *(u32x2*)(dst + d) = o; }
        }
    } else {
        bf16_t* dst = AO + qrow * D + 512 + hu * 64;
#pragma unroll
        for (int db = 0; db < NDB; ++db)
#pragma unroll
            for (int t = 0; t < 4; ++t) { const int d = 32 * db + 8 * t + 4 * hi;
                u32x2 o; o.x = cvtpk(oacc[db][4 * t] * inv, oacc[db][4 * t + 1] * inv); o.y = cvtpk(oacc[db][4 * t + 2] * inv, oacc[db][4 * t + 3] * inv);
                *(u32x2*)(dst + d) = o; }
    }
}

__device__ __forceinline__ void phase(const Params& P, LAS unsigned char* L) {
    const int tid = threadIdx.x;
    unsigned* ctr = (unsigned*)(P.ws + WS_CTL) + 64;
    LAS int* su = (LAS int*)(L + OFF_UNIT);
    const float lam = ((const float*)(P.ws + WS_CTL))[0];
    const int x0 = (int)(__builtin_amdgcn_s_getreg((3 << 11) | 20) & 7u);
    int a = 0;
    for (;;) {
        const int x = (x0 + a) & 7;
        if (tid == 0) *su = (int)atomicAdd(ctr + 64 * x, 1u);
        __syncthreads();
        const int i = __builtin_amdgcn_readfirstlane(*su);
        __syncthreads();
        if (i >= 256) { if (++a == 8) break; continue; }
        if (i < 128) { const int d = 2 * x + (i & 1); unit<true>(P, L, d >> 2, d & 3, 65 - (i >> 1), lam); }
        else { const int j = i - 128; const int f = 4 * x + (j & 3); unit<false>(P, L, f >> 3, f & 7, 32 - (j >> 2), lam); }
    }
}
}

#ifndef FAST_ATTN
#define FAST_ATTN 1
#endif
template <bool DIFF> __global__ void __launch_bounds__(256) naive_attn(Params P) { naive_attn_body<DIFF>(P, threadIdx.x, blockIdx.x, blockIdx.y, blockIdx.z); }
#define XB_TMO      128
#define XB_XCNT(j)  (256  + 64 * (j))
#define XB_XSUB(j)  (1280 + 64 * (j))
#define XB_XGEN(j)  (2304 + 64 * (j))
#define XB_TOP      3328
#define XB_TOPGEN   3392
#define XCD_BAR_WORDS 3456
#define XB_SPIN_CAP (1u << 18)

__device__ __forceinline__ unsigned xb_ld(unsigned* p)              { return __hip_atomic_load(p, __ATOMIC_RELAXED, __HIP_MEMORY_SCOPE_AGENT); }
__device__ __forceinline__ unsigned xb_add(unsigned* p, unsigned v) { return __hip_atomic_fetch_add(p, v, __ATOMIC_RELAXED, __HIP_MEMORY_SCOPE_AGENT); }
__device__ __forceinline__ unsigned xb_xcc_id() { return (unsigned)__builtin_amdgcn_s_getreg((3 << 11) | 20) & 0xFu; }
#define XB_SPIN(cond, bar) do { unsigned _sp = 0; while (cond) { __builtin_amdgcn_s_sleep(1); \
    if ((++_sp & 255u) == 0u) { if (xb_ld(&(bar)[XB_TMO])) break; if (_sp > XB_SPIN_CAP) { atomicAdd(&(bar)[XB_TMO], 1u); break; } } } } while (0)

struct XcdBarrier {
    unsigned* bar; unsigned x;
    volatile LAS unsigned* st;
};

__device__ __forceinline__ XcdBarrier xcd_barrier_post(unsigned* bar, volatile LAS unsigned* st) {
    XcdBarrier b; b.bar = bar; b.x = xb_xcc_id(); b.st = st;
    if (threadIdx.x == 0) (void)xb_add(&bar[XB_XCNT(b.x)], 1u);
    return b;
}
__device__ __forceinline__ void xcd_barrier_complete(unsigned* bar, unsigned x, unsigned& nloc, unsigned& nx) {
    const unsigned G = gridDim.x * gridDim.y * gridDim.z;
    unsigned sum, cnt, mine, sp = 0u;
    for (;;) {
        sum = 0u; cnt = 0u; mine = 0u;
#pragma unroll
        for (unsigned j = 0; j < 16; ++j) { const unsigned c = xb_ld(&bar[XB_XCNT(j)]); sum += c; cnt += (c > 0u) ? 1u : 0u; mine = (j == x) ? c : mine; }
        if (sum == G) break;
        __builtin_amdgcn_s_sleep(1);
        if ((++sp & 255u) == 0u) { if (xb_ld(&bar[XB_TMO])) break; if (sp > XB_SPIN_CAP) { atomicAdd(&bar[XB_TMO], 1u); break; } }
    }
    nloc = mine > 0u ? mine : 1u; nx = cnt > 0u ? cnt : 1u;
}

__device__ __forceinline__ void xcd_barrier(const XcdBarrier& b) {
    asm volatile("s_waitcnt vmcnt(0)" ::: "memory");
    __syncthreads();
    if (threadIdx.x == 0) {
        unsigned* bar = b.bar;
        __builtin_amdgcn_s_waitcnt(0);
        unsigned nloc = b.st[0], nx = b.st[1];
        if (nloc == 0u) { xcd_barrier_complete(bar, b.x, nloc, nx); b.st[0] = nloc; b.st[1] = nx; }
        const unsigned old = xb_add(&bar[XB_XSUB(b.x)], 1u);
        const unsigned gen = old / nloc;
        if (old + 1u == (gen + 1u) * nloc) {
            __builtin_amdgcn_fence(__ATOMIC_RELEASE, "agent");
            asm volatile("s_waitcnt vmcnt(0)" ::: "memory");
            const unsigned og = xb_add(&bar[XB_TOP], 1u);
            const unsigned tg = og / nx;
            if (og + 1u == (tg + 1u) * nx) xb_add(&bar[XB_TOPGEN], 1u);
            else XB_SPIN(xb_ld(&bar[XB_TOPGEN]) == tg, bar);
            __builtin_amdgcn_fence(__ATOMIC_ACQUIRE, "agent");
            xb_add(&bar[XB_XGEN(b.x)], 1u);
            asm volatile("s_waitcnt vmcnt(0)" ::: "memory");
        } else {
            XB_SPIN(xb_ld(&bar[XB_XGEN(b.x)]) == gen, bar);
            __builtin_amdgcn_fence(__ATOMIC_ACQUIRE, "agent");
            asm volatile("s_waitcnt vmcnt(0)" ::: "memory");
        }
    }
    __syncthreads();
}

constexpr size_t WS_XBAR = 16 * 1024;
constexpr int LDS_XBST = 147456 - 64;
constexpr int LDS_BYTES = 147456;
constexpr int N_PHASES = 10;
#ifndef MK_PER_PHASE
#define MK_PER_PHASE 0
#endif

__global__ void __launch_bounds__(512, 2) mk(Params P) {
    extern __shared__ __attribute__((aligned(16))) unsigned char lds[];
    cg::grid_group grid = cg::this_grid();
    LAS unsigned char* L = (LAS unsigned char*)lds;
    const int tid = threadIdx.x, lane = tid & 63, wave = __builtin_amdgcn_readfirstlane(tid >> 6);
    const int G = gridDim.x, gw = blockIdx.x * 8 + wave, NGW = G * 8;
    unsigned char* ws = P.ws;
    float* ssq = (float*)(ws + WS_SSQ);
    bf16_t* HB = (bf16_t*)P.out; bf16_t* ACT = (bf16_t*)(ws + WS_BIG); bf16_t* QK = (bf16_t*)(ws + WS_BIG); bf16_t* VT = (bf16_t*)(ws + WS_VT); bf16_t* AO = (bf16_t*)(ws + WS_AO);
    float* H = (float*)(ws + WS_H);
    const int lo = P.ph_lo, hi = P.ph_hi;
#define IN(k) (lo <= (k) && (k) < hi)
    volatile LAS unsigned* xst = (volatile LAS unsigned*)(L + LDS_XBST);
    if (tid < 2) xst[tid] = 0u;
    __syncthreads();
    unsigned* xbar_words = (unsigned*)(ws + WS_XBAR);
    XcdBarrier xbar; xbar.bar = xbar_words; xbar.x = 0; xbar.st = xst;
    if (hi - lo > 1) xbar = xcd_barrier_post(xbar_words, xst);
    if (hi > 1000) grid.sync();
#define SEAM(k) do { if (IN(k) && IN((k) + 1)) xcd_barrier(xbar); } while (0)

    if (IN(0)) { p0_prologue(P, (LAS float*)(L + wave * 17408), gw, NGW, lane); }
    SEAM(0);
    if (IN(1)) {
        for (int t = blockIdx.x; t < DFF / 16; t += G) side_stage1(P, (LAS float*)L, t);
        pg8::Gemm g{HB, (const bf16_t*)(ws + WS_WGU1), TP, NGU, D}; LiveOrder S; S.init(NGU, G, (int)blockIdx.x);
        PgSwiglu E{ssq, ACT};
        pg8::gemm_phase<PgSwiglu, LiveOrder, true, true>(L, g, S, E);
    }
    SEAM(1);
    if (IN(2)) {
        for (int t = blockIdx.x; t < D / 16; t += G) side_stage2(P, (LAS float*)L, t);
        pg8::Gemm g{ACT, (const bf16_t*)(ws + WS_WD1), TP, D, DFF}; LiveOrder S; S.init(D, G, (int)blockIdx.x);
        PgResid E{EpiResid{&P, 1, 0.5f, nullptr, HB, nullptr}, ssq + (size_t)1 * TP};
        pg8::gemm_phase<PgResid, LiveOrder, true, true>(L, g, S, E);
    }
    SEAM(2);
    if (IN(3)) {
        zero_pad_kv(ws, gw, NGW, lane);
        for (int t = blockIdx.x; t < 129; t += G) side_stage3(P, (LAS float*)L, t);
        gates_rows(P, wave * G + (int)blockIdx.x, NGW, lane);
        pg8::Gemm g{HB, (const bf16_t*)(ws + WS_WIN), TP, 3072, D}; LiveOrder S; S.init(3072, G, (int)blockIdx.x);
        PgInproj E{EpiInproj{(const float*)(ws + WS_ROPE), P.in[7], QK, VT, (float*)(ws + WS_LOGF)}, ssq + (size_t)1 * TP};
        pg8::gemm_phase<PgInproj, LiveOrder, true, true>(L, g, S, E);
    }
    SEAM(3);
    if (IN(4)) {
        if (G >= 64) { if (blockIdx.x < 32) cum_scan_seq((const float*)(ws + WS_LOGF), (float*)(ws + WS_CUM), blockIdx.x, (LAS float*)L, tid);
                       else if (blockIdx.x < 64) key_norm_max(QK, (float*)(ws + WS_KNMAX), blockIdx.x - 32, (LAS float*)L, tid); }
        else { for (int bh = blockIdx.x; bh < 32; bh += G) { cum_scan_seq((const float*)(ws + WS_LOGF), (float*)(ws + WS_CUM), bh, (LAS float*)L, tid); key_norm_max(QK, (float*)(ws + WS_KNMAX), bh, (LAS float*)L, tid); } }
    }
    SEAM(4);
    if (IN(5)) {
#if FAST_ATTN
        fa::phase(P, L);
#endif
    }
    SEAM(5);
    if (IN(6)) {
        pg8::Gemm g{AO, (const bf16_t*)(ws + WS_WOUT), TP, D, D}; LiveOrder S; S.init(D, G, (int)blockIdx.x);
        PgResid E{EpiResid{&P, 0, 1.0f, nullptr, HB, HB}, ssq + (size_t)2 * TP};
        pg8::gemm_phase<PgResid, LiveOrder, true, true>(L, g, S, E);
    }
    SEAM(6);
    if (IN(7)) {
        pg8::Gemm g{HB, (const bf16_t*)(ws + WS_WGU2), TP, NGU, D}; LiveOrder S; S.init(NGU, G, (int)blockIdx.x);
        PgSwiglu E{ssq + (size_t)2 * TP, ACT};
        pg8::gemm_phase<PgSwiglu, LiveOrder, true, true>(L, g, S, E);
    }
    SEAM(7);
    if (IN(8)) {
        pg8::Gemm g{ACT, (const bf16_t*)(ws + WS_WD2), TP, D, DFF}; LiveOrder S; S.init(D, G, (int)blockIdx.x);
        PgResid E{EpiResid{&P, 0, 0.5f, H, nullptr, HB}, ssq + (size_t)3 * TP};
        pg8::gemm_phase<PgResid, LiveOrder, true, true>(L, g, S, E);
    }
    SEAM(8);
    if (IN(9)) final_norm_rows(P, gw, NGW, lane);
#undef IN
#undef SEAM
}

extern "C" void kernel_launch(void* const* d_in, const int* in_sizes, int n_in, void* d_out, int out_size, void* d_ws, size_t ws_size, hipStream_t stream) {
    if (n_in != 18 || out_size != BATCH * SEQ * D || ws_size < WS_END) { fprintf(stderr, "kernel_launch: unexpected shapes (n_in %d out %d ws %zu need %zu)\n", n_in, out_size, ws_size, (size_t)WS_END); return; }
    static int grid = 0;
    if (grid == 0) {
        int dev = 0, cus = 0, per_cu = 0;
        (void)hipGetDevice(&dev); (void)hipDeviceGetAttribute(&cus, hipDeviceAttributeMultiprocessorCount, dev);
        (void)hipFuncSetAttribute((const void*)mk, hipFuncAttributeMaxDynamicSharedMemorySize, LDS_BYTES);
        (void)hipOccupancyMaxActiveBlocksPerMultiprocessor(&per_cu, (const void*)mk, 512, LDS_BYTES);
        if (per_cu < 1) { fprintf(stderr, "kernel_launch: occupancy query says %d blocks per CU\n", per_cu); per_cu = 1; }
        grid = cus * per_cu;
    }
    Params P{};
    for (int i = 0; i < 18; ++i) P.in[i] = (const float*)d_in[i];
    P.out = (float*)d_out; P.ws = (unsigned char*)d_ws;
#if MK_PER_PHASE
    for (int ph = 0; ph < N_PHASES; ++ph) { P.ph_lo = ph; P.ph_hi = ph + 1;
        if (ph == 5 && !FAST_ATTN) { hipLaunchKernelGGL(naive_attn<true>, dim3(LP / 64, 4, BATCH), dim3(256), 0, stream, P); hipLaunchKernelGGL(naive_attn<false>, dim3(LP / 128, 8, BATCH), dim3(256), 0, stream, P); continue; }
        hipLaunchKernelGGL(mk, dim3(grid), dim3(512), LDS_BYTES, stream, P); }
#else
    P.ph_lo = 0; P.ph_hi = N_PHASES;
    if (hipMemsetAsync((unsigned char*)d_ws + WS_XBAR, 0, XCD_BAR_WORDS * 4, stream) != hipSuccess) { fprintf(stderr, "kernel_launch: memset of the barrier words failed\n"); return; }
    void* args[] = {&P};
    hipError_t e = hipLaunchCooperativeKernel((const void*)mk, dim3(grid), dim3(512), args, LDS_BYTES, stream);
    if (e != hipSuccess) fprintf(stderr, "cooperative launch failed: %s (grid %d)\n", hipGetErrorString(e), grid);
#endif
}
```

```cpp
#include <hip/hip_runtime.h>
#include <hip/hip_cooperative_groups.h>
namespace cg = cooperative_groups;
#include <cstdio>
#include <cstdint>

typedef unsigned short bf16_t;
typedef unsigned u32x4 __attribute__((ext_vector_type(4)));
typedef float f32x4 __attribute__((ext_vector_type(4)));
#define LAS __attribute__((address_space(3)))

constexpr int D = 1024, BATCH = 4, SEQ = 8192, NMETA = 16, NPAD = 240, REAL0 = 256, LP = 8448, TP = BATCH * LP;
constexpr int DFF = 2816, NGU = 2 * DFF, NIN = 3080, NINP = 3328;
constexpr int QKW = 2048;
constexpr float RMS_EPS = 1e-6f, SUBLN_EPS = 1e-5f, LAMBDA_INIT = 0.2f;
constexpr float QSCALE = 0.18033688011112042f;
constexpr float LOG2E = 1.4426950408889634f;
constexpr float NEGBIG = -1e30f;

constexpr size_t MiB = 1u << 20;
constexpr size_t WS_CTL = 0;
constexpr size_t WS_AT0 = 64 * 1024, WS_ACTT = 128 * 1024, WS_H1T = 320 * 1024, WS_SSQM = 384 * 1024;
constexpr size_t WS_SSQ = 1 * MiB;
constexpr size_t WS_LOGF = 4 * MiB;
constexpr size_t WS_CUM = 6 * MiB;
constexpr size_t WS_ROPE = 8 * MiB;
constexpr size_t WS_WGU1 = 9 * MiB, WS_WD1 = 20 * MiB, WS_WIN = 26 * MiB, WS_WOUT = 33 * MiB, WS_WGU2 = 35 * MiB, WS_WD2 = 46 * MiB;
constexpr size_t WS_H = 52 * MiB;
constexpr size_t WS_AO = 184 * MiB;
constexpr size_t WS_BIG = 250 * MiB;
constexpr size_t WS_VT = WS_BIG + 132 * MiB;
constexpr size_t WS_END = WS_BIG + 198 * MiB;

struct Params {
    const float* in[18];
    float* out; unsigned char* ws;
    int ph_lo, ph_hi;
};

__device__ __forceinline__ unsigned f2bf(float f) { unsigned u = __float_as_uint(f); return (u + 0x7fffu + ((u >> 16) & 1u)) >> 16; }
__device__ __forceinline__ unsigned pk2(float lo, float hi) { return f2bf(lo) | (f2bf(hi) << 16); }
__device__ __forceinline__ float bf2f(unsigned short b) { return __uint_as_float(((unsigned)b) << 16); }
__device__ __forceinline__ float bflo(unsigned w) { return __uint_as_float(w << 16); }
__device__ __forceinline__ float bfhi(unsigned w) { return __uint_as_float(w & 0xffff0000u); }
__device__ __forceinline__ float wave_sum(float v) {
#pragma unroll
    for (int o = 1; o < 64; o <<= 1) v += __shfl_xor(v, o);
    return v;
}
struct F8 { float v[8]; };

__device__ __forceinline__ void wconv_item(const float* W, const float* gvec, int K, int N, bf16_t* WT, int mode, LAS float* scr, int item, int nblk, int lane) {
    const int kb = item / nblk, nb = item % nblk, k0 = 64 * kb, n0 = 64 * nb;
    const int nl = 4 * (lane & 15);
    const int ng = n0 + nl;
    int sc; if (mode == 1) { const int pn = ng >> 8, w = ng & 255, bj = w >> 7, c = w & 127; sc = bj * DFF + 128 * pn + c; } else sc = ng;
    const bool valid = (mode != 2) || (ng < NIN);
#pragma unroll 8
    for (int i = 0; i < 16; ++i) { const int kk = 4 * i + (lane >> 4);
        f32x4 w = valid ? __builtin_nontemporal_load((const f32x4*)(W + (size_t)(k0 + kk) * N + sc)) : (f32x4){0.f, 0.f, 0.f, 0.f};
        if (gvec) { const int kx = k0 + kk; const float gs = (mode == 3) ? (kx < 512 ? gvec[kx & 127] * (1.0f - LAMBDA_INIT) : 1.0f) : gvec[kx]; w.x *= gs; w.y *= gs; w.z *= gs; w.w *= gs; }
        *(LAS f32x4*)(scr + kk * 68 + nl) = w; }
    asm volatile("s_waitcnt lgkmcnt(0)" ::: "memory");
    const int c = lane & 7;
#pragma unroll
    for (int j = 0; j < 8; ++j) { const int n = (lane >> 3) + 8 * j; const LAS float* sp = scr + (8 * c) * 68 + n;
        u32x4 o; o.x = pk2(sp[0 * 68], sp[1 * 68]); o.y = pk2(sp[2 * 68], sp[3 * 68]); o.z = pk2(sp[4 * 68], sp[5 * 68]); o.w = pk2(sp[6 * 68], sp[7 * 68]);
        *(u32x4*)(WT + (size_t)(n0 + n) * K + k0 + 8 * c) = o; }
    asm volatile("s_waitcnt lgkmcnt(0)" ::: "memory");
}

__device__ __forceinline__ const float* h0_row(const Params& P, int row) {
    const int b = row / LP, p = row % LP;
    if (p < NPAD) return nullptr;
    if (p < NPAD + NMETA) return P.in[1] + (size_t)(p - NPAD) * D;
    return P.in[0] + ((size_t)b * SEQ + (p - REAL0)) * D;
}

__device__ __forceinline__ void p0_prologue(const Params& P, LAS float* scr_wave, int gw, int NGW, int lane) {
    unsigned char* ws = P.ws;
    constexpr int I_GU = 16 * (NGU / 64), I_D = (DFF / 64) * (D / 64), I_IN = 16 * (NINP / 64), I_OUT = 16 * (D / 64);
    constexpr int NITEMS = 2 * I_GU + 2 * I_D + I_IN + I_OUT;
    for (int it = gw; it < NITEMS; it += NGW) {
        int r = it;
        if (r < I_GU) { wconv_item(P.in[3], P.in[2], D, NGU, (bf16_t*)(ws + WS_WGU1), 1, scr_wave, r, NGU / 64, lane); continue; } r -= I_GU;
        if (r < I_GU) { wconv_item(P.in[15], P.in[14], D, NGU, (bf16_t*)(ws + WS_WGU2), 1, scr_wave, r, NGU / 64, lane); continue; } r -= I_GU;
        if (r < I_D) { wconv_item(P.in[4], nullptr, DFF, D, (bf16_t*)(ws + WS_WD1), 0, scr_wave, r, D / 64, lane); continue; } r -= I_D;
        if (r < I_D) { wconv_item(P.in[16], nullptr, DFF, D, (bf16_t*)(ws + WS_WD2), 0, scr_wave, r, D / 64, lane); continue; } r -= I_D;
        if (r < I_IN) { wconv_item(P.in[6], P.in[5], D, NIN, (bf16_t*)(ws + WS_WIN), 2, scr_wave, r, NINP / 64, lane); continue; } r -= I_IN;
        wconv_item(P.in[13], P.in[12], D, D, (bf16_t*)(ws + WS_WOUT), 3, scr_wave, r, D / 64, lane);
    }
    float* ssq = (float*)(ws + WS_SSQ);
    bf16_t* HB = (bf16_t*)P.out;
    for (int row = gw; row < TP; row += 2 * NGW) {
        const int row2 = row + NGW; const bool has2 = row2 < TP;
        const float* src = h0_row(P, row); const float* src2 = has2 ? h0_row(P, row2) : nullptr;
        f32x4 v[4], u[4]; float s = 0.f, s2 = 0.f;
#pragma unroll
        for (int j = 0; j < 4; ++j) { v[j] = src ? *((const f32x4*)src + lane + 64 * j) : (f32x4){0.f, 0.f, 0.f, 0.f}; u[j] = src2 ? *((const f32x4*)src2 + lane + 64 * j) : (f32x4){0.f, 0.f, 0.f, 0.f}; }
#pragma unroll
        for (int j = 0; j < 4; ++j) { s += (v[j].x * v[j].x + v[j].y * v[j].y) + (v[j].z * v[j].z + v[j].w * v[j].w); s2 += (u[j].x * u[j].x + u[j].y * u[j].y) + (u[j].z * u[j].z + u[j].w * u[j].w); }
        s = wave_sum(s); s2 = wave_sum(s2);
        unsigned long long* o8 = (unsigned long long*)(HB + (size_t)row * D) + lane;
#pragma unroll
        for (int j = 0; j < 4; ++j) o8[64 * j] = (unsigned long long)pk2(v[j].x, v[j].y) | ((unsigned long long)pk2(v[j].z, v[j].w) << 32);
        if (lane < 4) ssq[(size_t)lane * TP + row] = (lane == 0) ? s : 0.f;
        if (has2) {
            unsigned long long* p8 = (unsigned long long*)(HB + (size_t)row2 * D) + lane;
#pragma unroll
            for (int j = 0; j < 4; ++j) p8[64 * j] = (unsigned long long)pk2(u[j].x, u[j].y) | ((unsigned long long)pk2(u[j].z, u[j].w) << 32);
            if (lane < 4) ssq[(size_t)lane * TP + row2] = (lane == 0) ? s2 : 0.f;
        }
    }
    float* rope = (float*)(ws + WS_ROPE);
    for (int e = gw * 64 + lane; e < (NMETA + SEQ) * 8; e += NGW * 64) {
        const int pos = e >> 3, i = e & 7;
        const double invf = (i == 0) ? 1.0 : (i == 1) ? 0.19392274474868576 : (i == 2) ? 0.03760603093086393 : (i == 3) ? 0.007292664737217109 :
                            (i == 4) ? 0.001414213562373095 : (i == 5) ? 0.0002742481756762073 : (i == 6) ? 5.318295896944988e-05 : 1.031338537721246e-05;
        double rev = (double)pos * invf * 0.15915494309189535; rev -= floor(rev);
        const float rf = (float)rev;
        rope[2 * e] = __builtin_amdgcn_cosf(rf); rope[2 * e + 1] = __builtin_amdgcn_sinf(rf);
    }
    if (gw >= 8 && gw < 8 + NMETA) {
        const int r = gw - 8; const float* src = P.in[1] + (size_t)r * D; const float* g1 = P.in[2]; float* AT0 = (float*)(ws + WS_AT0);
        float v[16]; float sq = 0.f;
#pragma unroll
        for (int j = 0; j < 16; ++j) { v[j] = src[lane + 64 * j]; sq += v[j] * v[j]; }
        const float rs = rsqrtf(wave_sum(sq) * (1.0f / D) + RMS_EPS);
#pragma unroll
        for (int j = 0; j < 16; ++j) { const int k = lane + 64 * j; AT0[k * 16 + r] = v[j] * rs * g1[k]; }
        if (lane == 0) ((float*)(ws + WS_SSQM))[r] = 0.f;
    }
    if (gw == 0) {
        const float a = wave_sum(P.in[8][lane] * P.in[9][lane]), b = wave_sum(P.in[10][lane] * P.in[11][lane]);
        if (lane == 0) { ((float*)(ws + WS_CTL))[0] = expf(a) - expf(b) + LAMBDA_INIT; ((unsigned*)(ws + WS_CTL))[16] = 0u; }
        if (lane < 8) ((unsigned*)(ws + WS_CTL))[64 + 64 * lane] = 0u;
    }
}

__device__ __forceinline__ void zero_pad_kv(unsigned char* ws, int gw, int NGW, int lane) {
    {
        float* logf = (float*)(ws + WS_LOGF); bf16_t* QKz = (bf16_t*)(ws + WS_BIG); bf16_t* VTz = (bf16_t*)(ws + WS_VT);
        for (int e = gw * 64 + lane; e < BATCH * NPAD * 8; e += NGW * 64) { const int b = e / (NPAD * 8), o = e % (NPAD * 8); logf[(size_t)b * LP * 8 + o] = 0.f; }
        for (int e = gw * 64 + lane; e < BATCH * 48 * (QKW / 8); e += NGW * 64) { const int b = e / (48 * (QKW / 8)), o = e % (48 * (QKW / 8)); *(u32x4*)(QKz + ((size_t)b * LP + 192) * QKW + (size_t)o * 8) = (u32x4){0u, 0u, 0u, 0u}; }
        for (int e = gw * 64 + lane; e < BATCH * 1024 * 6; e += NGW * 64) { const int bv = e / 6, o = e % 6; *(u32x4*)(VTz + (size_t)bv * LP + 192 + o * 8) = (u32x4){0u, 0u, 0u, 0u}; }
    }
}

__device__ __forceinline__ float row_rstd(const float* ssq, int row) { return rsqrtf(ssq[row] * (1.0f / D) + RMS_EPS); }

struct EpiSwiglu {
    const float* ssq; bf16_t* ACT;
    __device__ __forceinline__ void operator()(int row, int col, const F8& v, const F8& w, float rstd) const {
        float a[8];
        const float k1 = -LOG2E * rstd, k2 = rstd * rstd;
#pragma unroll
        for (int j = 0; j < 8; ++j) a[j] = (v.v[j] * w.v[j]) * (k2 * __builtin_amdgcn_rcpf(1.f + __builtin_amdgcn_exp2f(v.v[j] * k1)));
        u32x4 o; o.x = pk2(a[0], a[1]); o.y = pk2(a[2], a[3]); o.z = pk2(a[4], a[5]); o.w = pk2(a[6], a[7]);
        *(u32x4*)(ACT + (size_t)row * DFF + col) = o;
    }
};
struct EpiResid {
    const Params* P; int from_x; float scale; float* H; bf16_t* HB; const bf16_t* HBin;
    __device__ __forceinline__ F8 load(int row, int col) const {
        F8 r;
        if (from_x) { const float* src = h0_row(*P, row); f32x4 b0 = {0.f, 0.f, 0.f, 0.f}, b1 = b0; if (src) { b0 = *(const f32x4*)(src + col); b1 = *(const f32x4*)(src + col + 4); }
            r.v[0] = b0.x; r.v[1] = b0.y; r.v[2] = b0.z; r.v[3] = b0.w; r.v[4] = b1.x; r.v[5] = b1.y; r.v[6] = b1.z; r.v[7] = b1.w; }
        else { const u32x4 w = *(const u32x4*)(HBin + (size_t)row * D + col);
            r.v[0] = bflo(w.x); r.v[1] = bfhi(w.x); r.v[2] = bflo(w.y); r.v[3] = bfhi(w.y); r.v[4] = bflo(w.z); r.v[5] = bfhi(w.z); r.v[6] = bflo(w.w); r.v[7] = bfhi(w.w); }
        return r;
    }
    __device__ __forceinline__ float finish(int row, int col, const F8& v, const F8& bs) const {
        f32x4 h0 = {bs.v[0] + scale * v.v[0], bs.v[1] + scale * v.v[1], bs.v[2] + scale * v.v[2], bs.v[3] + scale * v.v[3]};
        f32x4 h1 = {bs.v[4] + scale * v.v[4], bs.v[5] + scale * v.v[5], bs.v[6] + scale * v.v[6], bs.v[7] + scale * v.v[7]};
        if (H) { *(f32x4*)(H + (size_t)row * D + col) = h0; *(f32x4*)(H + (size_t)row * D + col + 4) = h1; }
        if (HB) { u32x4 o; o.x = pk2(h0.x, h0.y); o.y = pk2(h0.z, h0.w); o.z = pk2(h1.x, h1.y); o.w = pk2(h1.z, h1.w); *(u32x4*)(HB + (size_t)row * D + col) = o; }
        return (h0.x * h0.x + h0.y * h0.y) + (h0.z * h0.z + h0.w * h0.w) + (h1.x * h1.x + h1.y * h1.y) + (h1.z * h1.z + h1.w * h1.w);
    }
    __device__ __forceinline__ float operator()(int row, int col, const F8& v) const { return finish(row, col, v, load(row, col)); }
};
struct EpiInproj {
    const float* rope; const float* bforget; bf16_t* QK; bf16_t* VT; float* logf;
    __device__ __forceinline__ void qk_rope(int row, int col, const F8& v, const F8& w, const f32x4 (&cs4)[4]) const {
        const int d = col & 63; float a[8];
#pragma unroll
        for (int j = 0; j < 8; ++j) a[j] = v.v[j];
        if (d < 16) {
#pragma unroll
            for (int j = 0; j < 8; ++j) { const float c = cs4[j >> 1][2 * (j & 1)], sn = cs4[j >> 1][2 * (j & 1) + 1]; a[j] = (d < 8) ? v.v[j] * c - w.v[j] * sn : v.v[j] * c + w.v[j] * sn; }
        }
        if (col < 512) {
#pragma unroll
            for (int j = 0; j < 8; ++j) a[j] *= QSCALE;
        }
        u32x4 o; o.x = pk2(a[0], a[1]); o.y = pk2(a[2], a[3]); o.z = pk2(a[4], a[5]); o.w = pk2(a[6], a[7]);
        *(u32x4*)(QK + (size_t)row * QKW + col) = o;
    }
    __device__ __forceinline__ void operator()(int row, int col, const F8& v, const F8& w) const {
        const int b = row / LP, p = row % LP;
        if (col < 1024 || (col >= 1536 && col < 2560)) {
            float a[8]; int dst;
#pragma unroll
            for (int j = 0; j < 8; ++j) a[j] = v.v[j];
            if (col < 1024) {
                const int d = col & 63;
                if (d < 16 && p >= NPAD) {
                    const float* cs = rope + (size_t)(p - NPAD) * 16;
#pragma unroll
                    for (int j = 0; j < 8; ++j) { const float c = cs[2 * j], s = cs[2 * j + 1]; a[j] = (d < 8) ? v.v[j] * c - w.v[j] * s : v.v[j] * c + w.v[j] * s; }
                }
                if (col < 512) {
#pragma unroll
                    for (int j = 0; j < 8; ++j) a[j] *= QSCALE;
                }
                dst = col;
            } else {
                if (col < 2048) {
#pragma unroll
                    for (int j = 0; j < 8; ++j) a[j] *= QSCALE;
                }
                dst = col - 512;
            }
            u32x4 o; o.x = pk2(a[0], a[1]); o.y = pk2(a[2], a[3]); o.z = pk2(a[4], a[5]); o.w = pk2(a[6], a[7]);
            *(u32x4*)(QK + (size_t)row * QKW + dst) = o;
        } else if (col < 3072) {
            const int vcol = (col < 1536) ? col - 1024 : col - 2560 + 512;
            bf16_t* dstp = VT + ((size_t)b * 1024 + vcol) * LP + p;
#pragma unroll
            for (int j = 0; j < 8; ++j) dstp[(size_t)j * LP] = (bf16_t)f2bf(v.v[j]);
        } else if (col == 3072) {
            f32x4 o0, o1; float r[8];
#pragma unroll
            for (int j = 0; j < 8; ++j) { const float x = v.v[j] + bforget[j]; r[j] = (p >= NPAD) ? (fminf(x, 0.f) - log1pf(__expf(-fabsf(x)))) : 0.f; }
            o0 = (f32x4){r[0], r[1], r[2], r[3]}; o1 = (f32x4){r[4], r[5], r[6], r[7]};
            *(f32x4*)(logf + (size_t)row * 8) = o0; *(f32x4*)(logf + (size_t)row * 8 + 4) = o1;
        }
    }
};

template <int MODE  >
__global__ void __launch_bounds__(256) naive_gemm(Params P, const bf16_t* A, const bf16_t* Bt, int K, int norm_in, int norm_out, int from_x, float scale, int writeHB) {
    const int row = blockIdx.x * 256 + threadIdx.x;
    const int c16 = blockIdx.y * 16;
    int n0;
    if (MODE == 0) { const int pn = c16 >> 7, c = c16 & 127; n0 = pn * 256 + c; } else n0 = c16;
    constexpr int NACC = (MODE == 0) ? 32 : 16;
    float acc[NACC];
#pragma unroll
    for (int i = 0; i < NACC; ++i) acc[i] = 0.f;
    const bf16_t* ap = A + (size_t)row * K;
    for (int k = 0; k < K; k += 8) {
        const u32x4 av = *(const u32x4*)(ap + k);
        float a[8] = {bflo(av.x), bfhi(av.x), bflo(av.y), bfhi(av.y), bflo(av.z), bfhi(av.z), bflo(av.w), bfhi(av.w)};
#pragma unroll
        for (int i = 0; i < NACC; ++i) {
            const int n = n0 + (i & 15) + ((i >> 4) << 7);
            const u32x4 bv = *(const u32x4*)(Bt + (size_t)n * K + k);
            acc[i] += a[0] * bflo(bv.x) + a[1] * bfhi(bv.x) + a[2] * bflo(bv.y) + a[3] * bfhi(bv.y) + a[4] * bflo(bv.z) + a[5] * bfhi(bv.z) + a[6] * bflo(bv.w) + a[7] * bfhi(bv.w);
        }
    }
    float* ssq = (float*)(P.ws + WS_SSQ);
    if (MODE == 0) {
        const float rstd = row_rstd(ssq + (size_t)norm_in * TP, row);
        EpiSwiglu E{nullptr, (bf16_t*)(P.ws + WS_BIG)};
        F8 g0, g1, u0, u1;
#pragma unroll
        for (int j = 0; j < 8; ++j) { g0.v[j] = acc[j]; g1.v[j] = acc[8 + j]; u0.v[j] = acc[16 + j]; u1.v[j] = acc[24 + j]; }
        E(row, c16, g0, u0, rstd); E(row, c16 + 8, g1, u1, rstd);
    } else if (MODE == 1) {
        EpiResid E{&P, from_x, scale, (float*)(P.ws + WS_H), writeHB ? (bf16_t*)P.out : nullptr};
        F8 v0, v1;
#pragma unroll
        for (int j = 0; j < 8; ++j) { v0.v[j] = acc[j]; v1.v[j] = acc[8 + j]; }
        const float s = E(row, c16, v0) + E(row, c16 + 8, v1);
        atomicAdd(ssq + (size_t)norm_out * TP + row, s);
    } else {
        const float rstd = row_rstd(ssq + (size_t)norm_in * TP, row);
        EpiInproj E{(const float*)(P.ws + WS_ROPE), P.in[7], (bf16_t*)(P.ws + WS_BIG), (bf16_t*)(P.ws + WS_VT), (float*)(P.ws + WS_LOGF)};
        F8 v0, v1;
#pragma unroll
        for (int j = 0; j < 8; ++j) { v0.v[j] = acc[j] * rstd; v1.v[j] = acc[8 + j] * rstd; }
        E(row, c16, v0, v1); E(row, c16 + 8, v1, v0);
    }
}

constexpr size_t WS_KNMAX = 448 * 1024;
__device__ __forceinline__ void key_norm_max(const bf16_t* QK, float* knmax, int bh, LAS float* sh, int tid) {
    const int b = bh >> 3, h = bh & 7; float mx = 0.f;
    for (int p = NPAD + tid; p < LP; p += 512) { const bf16_t* kr = QK + ((size_t)b * LP + p) * QKW + 1536 + h * 64; float q = 0.f;
#pragma unroll
        for (int i = 0; i < 8; ++i) { const u32x4 w = *(const u32x4*)(kr + 8 * i); const float a0 = bflo(w.x), a1 = bfhi(w.x), a2 = bflo(w.y), a3 = bfhi(w.y), a4 = bflo(w.z), a5 = bfhi(w.z), a6 = bflo(w.w), a7 = bfhi(w.w);
            q += (a0 * a0 + a1 * a1) + (a2 * a2 + a3 * a3) + (a4 * a4 + a5 * a5) + (a6 * a6 + a7 * a7); }
        mx = fmaxf(mx, q); }
#pragma unroll
    for (int o = 1; o < 64; o <<= 1) mx = fmaxf(mx, __shfl_xor(mx, o));
    if ((tid & 63) == 0) sh[tid >> 6] = mx;
    __syncthreads();
    if (tid == 0) { float m = sh[0]; for (int i = 1; i < 8; ++i) m = fmaxf(m, sh[i]); knmax[bh] = sqrtf(m); }
    __syncthreads();
}
__device__ __forceinline__ void cum_scan_seq(const float* logf, float* cum, int bh, LAS float* sh  , int tid) {
    const int b = bh >> 3, h = bh & 7;
    constexpr int PER = 17;
    const int p0 = tid * PER;
    float v[PER]; float s = 0.f;
#pragma unroll
    for (int i = 0; i < PER; ++i) { const int p = p0 + i; v[i] = (p < LP) ? logf[((size_t)b * LP + p) * 8 + h] : 0.f; s += v[i]; v[i] = s; }
    sh[tid] = s;
    __syncthreads();
    for (int off = 1; off < 512; off <<= 1) {
        const float t = (tid >= off) ? sh[tid - off] : 0.f;
        __syncthreads();
        sh[tid] += t;
        __syncthreads();
    }
    const float base = sh[tid] - s;
#pragma unroll
    for (int i = 0; i < PER; ++i) { const int p = p0 + i; if (p < LP) cum[((size_t)b * 8 + h) * LP + p] = (base + v[i]) * LOG2E; }
    __syncthreads();
}

__device__ __forceinline__ void final_norm_rows(const Params& P, int gw, int NGW, int lane) {
    const float* H = (const float*)(P.ws + WS_H); const float* ssq = (const float*)(P.ws + WS_SSQ) + (size_t)3 * TP; const float* g = P.in[17];
    f32x4 gv[4];
#pragma unroll
    for (int j = 0; j < 4; ++j) gv[j] = *((const f32x4*)g + lane + 64 * j);
    for (int t = gw; t < BATCH * SEQ; t += 2 * NGW) {
        const int t2 = t + NGW; const bool has2 = t2 < BATCH * SEQ;
        const int row = (t / SEQ) * LP + REAL0 + (t % SEQ), row2 = has2 ? (t2 / SEQ) * LP + REAL0 + (t2 % SEQ) : row;
        const float rstd = rsqrtf(ssq[row] * (1.0f / D) + RMS_EPS), rstd2 = rsqrtf(ssq[row2] * (1.0f / D) + RMS_EPS);
        const f32x4* hr = (const f32x4*)(H + (size_t)row * D) + lane; const f32x4* hr2 = (const f32x4*)(H + (size_t)row2 * D) + lane;
        f32x4 hv[4], hw[4];
#pragma unroll
        for (int j = 0; j < 4; ++j) { hv[j] = hr[64 * j]; hw[j] = hr2[64 * j]; }
        f32x4* o = (f32x4*)(P.out + (size_t)t * D) + lane;
#pragma unroll
        for (int j = 0; j < 4; ++j) __builtin_nontemporal_store((f32x4){hv[j].x * rstd * gv[j].x, hv[j].y * rstd * gv[j].y, hv[j].z * rstd * gv[j].z, hv[j].w * rstd * gv[j].w}, &o[64 * j]);
        if (has2) { f32x4* o2 = (f32x4*)(P.out + (size_t)t2 * D) + lane;
#pragma unroll
            for (int j = 0; j < 4; ++j) __builtin_nontemporal_store((f32x4){hw[j].x * rstd2 * gv[j].x, hw[j].y * rstd2 * gv[j].y, hw[j].z * rstd2 * gv[j].z, hw[j].w * rstd2 * gv[j].w}, &o2[64 * j]); }
    }
}

template <bool DIFF>
__device__ __forceinline__ void naive_attn_body(const Params& P, int tid, int bx, int h, int b) {
    constexpr int NS = DIFF ? 4 : 2, RPB = 256 / NS;
    const int ql = tid / NS, sub = tid % NS;
    const int pq = bx * RPB + ql;
    const size_t row = (size_t)b * LP + pq;
    const bf16_t* QK = (const bf16_t*)(P.ws + WS_BIG); const bf16_t* VT = (const bf16_t*)(P.ws + WS_VT); const float* cum = (const float*)(P.ws + WS_CUM) + ((size_t)b * 8 + h) * LP;
    bf16_t* AO = (bf16_t*)(P.ws + WS_AO);
    const float lam = ((const float*)(P.ws + WS_CTL))[0];
    float res[32];
#pragma unroll
    for (int j = 0; j < 32; ++j) res[j] = 0.f;
    const bool live = pq >= NPAD;
    for (int map = 0; map < (DIFF ? 2 : 1); ++map) {
        const int qcol = DIFF ? h * 128 + map * 64 : 1024 + h * 64, kcol = DIFF ? 512 + h * 128 + map * 64 : 1536 + h * 64;
        const int vcol0 = DIFF ? h * 128 + sub * 32 : 512 + h * 64 + sub * 32;
        float q[64];
#pragma unroll
        for (int i = 0; i < 8; ++i) { const u32x4 w = *(const u32x4*)(QK + row * QKW + qcol + 8 * i);
            q[8 * i] = bflo(w.x); q[8 * i + 1] = bfhi(w.x); q[8 * i + 2] = bflo(w.y); q[8 * i + 3] = bfhi(w.y); q[8 * i + 4] = bflo(w.z); q[8 * i + 5] = bfhi(w.z); q[8 * i + 6] = bflo(w.w); q[8 * i + 7] = bfhi(w.w); }
        const float cq = DIFF ? 0.f : cum[pq];
        float m = NEGBIG, l = 0.f, o[32];
#pragma unroll
        for (int j = 0; j < 32; ++j) o[j] = 0.f;
        if (live) for (int s0 = NPAD; s0 <= pq; s0 += 8) {
            float sc[8]; float gm = NEGBIG;
#pragma unroll
            for (int e = 0; e < 8; ++e) {
                const int s = s0 + e; const bf16_t* kr = QK + ((size_t)b * LP + s) * QKW + kcol; float d = 0.f;
#pragma unroll
                for (int i = 0; i < 8; ++i) { const u32x4 w = *(const u32x4*)(kr + 8 * i);
                    d += q[8 * i] * bflo(w.x) + q[8 * i + 1] * bfhi(w.x) + q[8 * i + 2] * bflo(w.y) + q[8 * i + 3] * bfhi(w.y) + q[8 * i + 4] * bflo(w.z) + q[8 * i + 5] * bfhi(w.z) + q[8 * i + 6] * bflo(w.w) + q[8 * i + 7] * bfhi(w.w); }
                if (!DIFF) d += cq - cum[s];
                sc[e] = (s <= pq) ? d : NEGBIG; gm = fmaxf(gm, sc[e]);
            }
            const float mn = fmaxf(m, gm), f = exp2f(m - mn);
            float pw[8]; float ps = 0.f;
#pragma unroll
            for (int e = 0; e < 8; ++e) { pw[e] = (s0 + e <= pq) ? exp2f(sc[e] - mn) : 0.f; ps += pw[e]; }
            l = l * f + ps; m = mn;
#pragma unroll
            for (int j = 0; j < 32; ++j) { const u32x4 w = *(const u32x4*)(VT + ((size_t)b * 1024 + vcol0 + j) * LP + s0);
                o[j] = o[j] * f + (pw[0] * bflo(w.x) + pw[1] * bfhi(w.x) + pw[2] * bflo(w.y) + pw[3] * bfhi(w.y) + pw[4] * bflo(w.z) + pw[5] * bfhi(w.z) + pw[6] * bflo(w.w) + pw[7] * bfhi(w.w)); }
        }
        const float il = (l > 0.f) ? 1.f / l : 0.f;
        if (DIFF) {
#pragma unroll
            for (int j = 0; j < 32; ++j) res[j] = (map == 0) ? o[j] * il : res[j] - lam * o[j] * il;
        } else {
#pragma unroll
            for (int j = 0; j < 32; ++j) res[j] = o[j] * il;
        }
    }
    if (DIFF) {
        float ss = 0.f;
#pragma unroll
        for (int j = 0; j < 32; ++j) ss += res[j] * res[j];
        ss += __shfl_xor(ss, 1); ss += __shfl_xor(ss, 2);
        const float r = rsqrtf(ss * (1.0f / 128.f) + SUBLN_EPS) * (1.0f - LAMBDA_INIT);
        const float* g = P.in[12] + sub * 32;
#pragma unroll
        for (int j = 0; j < 32; ++j) res[j] = res[j] * r * g[j];
    }
    bf16_t* dst = AO + row * D + (DIFF ? h * 128 + sub * 32 : 512 + h * 64 + sub * 32);
#pragma unroll
    for (int j = 0; j < 4; ++j) { u32x4 o4; o4.x = pk2(res[8 * j], res[8 * j + 1]); o4.y = pk2(res[8 * j + 2], res[8 * j + 3]); o4.z = pk2(res[8 * j + 4], res[8 * j + 5]); o4.w = pk2(res[8 * j + 6], res[8 * j + 7]);
        *(u32x4*)(dst + 8 * j) = live ? o4 : (u32x4){0u, 0u, 0u, 0u}; }
}


namespace pg8 {
#define PG8_LAS __attribute__((address_space(3)))
typedef unsigned short bf16_t;
typedef short bf16x8 __attribute__((ext_vector_type(8)));
typedef float f32x4 __attribute__((ext_vector_type(4)));
typedef unsigned u32x4 __attribute__((ext_vector_type(4)));
constexpr int BM = 256, BK = 64, HALF = 128, HTB = HALF * BK * 2  , STAGE_BYTES = 8 * HTB, NXCD = 8, WGM = 8;

__host__ __device__ __forceinline__ int lds_byte(int r, int c) { const int st = (r >> 4) * 2 + (c >> 5), rr = r & 15, cc = c & 31, ob = rr * 64 + cc * 2; return st * 1024 + (ob ^ (((ob >> 9) & 1) << 5)); }
__host__ __device__ __forceinline__ void stage_rc(int b, int& R, int& C) { const int st = b / 1024, sb = b % 1024, swz = sb ^ (((sb >> 9) & 1) << 5); R = (st >> 1) * 16 + swz / 64; C = (st & 1) * 32 + (swz % 64) / 2; }
__host__ __device__ __forceinline__ int perm32(int rho) { const int n = rho >> 4, i = rho & 15; return 8 * (i >> 2) + 4 * n + (i & 3); }

struct Unit { int pm, pn; };
struct Gemm { const bf16_t* A; const bf16_t* Bt; int M, N, K; };

struct StaticOrder {
    int nM, nN, nwg, G, c;
    __host__ __device__ void init(int M, int N, int G_, int c_) { nM = M / BM; nN = N / BM; nwg = nM * nN; G = G_; c = c_; }
    __host__ __device__ bool next(int i, Unit& u) const {
        const long L = (long)i * G + c; if (L >= nwg) return false;
        int wgid = (int)L; { const int q = nwg / NXCD, r = nwg % NXCD, xcd = wgid % NXCD, off = wgid / NXCD; wgid = (xcd < r ? xcd * (q + 1) : r * (q + 1) + (xcd - r) * q) + off; }
        const int nig = WGM * nN, gid = wgid / nig, fm = gid * WGM, gsz = (nM - fm) < WGM ? (nM - fm) : WGM;
        u.pm = fm + ((wgid % nig) % gsz); u.pn = (wgid % nig) / gsz; return true;
    }
    __device__ __forceinline__ void a_ready(const Unit&) const {}
    __device__ __forceinline__ void done(const Unit&) const {}
};

template <class Epi, class Sched, bool ALIGN_EPI = false, bool SP2 = false>
__device__ __forceinline__ void gemm_phase(PG8_LAS unsigned char* lds, const Gemm g, const Sched& S, const Epi& E) {
    const int tid = threadIdx.x, wid = __builtin_amdgcn_readfirstlane(tid >> 6), lane = tid & 63, wr = wid >> 2, wc = wid & 3, fr = lane & 15, fq = lane >> 4;
    const int K = g.K, nt = K / BK;
    unsigned voffA[2], voffB[2];
#pragma unroll
    for (int i = 0; i < 2; ++i) { int R, C; stage_rc(tid * 16 + i * 8192, R, C); const int Rb = Epi::PERM ? ((R & ~31) + perm32(R & 31)) : R;
        voffA[i] = (unsigned)(R * K + C) * 2u; voffB[i] = (unsigned)(Rb * K + C) * 2u; }
    const size_t kstep = (size_t)(BK * 2);
    const size_t hstep = (size_t)HALF * K * 2;
    const size_t tstep = 2 * hstep;
    const unsigned ldsw = (unsigned)wid * 1024u;
    const int aoff = lds_byte(wr * 64 + fr, fq * 8), boff = lds_byte(wc * 32 + fr, fq * 8);
#define PG8_SA(b, h) (((b) * 2 + (h)) * HTB)
#define PG8_SB(b, h) ((4 + (b) * 2 + (h)) * HTB)
#define PG8_STAGE(bufoff, gbase, voff) do { _Pragma("unroll") for (int _i = 0; _i < 2; ++_i) \
        __builtin_amdgcn_global_load_lds((const unsigned*)((const char*)(gbase) + (voff)[_i]), (PG8_LAS unsigned*)(lds + (bufoff) + ldsw + _i * 8192), 16, 0, 0); } while (0)
#define PG8_LDA(dst, b, h) do { _Pragma("unroll") for (int m = 0; m < 4; ++m) _Pragma("unroll") for (int k = 0; k < 2; ++k) dst[m][k] = *(const PG8_LAS bf16x8*)(lds + PG8_SA(b, h) + aoff + m * 2048 + k * 1024); } while (0)
#define PG8_LDB(dst, b, h) do { _Pragma("unroll") for (int n = 0; n < 2; ++n) _Pragma("unroll") for (int k = 0; k < 2; ++k) dst[n][k] = *(const PG8_LAS bf16x8*)(lds + PG8_SB(b, h) + boff + n * 2048 + k * 1024); } while (0)
#define PG8_MMA(ai, bj, At, Bt) do { __builtin_amdgcn_s_setprio(1); _Pragma("unroll") for (int m = 0; m < 4; ++m) _Pragma("unroll") for (int n = 0; n < 2; ++n) _Pragma("unroll") for (int k = 0; k < 2; ++k) \
        acc[ai][bj][m][n] = __builtin_amdgcn_mfma_f32_16x16x32_bf16(Bt[n][k], At[m][k], acc[ai][bj][m][n], 0, 0, 0); __builtin_amdgcn_s_setprio(0); } while (0)
#define PG8_WAIT_V(n) asm volatile("s_waitcnt vmcnt(" #n ")" ::: "memory")
#define PG8_WAIT_L(n) asm volatile("s_waitcnt lgkmcnt(" #n ")" ::: "memory")
#define PG8_BAR __builtin_amdgcn_s_barrier()
#define PG8_SCHED __builtin_amdgcn_sched_barrier(0)
    Unit cur, nxt; int ui = 0;
    if (!S.next(0, cur)) return;
    f32x4 acc[2][2][4][2];
#pragma unroll
    for (int a = 0; a < 2; ++a)
#pragma unroll
        for (int b = 0; b < 2; ++b)
#pragma unroll
            for (int m = 0; m < 4; ++m)
#pragma unroll
                for (int n = 0; n < 2; ++n) acc[a][b][m][n] = (f32x4){0.f, 0.f, 0.f, 0.f};
    bf16x8 At[4][2], B0[2][2], B1[2][2];
    const char* cA = (const char*)g.A + (size_t)cur.pm * tstep; const char* cB = (const char*)g.Bt + (size_t)cur.pn * tstep;
    S.a_ready(cur);
    if constexpr (SP2) {
        PG8_STAGE(PG8_SB(0, 0), cB, voffB); PG8_STAGE(PG8_SB(0, 1), cB + hstep, voffB); PG8_STAGE(PG8_SA(0, 0), cA, voffA); PG8_STAGE(PG8_SA(0, 1), cA + hstep, voffA);
        if (wr == 1) PG8_BAR;
        PG8_WAIT_V(2); PG8_BAR;
        PG8_STAGE(PG8_SB(1, 0), cB + kstep, voffB); PG8_STAGE(PG8_SA(1, 0), cA + kstep, voffA); PG8_STAGE(PG8_SB(1, 1), cB + hstep + kstep, voffB);
        PG8_WAIT_V(6); PG8_BAR;
    } else {
        PG8_STAGE(PG8_SB(0, 0), cB, voffB); PG8_STAGE(PG8_SA(0, 0), cA, voffA); PG8_STAGE(PG8_SB(0, 1), cB + hstep, voffB); PG8_STAGE(PG8_SA(0, 1), cA + hstep, voffA);
        if (wr == 1) PG8_BAR;
        PG8_WAIT_V(4); PG8_BAR;
        PG8_STAGE(PG8_SB(1, 0), cB + kstep, voffB); PG8_STAGE(PG8_SA(1, 0), cA + kstep, voffA); PG8_STAGE(PG8_SB(1, 1), cB + hstep + kstep, voffB);
        PG8_WAIT_V(6); PG8_BAR;
    }
    for (;;) {
        const bool has_next = S.next(ui + 1, nxt);
        const char* nA = has_next ? (const char*)g.A + (size_t)nxt.pm * tstep : cA; const char* nB = has_next ? (const char*)g.Bt + (size_t)nxt.pn * tstep : cB;
        for (int t = 0; t < nt; t += 2) {
            const bool last = (t == nt - 2);
            const char* a1 = cA + (size_t)(t + 1) * kstep;
            const char* a2 = last ? nA : cA + (size_t)(t + 2) * kstep; const char* b2 = last ? nB : cB + (size_t)(t + 2) * kstep;
            const char* a3 = a2 + kstep; const char* b3 = b2 + kstep;
            if (last && has_next) S.a_ready(nxt);
            if constexpr (SP2) {
            PG8_LDB(B0, 0, 0); PG8_LDB(B1, 0, 1); PG8_SCHED; PG8_LDA(At, 0, 0); PG8_STAGE(PG8_SA(1, 1), a1 + hstep, voffA);
            PG8_WAIT_V(8); PG8_WAIT_L(0); PG8_BAR; PG8_MMA(0, 0, At, B0); PG8_MMA(0, 1, At, B1); PG8_BAR; PG8_SCHED;
            PG8_LDA(At, 0, 1); PG8_STAGE(PG8_SB(0, 0), b2, voffB); PG8_STAGE(PG8_SB(0, 1), b2 + hstep, voffB); PG8_STAGE(PG8_SA(0, 0), a2, voffA);
            PG8_WAIT_V(8); PG8_WAIT_L(0); PG8_BAR; PG8_MMA(1, 0, At, B0); PG8_MMA(1, 1, At, B1); PG8_BAR; PG8_SCHED;
            PG8_LDB(B0, 1, 0); PG8_LDB(B1, 1, 1); PG8_SCHED; PG8_LDA(At, 1, 0); PG8_STAGE(PG8_SA(0, 1), a2 + hstep, voffA);
            PG8_WAIT_V(8); PG8_WAIT_L(0); PG8_BAR; PG8_MMA(0, 0, At, B0); PG8_MMA(0, 1, At, B1); PG8_BAR; PG8_SCHED;
            PG8_LDA(At, 1, 1); PG8_STAGE(PG8_SB(1, 0), b3, voffB); PG8_STAGE(PG8_SB(1, 1), b3 + hstep, voffB); PG8_STAGE(PG8_SA(1, 0), a3, voffA);
            PG8_WAIT_V(8); PG8_WAIT_L(0); PG8_BAR; PG8_MMA(1, 0, At, B0); PG8_MMA(1, 1, At, B1); PG8_BAR; PG8_SCHED;
            } else {
            PG8_LDB(B0, 0, 0); PG8_SCHED; PG8_LDA(At, 0, 0); PG8_STAGE(PG8_SA(1, 1), a1 + hstep, voffA);
            PG8_WAIT_L(8); PG8_BAR; PG8_WAIT_L(0); PG8_MMA(0, 0, At, B0); PG8_BAR; PG8_SCHED;
            PG8_LDB(B1, 0, 1); PG8_STAGE(PG8_SB(0, 0), b2, voffB);
            PG8_BAR; PG8_WAIT_L(0); PG8_MMA(0, 1, At, B1); PG8_BAR;
            PG8_LDA(At, 0, 1); PG8_STAGE(PG8_SA(0, 0), a2, voffA);
            PG8_BAR; PG8_WAIT_L(0); PG8_MMA(1, 0, At, B0); PG8_BAR; PG8_SCHED;
            PG8_STAGE(PG8_SB(0, 1), b2 + hstep, voffB);
            PG8_WAIT_V(6); PG8_BAR; PG8_MMA(1, 1, At, B1); PG8_BAR;
            PG8_LDB(B0, 1, 0); PG8_SCHED; PG8_LDA(At, 1, 0); PG8_STAGE(PG8_SA(0, 1), a2 + hstep, voffA);
            PG8_WAIT_L(8); PG8_BAR; PG8_WAIT_L(0); PG8_MMA(0, 0, At, B0); PG8_BAR; PG8_SCHED;
            PG8_LDB(B1, 1, 1); PG8_STAGE(PG8_SB(1, 0), b3, voffB);
            PG8_BAR; PG8_WAIT_L(0); PG8_MMA(0, 1, At, B1); PG8_BAR;
            PG8_LDA(At, 1, 1); PG8_STAGE(PG8_SA(1, 0), a3, voffA);
            PG8_BAR; PG8_WAIT_L(0); PG8_MMA(1, 0, At, B0); PG8_BAR; PG8_SCHED;
            PG8_STAGE(PG8_SB(1, 1), b3 + hstep, voffB);
            PG8_WAIT_V(6); PG8_BAR; PG8_MMA(1, 1, At, B1); PG8_BAR;
            }
        }
        if constexpr (ALIGN_EPI) { if (wr == 0) PG8_BAR; }
        if constexpr (!Epi::AFTER_DRAIN) { E(acc, cur, wr, wc, fr, fq); S.done(cur); }
        if (!has_next) break;
#pragma unroll
        for (int a = 0; a < 2; ++a)
#pragma unroll
            for (int b = 0; b < 2; ++b)
#pragma unroll
                for (int m = 0; m < 4; ++m)
#pragma unroll
                    for (int n = 0; n < 2; ++n) acc[a][b][m][n] = (f32x4){0.f, 0.f, 0.f, 0.f};
        cur = nxt; cA = nA; cB = nB; ++ui;
        if constexpr (ALIGN_EPI) { if (wr == 1) PG8_BAR; }
    }
    PG8_WAIT_V(0);
    if constexpr (!ALIGN_EPI) { if (wr == 0) PG8_BAR; }
    PG8_BAR;
    if constexpr (Epi::AFTER_DRAIN) { E.fused(acc, cur, wr, wc, fr, fq, lds, wid, lane); S.done(cur); }
#undef PG8_SA
#undef PG8_SB
#undef PG8_STAGE
#undef PG8_LDA
#undef PG8_LDB
#undef PG8_MMA
#undef PG8_WAIT_V
#undef PG8_WAIT_L
#undef PG8_BAR
#undef PG8_SCHED
}
}


template <int NW>
__device__ __forceinline__ void side16_dot(const float* AT, const float* W, int ldw, int K, const int (&col)[NW], const float* gk, LAS float* red, float (&res)[NW]) {
    const int tid = threadIdx.x, lane = tid & 63, w = tid >> 6, c = lane & 15, kq = lane >> 4;
    float acc[NW][16];
#pragma unroll
    for (int wi = 0; wi < NW; ++wi)
#pragma unroll
        for (int r = 0; r < 16; ++r) acc[wi][r] = 0.f;
    const int ks = K >> 3, kbeg = w * ks;
#pragma unroll 8
    for (int k = kbeg + kq; k < kbeg + ks; k += 4) {
        const f32x4 a0 = *(const f32x4*)(AT + (size_t)k * 16), a1 = *(const f32x4*)(AT + (size_t)k * 16 + 4), a2 = *(const f32x4*)(AT + (size_t)k * 16 + 8), a3 = *(const f32x4*)(AT + (size_t)k * 16 + 12);
        const float gs = gk ? gk[k] : 1.f;
#pragma unroll
        for (int wi = 0; wi < NW; ++wi) { const float wv = (col[wi] >= 0) ? W[(size_t)k * ldw + col[wi]] * gs : 0.f;
            acc[wi][0] += a0.x * wv; acc[wi][1] += a0.y * wv; acc[wi][2] += a0.z * wv; acc[wi][3] += a0.w * wv; acc[wi][4] += a1.x * wv; acc[wi][5] += a1.y * wv; acc[wi][6] += a1.z * wv; acc[wi][7] += a1.w * wv;
            acc[wi][8] += a2.x * wv; acc[wi][9] += a2.y * wv; acc[wi][10] += a2.z * wv; acc[wi][11] += a2.w * wv; acc[wi][12] += a3.x * wv; acc[wi][13] += a3.y * wv; acc[wi][14] += a3.z * wv; acc[wi][15] += a3.w * wv; }
    }
#pragma unroll
    for (int wi = 0; wi < NW; ++wi)
#pragma unroll
        for (int r = 0; r < 16; ++r) { float v = acc[wi][r]; v += __shfl_xor(v, 16); v += __shfl_xor(v, 32); if (kq == 0) red[((wi * 8 + w) * 16 + r) * 16 + c] = v; }
    __syncthreads();
    if (tid < 256) {
#pragma unroll
        for (int wi = 0; wi < NW; ++wi) { float v = 0.f;
#pragma unroll
            for (int ww = 0; ww < 8; ++ww) v += red[(wi * 8 + ww) * 256 + tid];
            res[wi] = v; }
    }
    __syncthreads();
}
__device__ __forceinline__ void side_stage1(const Params& P, LAS float* red, int t) {
    const int tid = threadIdx.x, c = tid & 15;
    const int col[2] = {16 * t + c, DFF + 16 * t + c}; float res[2];
    side16_dot<2>((const float*)(P.ws + WS_AT0), P.in[3], NGU, D, col, nullptr, red, res);
    if (tid < 256) { const int r = tid >> 4, cc = tid & 15; const float g = res[0], u = res[1]; ((float*)(P.ws + WS_ACTT))[(16 * t + cc) * 16 + r] = g * u / (1.f + __expf(-g)); }
}
__device__ __forceinline__ void side_stage2(const Params& P, LAS float* red, int t) {
    const int tid = threadIdx.x, c = tid & 15;
    const int col[1] = {16 * t + c}; float res[1];
    side16_dot<1>((const float*)(P.ws + WS_ACTT), P.in[4], D, DFF, col, nullptr, red, res);
    if (tid < 256) { const int r = tid >> 4, cc = tid & 15, n = 16 * t + cc; const float h1 = P.in[1][(size_t)r * D + n] + 0.5f * res[0];
        ((float*)(P.ws + WS_H1T))[n * 16 + r] = h1;
        float q = h1 * h1; q += __shfl_xor(q, 1); q += __shfl_xor(q, 2); q += __shfl_xor(q, 4); q += __shfl_xor(q, 8);
        if (cc == 0) unsafeAtomicAdd((float*)(P.ws + WS_SSQM) + r, q); }
}
__device__ __forceinline__ void side_stage3(const Params& P, LAS float* red, int t) {
    const int tid = threadIdx.x, c = tid & 15;
    const int kind = (t >= 128) ? 4 : (t >> 5);
    const int n0 = (kind == 0) ? 512 + 16 * t : (kind == 1) ? 1024 + 16 * (t - 32) : (kind == 2) ? 2048 + 16 * (t - 64) : (kind == 3) ? 2560 + 16 * (t - 96) : 3072;
    const int col[1] = {(n0 + c < NIN) ? n0 + c : -1}; float res[1];
    side16_dot<1>((const float*)(P.ws + WS_H1T), P.in[6], NIN, D, col, P.in[5], red, res);
    float v = 0.f; int r = 0, cc = 0;
    if (tid < 256) { r = tid >> 4; cc = tid & 15; v = res[0] * rsqrtf(((const float*)(P.ws + WS_SSQM))[r] * (1.0f / D) + RMS_EPS); red[tid] = v; }
    __syncthreads();
    if (tid < 256) {
        const int n = n0 + cc; const int p = NPAD + r;
        bf16_t* QK = (bf16_t*)(P.ws + WS_BIG); bf16_t* VT = (bf16_t*)(P.ws + WS_VT); float* logf = (float*)(P.ws + WS_LOGF);
        if (kind == 0 || kind == 2) {
            float o = v;
            if (kind == 0 && (n & 63) < 16) { const float pr = red[tid ^ 8]; const float* cs = (const float*)(P.ws + WS_ROPE) + (size_t)r * 16 + 2 * (n & 7);
                o = ((n & 63) < 8) ? v * cs[0] - pr * cs[1] : v * cs[0] + pr * cs[1]; }
            const int dst = (kind == 0) ? n : n - 512;
            for (int b = 0; b < BATCH; ++b) QK[((size_t)b * LP + p) * QKW + dst] = (bf16_t)f2bf(o);
        } else if (kind == 1 || kind == 3) {
            const int vcol = (kind == 1) ? n - 1024 : n - 2560 + 512;
            for (int b = 0; b < BATCH; ++b) VT[((size_t)b * 1024 + vcol) * LP + p] = (bf16_t)f2bf(v);
        } else if (cc < 8) {
            const float x = v + P.in[7][cc]; const float lf = fminf(x, 0.f) - log1pf(__expf(-fabsf(x)));
            for (int b = 0; b < BATCH; ++b) logf[((size_t)b * LP + p) * 8 + cc] = lf;
        }
    }
    __syncthreads();
}


__device__ __forceinline__ void gates_rows(const Params& P, int widx, int nw, int lane) {
    typedef short bf16x8 __attribute__((ext_vector_type(8))); typedef float f32x16 __attribute__((ext_vector_type(16)));
    const bf16_t* HB = (const bf16_t*)P.out; const bf16_t* WG = (const bf16_t*)(P.ws + WS_WIN) + (size_t)3072 * D;
    const float* ssq1 = (const float*)(P.ws + WS_SSQ) + TP; float* logf = (float*)(P.ws + WS_LOGF); const float* bfg = P.in[7];
    const int ql = lane & 31, hi = lane >> 5;
    for (int t = widx; t < 1024; t += nw) {
        const int lt = t >> 3, row0 = (lt + (lt >> 5) + 1) * 256 + (t & 7) * 32;
        const bf16_t* ap = WG + (size_t)ql * D + 8 * hi; const bf16_t* bp = HB + (size_t)(row0 + ql) * D + 8 * hi;
        f32x16 acc;
#pragma unroll
        for (int r = 0; r < 16; ++r) acc[r] = 0.f;
#pragma unroll 16
        for (int ks = 0; ks < 64; ++ks) { const bf16x8 a = *(const bf16x8*)(ap + 16 * ks), b = *(const bf16x8*)(bp + 16 * ks); acc = __builtin_amdgcn_mfma_f32_32x32x16_bf16(a, b, acc, 0, 0, 0); }
        const int row = row0 + ql; const float rstd = row_rstd(ssq1, row);
        f32x4 o;
#pragma unroll
        for (int j = 0; j < 4; ++j) { const float x = acc[j] * rstd + bfg[4 * hi + j]; o[j] = fminf(x, 0.f) - log1pf(__expf(-fabsf(x))); }
        *(f32x4*)(logf + (size_t)row * 8 + 4 * hi) = o;
    }
}

struct LiveOrder {
    pg8::StaticOrder S;
    __device__ void init(int N, int G, int c) { S.init(128 * 256, N, G, c); }
    __device__ bool next(int i, pg8::Unit& u) const { if (!S.next(i, u)) return false; u.pm = u.pm + (u.pm >> 5) + 1; return true; }
    __device__ __forceinline__ void a_ready(const pg8::Unit&) const {}
    __device__ __forceinline__ void done(const pg8::Unit&) const {}
};
__device__ __forceinline__ F8 acc8(const f32x4 (&acc)[2][2][4][2], int ai, int bj, int m) {
    F8 r; const f32x4 a = acc[ai][bj][m][0], b = acc[ai][bj][m][1];
    r.v[0] = a[0]; r.v[1] = a[1]; r.v[2] = a[2]; r.v[3] = a[3]; r.v[4] = b[0]; r.v[5] = b[1]; r.v[6] = b[2]; r.v[7] = b[3]; return r;
}
struct PgSwiglu {
    static constexpr bool PERM = true, AFTER_DRAIN = false;
    const float* ssq_in; bf16_t* ACT;
    __device__ __forceinline__ void operator()(const f32x4 (&acc)[2][2][4][2], const pg8::Unit& u, int wr, int wc, int fr, int fq) const {
        const EpiSwiglu E{nullptr, ACT};
        const int col = u.pn * 128 + wc * 32 + 8 * fq;
        float rs[2][4];
#pragma unroll
        for (int ai = 0; ai < 2; ++ai)
#pragma unroll
            for (int m = 0; m < 4; ++m) rs[ai][m] = ssq_in[u.pm * 256 + ai * 128 + wr * 64 + m * 16 + fr];
#pragma unroll
        for (int ai = 0; ai < 2; ++ai)
#pragma unroll
            for (int m = 0; m < 4; ++m) rs[ai][m] = rsqrtf(rs[ai][m] * (1.0f / D) + RMS_EPS);
#pragma unroll
        for (int ai = 0; ai < 2; ++ai)
#pragma unroll
            for (int m = 0; m < 4; ++m) { const int row = u.pm * 256 + ai * 128 + wr * 64 + m * 16 + fr;
                E(row, col, acc8(acc, ai, 0, m), acc8(acc, ai, 1, m), rs[ai][m]); }
    }
};
struct PgResid {
    static constexpr bool PERM = true, AFTER_DRAIN = false;
    EpiResid E; float* ssq_out;
    __device__ __forceinline__ void operator()(const f32x4 (&acc)[2][2][4][2], const pg8::Unit& u, int wr, int wc, int fr, int fq) const {
#pragma unroll
        for (int ai = 0; ai < 2; ++ai) {
            F8 bs[4][2];
#pragma unroll
            for (int m = 0; m < 4; ++m)
#pragma unroll
                for (int bj = 0; bj < 2; ++bj) bs[m][bj] = E.load(u.pm * 256 + ai * 128 + wr * 64 + m * 16 + fr, u.pn * 256 + bj * 128 + wc * 32 + 8 * fq);
#pragma unroll
            for (int m = 0; m < 4; ++m) { const int row = u.pm * 256 + ai * 128 + wr * 64 + m * 16 + fr; float s = 0.f;
#pragma unroll
                for (int bj = 0; bj < 2; ++bj) s += E.finish(row, u.pn * 256 + bj * 128 + wc * 32 + 8 * fq, acc8(acc, ai, bj, m), bs[m][bj]);
                s += __shfl_xor(s, 16); s += __shfl_xor(s, 32);
                if (fq == 0) unsafeAtomicAdd(ssq_out + row, s); }
        }
    }
};
struct PgInproj {
    static constexpr bool PERM = true, AFTER_DRAIN = false;
    EpiInproj E; const float* ssq_in;
    __device__ __forceinline__ void operator()(const f32x4 (&acc)[2][2][4][2], const pg8::Unit& u, int wr, int wc, int fr, int fq) const {
        const bool rope_tile = u.pn < 4;
        float rs[2][4];
        if (rope_tile) {
            const bool need = ((wc & 1) == 0) && (fq < 2);
            float rr[2][4];
#pragma unroll
            for (int ai = 0; ai < 2; ++ai)
#pragma unroll
                for (int m = 0; m < 4; ++m) rr[ai][m] = ssq_in[u.pm * 256 + ai * 128 + wr * 64 + m * 16 + fr];
#pragma unroll
            for (int ah = 0; ah < 4; ++ah) {
                const int ai = ah >> 1, m0 = (ah & 1) * 2;
                f32x4 cst[2][4];
#pragma unroll
                for (int mm = 0; mm < 2; ++mm) { const int p = (u.pm * 256 + ai * 128 + wr * 64 + (m0 + mm) * 16 + fr) % LP; const f32x4* cp = (const f32x4*)(E.rope + (size_t)(need ? p - NPAD : 0) * 16);
#pragma unroll
                    for (int i = 0; i < 4; ++i) cst[mm][i] = need ? cp[i] : (f32x4){0.f, 0.f, 0.f, 0.f}; }
#pragma unroll
                for (int mm = 0; mm < 2; ++mm) { const int m = m0 + mm; const int row = u.pm * 256 + ai * 128 + wr * 64 + m * 16 + fr; const float rstd = rsqrtf(rr[ai][m] * (1.0f / D) + RMS_EPS);
#pragma unroll
                    for (int bj = 0; bj < 2; ++bj) { F8 v = acc8(acc, ai, bj, m), w;
#pragma unroll
                        for (int j = 0; j < 8; ++j) v.v[j] *= rstd;
#pragma unroll
                        for (int j = 0; j < 8; ++j) w.v[j] = __shfl_xor(v.v[j], 16);
                        E.qk_rope(row, u.pn * 256 + bj * 128 + wc * 32 + 8 * fq, v, w, cst[mm]); } }
            }
            return;
        }
#pragma unroll
        for (int ai = 0; ai < 2; ++ai)
#pragma unroll
            for (int m = 0; m < 4; ++m) rs[ai][m] = ssq_in[u.pm * 256 + ai * 128 + wr * 64 + m * 16 + fr];
#pragma unroll
        for (int ai = 0; ai < 2; ++ai)
#pragma unroll
            for (int m = 0; m < 4; ++m) rs[ai][m] = rsqrtf(rs[ai][m] * (1.0f / D) + RMS_EPS);
#pragma unroll
        for (int ai = 0; ai < 2; ++ai)
#pragma unroll
            for (int m = 0; m < 4; ++m) { const int row = u.pm * 256 + ai * 128 + wr * 64 + m * 16 + fr; const float rstd = rs[ai][m];
#pragma unroll
                for (int bj = 0; bj < 2; ++bj) { F8 v = acc8(acc, ai, bj, m), w;
#pragma unroll
                    for (int j = 0; j < 8; ++j) v.v[j] *= rstd;
                    if (rope_tile) {
#pragma unroll
                        for (int j = 0; j < 8; ++j) w.v[j] = __shfl_xor(v.v[j], 16);
                    } else w = v;
                    E(row, u.pn * 256 + bj * 128 + wc * 32 + 8 * fq, v, w); } }
    }
};


namespace fa {
typedef short bf16x8 __attribute__((ext_vector_type(8)));
typedef float f32x16 __attribute__((ext_vector_type(16)));
typedef unsigned u32x2 __attribute__((ext_vector_type(2)));
typedef float f32x2_t __attribute__((ext_vector_type(2))); typedef __bf16 bf16x2_t __attribute__((ext_vector_type(2)));
__device__ __forceinline__ unsigned cvtpk(float lo, float hi) { f32x2_t v = {lo, hi}; bf16x2_t b = __builtin_convertvector(v, bf16x2_t); return __builtin_bit_cast(unsigned, b); }
constexpr int KS = 272, VS = 272;
constexpr int OFF_K = 0, OFF_V = 128 * KS, OFF_CK = OFF_V + 128 * VS, BUF = OFF_CK + 1024;
constexpr int OFF_X = 0, OFF_UNIT = 2 * BUF;
constexpr int NUNITS = 64 * 32, KT0 = 3;
static_assert(65536 <= BUF && OFF_UNIT + 64 <= 147456, "fa LDS map");
#define FA_MFMA(a, b, c) __builtin_amdgcn_mfma_f32_32x32x16_bf16((a), (b), (c), 0, 0, 0)
__device__ __forceinline__ float max3f(float a, float b, float c) { return __builtin_fmaxf(__builtin_fmaxf(a, b), c); }

template <bool DIFF>
__device__ __forceinline__ void unit(const Params& P, LAS unsigned char* L, int b, int hu, int qb, float lam) {
    constexpr int NDB = DIFF ? 4 : 2;
    const int tid = threadIdx.x, lane = tid & 63, w = __builtin_amdgcn_readfirstlane(tid >> 6), g = w >> 2, wq = w & 3, ql = lane & 31, hi = lane >> 5;
    const bf16_t* QK = (const bf16_t*)(P.ws + WS_BIG); const bf16_t* VT = (const bf16_t*)(P.ws + WS_VT); const float* cum = (const float*)(P.ws + WS_CUM);
    bf16_t* AO = (bf16_t*)(P.ws + WS_AO);
    const int qbw = DIFF ? qb : 2 * qb + g;
    const int st_top = DIFF ? qb : 2 * qb + 1;
    const int qcol = DIFF ? hu * 128 + g * 64 : 1024 + hu * 64;
    const int kcol0 = DIFF ? 512 + hu * 128 : 1536 + hu * 64;
    const int vcol0 = DIFF ? hu * 128 : 512 + hu * 64;
    const int q_abs = 128 * qbw + 32 * wq + ql;
    const size_t qrow = (size_t)b * LP + q_abs;
    bf16x8 qf[4];
#pragma unroll
    for (int ds = 0; ds < 4; ++ds) qf[ds] = *(const bf16x8*)(QK + qrow * QKW + qcol + 16 * ds + 8 * hi);
    const float cq = DIFF ? 0.f : cum[((size_t)b * 8 + hu) * LP + q_abs];
    const bf16_t* kg = DIFF ? QK + ((size_t)b * LP + (tid >> 4)) * QKW + kcol0 + 8 * (tid & 15) : QK + ((size_t)b * LP + (tid >> 3)) * QKW + kcol0 + 8 * (tid & 7);
    const int kl = DIFF ? (tid >> 4) * KS + 16 * (tid & 15) : (tid >> 3) * KS + 16 * (tid & 7);
    const bf16_t* vg = VT + ((size_t)b * 1024 + vcol0 + (tid >> 4)) * LP + 8 * (tid & 15);
    const int vl = (tid >> 4) * VS + 16 * (tid & 15);
    const float* cgp = cum + ((size_t)b * 8 + hu) * LP + (tid & 127);
    u32x4 rk0, rk1, rk2, rk3, rv0, rv1, rv2, rv3; float rc = 0.f;
#define FA_LOAD(st) do { const bf16_t* kp_ = kg + (size_t)(128 * (st)) * QKW; const bf16_t* vp_ = vg + 128 * (st); \
        if (DIFF) { rk0 = *(const u32x4*)(kp_); rk1 = *(const u32x4*)(kp_ + (size_t)32 * QKW); rk2 = *(const u32x4*)(kp_ + (size_t)64 * QKW); rk3 = *(const u32x4*)(kp_ + (size_t)96 * QKW); \
            rv0 = *(const u32x4*)(vp_); rv1 = *(const u32x4*)(vp_ + (size_t)32 * LP); rv2 = *(const u32x4*)(vp_ + (size_t)64 * LP); rv3 = *(const u32x4*)(vp_ + (size_t)96 * LP); } \
        else { rk0 = *(const u32x4*)(kp_); rk1 = *(const u32x4*)(kp_ + (size_t)64 * QKW); rv0 = *(const u32x4*)(vp_); rv1 = *(const u32x4*)(vp_ + (size_t)32 * LP); if (tid < 128) rc = cgp[128 * (st)]; } } while (0)
#define FA_STORE(bo) do { LAS unsigned char* kd_ = L + (bo) + OFF_K + kl; LAS unsigned char* vd_ = L + (bo) + OFF_V + vl; \
        if (DIFF) { *(LAS u32x4*)(kd_) = rk0; *(LAS u32x4*)(kd_ + 32 * KS) = rk1; *(LAS u32x4*)(kd_ + 64 * KS) = rk2; *(LAS u32x4*)(kd_ + 96 * KS) = rk3; \
            *(LAS u32x4*)(vd_) = rv0; *(LAS u32x4*)(vd_ + 32 * VS) = rv1; *(LAS u32x4*)(vd_ + 64 * VS) = rv2; *(LAS u32x4*)(vd_ + 96 * VS) = rv3; } \
        else { *(LAS u32x4*)(kd_) = rk0; *(LAS u32x4*)(kd_ + 64 * KS) = rk1; *(LAS u32x4*)(vd_) = rv0; *(LAS u32x4*)(vd_ + 32 * VS) = rv1; if (tid < 128) *(LAS float*)(L + (bo) + OFF_CK + 4 * tid) = rc; } } while (0)
    const int pim = (ql & 0x13) | ((ql & 4) << 1) | ((ql & 8) >> 1);
    const int ka = pim * KS + ((DIFF ? 64 * g : 0) + 8 * hi) * 2;
    const int va = ql * VS + 16 * hi;
    float m_ref = 0.f, l = 0.f;
    bool first = true;
    f32x16 oacc[NDB];
#pragma unroll
    for (int db = 0; db < NDB; ++db)
#pragma unroll
        for (int r = 0; r < 16; ++r) oacc[db][r] = 0.f;
    f32x16 negm, lacc;
#pragma unroll
    for (int r = 0; r < 16; ++r) { negm[r] = 0.f; lacc[r] = 0.f; }
    bf16x8 onesf;
#pragma unroll
    for (int j = 0; j < 8; ++j) onesf[j] = (ql == 0) ? (short)0x3F80 : (short)0;
    LAS float* qnw = (LAS float*)(L + OFF_UNIT + 16);
    if (!DIFF) {
        float q2 = 0.f;
#pragma unroll
        for (int ds = 0; ds < 4; ++ds) { const u32x4 w = __builtin_bit_cast(u32x4, qf[ds]); const float a0 = bflo(w.x), a1 = bfhi(w.x), a2 = bflo(w.y), a3 = bfhi(w.y), a4 = bflo(w.z), a5 = bfhi(w.z), a6 = bflo(w.w), a7 = bfhi(w.w);
            q2 += (a0 * a0 + a1 * a1) + (a2 * a2 + a3 * a3) + (a4 * a4 + a5 * a5) + (a6 * a6 + a7 * a7); }
        q2 += __shfl_xor(q2, 32);
#pragma unroll
        for (int o = 1; o < 32; o <<= 1) q2 = fmaxf(q2, __shfl_xor(q2, o));
        if (lane == 0) qnw[w] = q2;
    }
    FA_LOAD(st_top); FA_STORE(0);
    __syncthreads();
    asm volatile("" : "+v"(qf[0]), "+v"(qf[1]), "+v"(qf[2]), "+v"(qf[3]));
    float cqp = cq; asm volatile("" : "+v"(cqp));
    int st_end = 0;
    if (!DIFF) {
        float qn2 = qnw[0];
#pragma unroll
        for (int i = 1; i < 8; ++i) qn2 = fmaxf(qn2, qnw[i]);
        const float* cs = cum + ((size_t)b * 8 + hu) * LP;
        const float base = 2.0f * 1.001f * sqrtf(qn2) * ((const float*)(P.ws + WS_KNMAX))[b * 8 + hu] + cs[256 * qb] + 2.0f;
        const int sti = st_top - lane;
        const bool dead = (sti >= 1) && (base - cs[128 * (sti > 0 ? sti : 1) + 127] < -150.0f);
        const unsigned long long mask = __ballot(dead);
        if (mask) st_end = st_top - (int)__builtin_ctzll(mask);
        st_end = __builtin_amdgcn_readfirstlane(st_end);
    }
    int bo = 0;
    for (int st = st_top; st > st_end; --st) {
        if (st - 1 > st_end) FA_LOAD(st - 1);
#pragma unroll
        for (int hh = 1; hh >= 0; --hh) {
        const int k0 = 128 * st + 64 * hh;
        if (k0 + 63 >= NPAD && k0 <= 128 * qbw + 32 * wq + 31) {
            const LAS unsigned char* Kb = L + bo + OFF_K + 64 * hh * KS; const LAS unsigned char* Vb = L + bo + OFF_V + 128 * hh;
            f32x16 s0, s1;
            __builtin_amdgcn_s_setprio(1);
            if (DIFF) {
                const bf16x8 a0 = *(const LAS bf16x8*)(Kb + ka), a1 = *(const LAS bf16x8*)(Kb + ka + 32 * KS);
                s0 = FA_MFMA(a0, qf[0], negm); s1 = FA_MFMA(a1, qf[0], negm);
            } else {
                const float cqm = cqp - m_ref;
                const LAS float* ck = (const LAS float*)(L + bo + OFF_CK) + 64 * hh + 8 * hi;
#pragma unroll
                for (int t = 0; t < 2; ++t) { const f32x4 a = *(const LAS f32x4*)(ck + 16 * t), c = *(const LAS f32x4*)(ck + 16 * t + 4), d = *(const LAS f32x4*)(ck + 32 + 16 * t), e = *(const LAS f32x4*)(ck + 32 + 16 * t + 4);
#pragma unroll
                    for (int j = 0; j < 4; ++j) { s0[8 * t + j] = cqm - a[j]; s0[8 * t + 4 + j] = cqm - c[j]; s1[8 * t + j] = cqm - d[j]; s1[8 * t + 4 + j] = cqm - e[j]; } }
                const bf16x8 a0 = *(const LAS bf16x8*)(Kb + ka), a1 = *(const LAS bf16x8*)(Kb + ka + 32 * KS);
                s0 = FA_MFMA(a0, qf[0], s0); s1 = FA_MFMA(a1, qf[0], s1);
            }
#pragma unroll
            for (int ds = 1; ds < 4; ++ds) { const bf16x8 a0 = *(const LAS bf16x8*)(Kb + ka + 32 * ds), a1 = *(const LAS bf16x8*)(Kb + ka + 32 * KS + 32 * ds);
                s0 = FA_MFMA(a0, qf[ds], s0); s1 = FA_MFMA(a1, qf[ds], s1); }
            __builtin_amdgcn_s_setprio(0);
            if (k0 < NPAD || k0 + 63 > 128 * qbw + 32 * wq) {
#pragma unroll
                for (int r = 0; r < 16; ++r) { const int key = k0 + 16 * (r >> 3) + 8 * hi + (r & 7);
                    if (key > q_abs || key < NPAD) s0[r] = NEGBIG;
                    if (key + 32 > q_abs || key + 32 < NPAD) s1[r] = NEGBIG; }
            }
            float tm = max3f(s0[0], s0[1], s1[0]), tm2 = max3f(s0[2], s0[3], s1[1]); tm = max3f(tm, s1[2], s1[3]);
#pragma unroll
            for (int r = 4; r < 16; r += 4) { tm = max3f(tm, s0[r], s0[r + 1]); tm2 = max3f(tm2, s0[r + 2], s0[r + 3]); tm = max3f(tm, s1[r], s1[r + 1]); tm2 = max3f(tm2, s1[r + 2], s1[r + 3]); }
            tm = fmaxf(tm, tm2);
            { const auto rr = __builtin_amdgcn_permlane32_swap(__float_as_uint(tm), __float_as_uint(tm), false, false); tm = fmaxf(__uint_as_float(rr[0]), __uint_as_float(rr[1])); }
            float tmpost = tm;
            if (first || __any(tm > 8.0f)) {
                const float dl = first ? tm : fmaxf(tm, 0.f);
                m_ref += dl; tmpost = tm - dl;
                if (!first) { const float f = __builtin_amdgcn_exp2f(-dl); l *= f; lacc[0] *= f;
#pragma unroll
                    for (int db = 0; db < NDB; ++db)
#pragma unroll
                        for (int r = 0; r < 16; ++r) oacc[db][r] *= f; }
#pragma unroll
                for (int r = 0; r < 16; ++r) { s0[r] -= dl; s1[r] -= dl; }
                if (DIFF) {
#pragma unroll
                    for (int r = 0; r < 16; ++r) negm[r] = -m_ref;
                }
                first = false;
            }
            if (!__all(tmpost < -150.0f)) {
            float ps = 0.f, ps2 = 0.f;
#pragma unroll
            for (int r = 0; r < 16; ++r) { s0[r] = __builtin_amdgcn_exp2f(s0[r]); s1[r] = __builtin_amdgcn_exp2f(s1[r]); if (DIFF) { ps += s0[r]; ps2 += s1[r]; asm volatile("" : "+v"(ps), "+v"(ps2)); } }
            if (DIFF) l += ps + ps2;
            bf16x8 pb[4];
            { u32x4 t0 = {cvtpk(s0[0], s0[1]), cvtpk(s0[2], s0[3]), cvtpk(s0[4], s0[5]), cvtpk(s0[6], s0[7])}; pb[0] = __builtin_bit_cast(bf16x8, t0);
              u32x4 t1 = {cvtpk(s0[8], s0[9]), cvtpk(s0[10], s0[11]), cvtpk(s0[12], s0[13]), cvtpk(s0[14], s0[15])}; pb[1] = __builtin_bit_cast(bf16x8, t1);
              u32x4 t2 = {cvtpk(s1[0], s1[1]), cvtpk(s1[2], s1[3]), cvtpk(s1[4], s1[5]), cvtpk(s1[6], s1[7])}; pb[2] = __builtin_bit_cast(bf16x8, t2);
              u32x4 t3 = {cvtpk(s1[8], s1[9]), cvtpk(s1[10], s1[11]), cvtpk(s1[12], s1[13]), cvtpk(s1[14], s1[15])}; pb[3] = __builtin_bit_cast(bf16x8, t3); }
            __builtin_amdgcn_s_setprio(1);
#pragma unroll
            for (int ks = 0; ks < 4; ++ks) {
#pragma unroll
                for (int db = 0; db < NDB; ++db) { const bf16x8 av = *(const LAS bf16x8*)(Vb + va + 32 * db * VS + 32 * ks); oacc[db] = FA_MFMA(av, pb[ks], oacc[db]); }
                if (!DIFF) lacc = FA_MFMA(onesf, pb[ks], lacc);
            }
            __builtin_amdgcn_s_setprio(0);
            }
        }
        }
        if (st - 1 > st_end) FA_STORE(bo ^ BUF);
        __syncthreads();
        bo ^= BUF;
    }
#undef FA_LOAD
#undef FA_STORE
    if (DIFF) l += __shfl_xor(l, 32); else l = __shfl(lacc[0], ql);
    const float inv = (q_abs >= NPAD) ? 1.0f / l : 0.f;
    if (DIFF) {
        LAS float* X = (LAS float*)(L + OFF_X);
        if (g == 1) {
#pragma unroll
            for (int db = 0; db < NDB; ++db)
#pragma unroll
                for (int r = 0; r < 16; ++r) X[((wq * 4 + db) * 16 + r) * 64 + lane] = oacc[db][r] * inv;
        }
        __syncthreads();
        if (g == 0) {
            float ss = 0.f;
#pragma unroll
            for (int db = 0; db < NDB; ++db)
#pragma unroll
                for (int r = 0; r < 16; ++r) { const float c = oacc[db][r] * inv - lam * X[((wq * 4 + db) * 16 + r) * 64 + lane]; oacc[db][r] = c; ss += c * c; }
            ss += __shfl_xor(ss, 32);
            const float rr = rsqrtf(ss * (1.0f / 128.f) + SUBLN_EPS);
            bf16_t* dst = AO + qrow * D + hu * 128;
#pragma unroll
            for (int db = 0; db < NDB; ++db)
#pragma unroll
                for (int t = 0; t < 4; ++t) { const int d = 32 * db + 8 * t + 4 * hi;
                    u32x2 o; o.x = cvtpk(oacc[db][4 * t] * rr, oacc[db][4 * t + 1] * rr); o.y = cvtpk(oacc[db][4 * t + 2] * rr, oacc[db][4 * t + 3] * rr);
                    *(u32x2*)(dst + d) = o; }
        }
    } else {
        bf16_t* dst = AO + qrow * D + 512 + hu * 64;
#pragma unroll
        for (int db = 0; db < NDB; ++db)
#pragma unroll
            for (int t = 0; t < 4; ++t) { const int d = 32 * db + 8 * t + 4 * hi;
                u32x2 o; o.x = cvtpk(oacc[db][4 * t] * inv, oacc[db][4 * t + 1] * inv); o.y = cvtpk(oacc[db][4 * t + 2] * inv, oacc[db][4 * t + 3] * inv);
                *(u32x2*)(dst + d) = o; }
    }
}

__device__ __forceinline__ void phase(const Params& P, LAS unsigned char* L) {
    const int tid = threadIdx.x;
    unsigned* ctr = (unsigned*)(P.ws + WS_CTL) + 64;
    LAS int* su = (LAS int*)(L + OFF_UNIT);
    const float lam = ((const float*)(P.ws + WS_CTL))[0];
    const int x0 = (int)(__builtin_amdgcn_s_getreg((3 << 11) | 20) & 7u);
    int a = 0;
    for (;;) {
        const int x = (x0 + a) & 7;
        if (tid == 0) *su = (int)atomicAdd(ctr + 64 * x, 1u);
        __syncthreads();
        const int i = __builtin_amdgcn_readfirstlane(*su);
        __syncthreads();
        if (i >= 256) { if (++a == 8) break; continue; }
        if (i < 128) { const int d = 2 * x + (i & 1); unit<true>(P, L, d >> 2, d & 3, 65 - (i >> 1), lam); }
        else { const int j = i - 128; const int f = 4 * x + (j & 3); unit<false>(P, L, f >> 3, f & 7, 32 - (j >> 2), lam); }
    }
}
}

#ifndef FAST_ATTN
#define FAST_ATTN 1
#endif
template <bool DIFF> __global__ void __launch_bounds__(256) naive_attn(Params P) { naive_attn_body<DIFF>(P, threadIdx.x, blockIdx.x, blockIdx.y, blockIdx.z); }
#define XB_TMO      128
#define XB_XCNT(j)  (256  + 64 * (j))
#define XB_XSUB(j)  (1280 + 64 * (j))
#define XB_XGEN(j)  (2304 + 64 * (j))
#define XB_TOP      3328
#define XB_TOPGEN   3392
#define XCD_BAR_WORDS 3456
#define XB_SPIN_CAP (1u << 18)

__device__ __forceinline__ unsigned xb_ld(unsigned* p)              { return __hip_atomic_load(p, __ATOMIC_RELAXED, __HIP_MEMORY_SCOPE_AGENT); }
__device__ __forceinline__ unsigned xb_add(unsigned* p, unsigned v) { return __hip_atomic_fetch_add(p, v, __ATOMIC_RELAXED, __HIP_MEMORY_SCOPE_AGENT); }
__device__ __forceinline__ unsigned xb_xcc_id() { return (unsigned)__builtin_amdgcn_s_getreg((3 << 11) | 20) & 0xFu; }
#define XB_SPIN(cond, bar) do { unsigned _sp = 0; while (cond) { __builtin_amdgcn_s_sleep(1); \
    if ((++_sp & 255u) == 0u) { if (xb_ld(&(bar)[XB_TMO])) break; if (_sp > XB_SPIN_CAP) { atomicAdd(&(bar)[XB_TMO], 1u); break; } } } } while (0)

struct XcdBarrier {
    unsigned* bar; unsigned x;
    volatile LAS unsigned* st;
};

__device__ __forceinline__ XcdBarrier xcd_barrier_post(unsigned* bar, volatile LAS unsigned* st) {
    XcdBarrier b; b.bar = bar; b.x = xb_xcc_id(); b.st = st;
    if (threadIdx.x == 0) (void)xb_add(&bar[XB_XCNT(b.x)], 1u);
    return b;
}
__device__ __forceinline__ void xcd_barrier_complete(unsigned* bar, unsigned x, unsigned& nloc, unsigned& nx) {
    const unsigned G = gridDim.x * gridDim.y * gridDim.z;
    unsigned sum, cnt, mine, sp = 0u;
    for (;;) {
        sum = 0u; cnt = 0u; mine = 0u;
#pragma unroll
        for (unsigned j = 0; j < 16; ++j) { const unsigned c = xb_ld(&bar[XB_XCNT(j)]); sum += c; cnt += (c > 0u) ? 1u : 0u; mine = (j == x) ? c : mine; }
        if (sum == G) break;
        __builtin_amdgcn_s_sleep(1);
        if ((++sp & 255u) == 0u) { if (xb_ld(&bar[XB_TMO])) break; if (sp > XB_SPIN_CAP) { atomicAdd(&bar[XB_TMO], 1u); break; } }
    }
    nloc = mine > 0u ? mine : 1u; nx = cnt > 0u ? cnt : 1u;
}

__device__ __forceinline__ void xcd_barrier(const XcdBarrier& b) {
    asm volatile("s_waitcnt vmcnt(0)" ::: "memory");
    __syncthreads();
    if (threadIdx.x == 0) {
        unsigned* bar = b.bar;
        __builtin_amdgcn_s_waitcnt(0);
        unsigned nloc = b.st[0], nx = b.st[1];
        if (nloc == 0u) { xcd_barrier_complete(bar, b.x, nloc, nx); b.st[0] = nloc; b.st[1] = nx; }
        const unsigned old = xb_add(&bar[XB_XSUB(b.x)], 1u);
        const unsigned gen = old / nloc;
        if (old + 1u == (gen + 1u) * nloc) {
            __builtin_amdgcn_fence(__ATOMIC_RELEASE, "agent");
            asm volatile("s_waitcnt vmcnt(0)" ::: "memory");
            const unsigned og = xb_add(&bar[XB_TOP], 1u);
            const unsigned tg = og / nx;
            if (og + 1u == (tg + 1u) * nx) xb_add(&bar[XB_TOPGEN], 1u);
            else XB_SPIN(xb_ld(&bar[XB_TOPGEN]) == tg, bar);
            __builtin_amdgcn_fence(__ATOMIC_ACQUIRE, "agent");
            xb_add(&bar[XB_XGEN(b.x)], 1u);
            asm volatile("s_waitcnt vmcnt(0)" ::: "memory");
        } else {
            XB_SPIN(xb_ld(&bar[XB_XGEN(b.x)]) == gen, bar);
            __builtin_amdgcn_fence(__ATOMIC_ACQUIRE, "agent");
            asm volatile("s_waitcnt vmcnt(0)" ::: "memory");
        }
    }
    __syncthreads();
}

constexpr size_t WS_XBAR = 16 * 1024;
constexpr int LDS_XBST = 147456 - 64;
constexpr int LDS_BYTES = 147456;
constexpr int N_PHASES = 10;
#ifndef MK_PER_PHASE
#define MK_PER_PHASE 0
#endif

__global__ void __launch_bounds__(512, 2) mk(Params P) {
    extern __shared__ __attribute__((aligned(16))) unsigned char lds[];
    cg::grid_group grid = cg::this_grid();
    LAS unsigned char* L = (LAS unsigned char*)lds;
    const int tid = threadIdx.x, lane = tid & 63, wave = __builtin_amdgcn_readfirstlane(tid >> 6);
    const int G = gridDim.x, gw = blockIdx.x * 8 + wave, NGW = G * 8;
    unsigned char* ws = P.ws;
    float* ssq = (float*)(ws + WS_SSQ);
    bf16_t* HB = (bf16_t*)P.out; bf16_t* ACT = (bf16_t*)(ws + WS_BIG); bf16_t* QK = (bf16_t*)(ws + WS_BIG); bf16_t* VT = (bf16_t*)(ws + WS_VT); bf16_t* AO = (bf16_t*)(ws + WS_AO);
    float* H = (float*)(ws + WS_H);
    const int lo = P.ph_lo, hi = P.ph_hi;
#define IN(k) (lo <= (k) && (k) < hi)
    volatile LAS unsigned* xst = (volatile LAS unsigned*)(L + LDS_XBST);
    if (tid < 2) xst[tid] = 0u;
    __syncthreads();
    unsigned* xbar_words = (unsigned*)(ws + WS_XBAR);
    XcdBarrier xbar; xbar.bar = xbar_words; xbar.x = 0; xbar.st = xst;
    if (hi - lo > 1) xbar = xcd_barrier_post(xbar_words, xst);
    if (hi > 1000) grid.sync();
#define SEAM(k) do { if (IN(k) && IN((k) + 1)) xcd_barrier(xbar); } while (0)

    if (IN(0)) { p0_prologue(P, (LAS float*)(L + wave * 17408), gw, NGW, lane); }
    SEAM(0);
    if (IN(1)) {
        for (int t = blockIdx.x; t < DFF / 16; t += G) side_stage1(P, (LAS float*)L, t);
        pg8::Gemm g{HB, (const bf16_t*)(ws + WS_WGU1), TP, NGU, D}; LiveOrder S; S.init(NGU, G, (int)blockIdx.x);
        PgSwiglu E{ssq, ACT};
        pg8::gemm_phase<PgSwiglu, LiveOrder, true, true>(L, g, S, E);
    }
    SEAM(1);
    if (IN(2)) {
        for (int t = blockIdx.x; t < D / 16; t += G) side_stage2(P, (LAS float*)L, t);
        pg8::Gemm g{ACT, (const bf16_t*)(ws + WS_WD1), TP, D, DFF}; LiveOrder S; S.init(D, G, (int)blockIdx.x);
        PgResid E{EpiResid{&P, 1, 0.5f, nullptr, HB, nullptr}, ssq + (size_t)1 * TP};
        pg8::gemm_phase<PgResid, LiveOrder, true, true>(L, g, S, E);
    }
    SEAM(2);
    if (IN(3)) {
        zero_pad_kv(ws, gw, NGW, lane);
        for (int t = blockIdx.x; t < 129; t += G) side_stage3(P, (LAS float*)L, t);
        gates_rows(P, wave * G + (int)blockIdx.x, NGW, lane);
        pg8::Gemm g{HB, (const bf16_t*)(ws + WS_WIN), TP, 3072, D}; LiveOrder S; S.init(3072, G, (int)blockIdx.x);
        PgInproj E{EpiInproj{(const float*)(ws + WS_ROPE), P.in[7], QK, VT, (float*)(ws + WS_LOGF)}, ssq + (size_t)1 * TP};
        pg8::gemm_phase<PgInproj, LiveOrder, true, true>(L, g, S, E);
    }
    SEAM(3);
    if (IN(4)) {
        if (G >= 64) { if (blockIdx.x < 32) cum_scan_seq((const float*)(ws + WS_LOGF), (float*)(ws + WS_CUM), blockIdx.x, (LAS float*)L, tid);
                       else if (blockIdx.x < 64) key_norm_max(QK, (float*)(ws + WS_KNMAX), blockIdx.x - 32, (LAS float*)L, tid); }
        else { for (int bh = blockIdx.x; bh < 32; bh += G) { cum_scan_seq((const float*)(ws + WS_LOGF), (float*)(ws + WS_CUM), bh, (LAS float*)L, tid); key_norm_max(QK, (float*)(ws + WS_KNMAX), bh, (LAS float*)L, tid); } }
    }
    SEAM(4);
    if (IN(5)) {
#if FAST_ATTN
        fa::phase(P, L);
#endif
    }
    SEAM(5);
    if (IN(6)) {
        pg8::Gemm g{AO, (const bf16_t*)(ws + WS_WOUT), TP, D, D}; LiveOrder S; S.init(D, G, (int)blockIdx.x);
        PgResid E{EpiResid{&P, 0, 1.0f, nullptr, HB, HB}, ssq + (size_t)2 * TP};
        pg8::gemm_phase<PgResid, LiveOrder, true, true>(L, g, S, E);
    }
    SEAM(6);
    if (IN(7)) {
        pg8::Gemm g{HB, (const bf16_t*)(ws + WS_WGU2), TP, NGU, D}; LiveOrder S; S.init(NGU, G, (int)blockIdx.x);
        PgSwiglu E{ssq + (size_t)2 * TP, ACT};
        pg8::gemm_phase<PgSwiglu, LiveOrder, true, true>(L, g, S, E);
    }
    SEAM(7);
    if (IN(8)) {
        pg8::Gemm g{ACT, (const bf16_t*)(ws + WS_WD2), TP, D, DFF}; LiveOrder S; S.init(D, G, (int)blockIdx.x);
        PgResid E{EpiResid{&P, 0, 0.5f, H, nullptr, HB}, ssq + (size_t)3 * TP};
        pg8::gemm_phase<PgResid, LiveOrder, true, true>(L, g, S, E);
    }
    SEAM(8);
    if (IN(9)) final_norm_rows(P, gw, NGW, lane);
#undef IN
#undef SEAM
}

extern "C" void kernel_launch(void* const* d_in, const int* in_sizes, int n_in, void* d_out, int out_size, void* d_ws, size_t ws_size, hipStream_t stream) {
    if (n_in != 18 || out_size != BATCH * SEQ * D || ws_size < WS_END) { fprintf(stderr, "kernel_launch: unexpected shapes (n_in %d out %d ws %zu need %zu)\n", n_in, out_size, ws_size, (size_t)WS_END); return; }
    static int grid = 0;
    if (grid == 0) {
        int dev = 0, cus = 0, per_cu = 0;
        (void)hipGetDevice(&dev); (void)hipDeviceGetAttribute(&cus, hipDeviceAttributeMultiprocessorCount, dev);
        (void)hipFuncSetAttribute((const void*)mk, hipFuncAttributeMaxDynamicSharedMemorySize, LDS_BYTES);
        (void)hipOccupancyMaxActiveBlocksPerMultiprocessor(&per_cu, (const void*)mk, 512, LDS_BYTES);
        if (per_cu < 1) { fprintf(stderr, "kernel_launch: occupancy query says %d blocks per CU\n", per_cu); per_cu = 1; }
        grid = cus * per_cu;
    }
    Params P{};
    for (int i = 0; i < 18; ++i) P.in[i] = (const float*)d_in[i];
    P.out = (float*)d_out; P.ws = (unsigned char*)d_ws;
#if MK_PER_PHASE
    for (int ph = 0; ph < N_PHASES; ++ph) { P.ph_lo = ph; P.ph_hi = ph + 1;
        if (ph == 5 && !FAST_ATTN) { hipLaunchKernelGGL(naive_attn<true>, dim3(LP / 64, 4, BATCH), dim3(256), 0, stream, P); hipLaunchKernelGGL(naive_attn<false>, dim3(LP / 128, 8, BATCH), dim3(256), 0, stream, P); continue; }
        hipLaunchKernelGGL(mk, dim3(grid), dim3(512), LDS_BYTES, stream, P); }
#else
    P.ph_lo = 0; P.ph_hi = N_PHASES;
    if (hipMemsetAsync((unsigned char*)d_ws + WS_XBAR, 0, XCD_BAR_WORDS * 4, stream) != hipSuccess) { fprintf(stderr, "kernel_launch: memset of the barrier words failed\n"); return; }
    void* args[] = {&P};
    hipError_t e = hipLaunchCooperativeKernel((const void*)mk, dim3(grid), dim3(512), args, LDS_BYTES, stream);
    if (e != hipSuccess) fprintf(stderr, "cooperative launch failed: %s (grid %d)\n", hipGetErrorString(e), grid);
#endif
}
```

```cpp
#include <hip/hip_runtime.h>
#include <hip/hip_cooperative_groups.h>
namespace cg = cooperative_groups;
#include <cstdio>
#include <cstdint>

typedef unsigned short bf16_t;
typedef unsigned u32x4 __attribute__((ext_vector_type(4)));
typedef float f32x4 __attribute__((ext_vector_type(4)));
#define LAS __attribute__((address_space(3)))

constexpr int D = 1024, BATCH = 4, SEQ = 8192, NMETA = 16, NPAD = 240, REAL0 = 256, LP = 8448, TP = BATCH * LP;
constexpr int DFF = 2816, NGU = 2 * DFF, NIN = 3080, NINP = 3328;
constexpr int QKW = 2048;
constexpr float RMS_EPS = 1e-6f, SUBLN_EPS = 1e-5f, LAMBDA_INIT = 0.2f;
constexpr float QSCALE = 0.18033688011112042f;
constexpr float LOG2E = 1.4426950408889634f;
constexpr float NEGBIG = -1e30f;

constexpr size_t MiB = 1u << 20;
constexpr size_t WS_CTL = 0;
constexpr size_t WS_AT0 = 64 * 1024, WS_ACTT = 128 * 1024, WS_H1T = 320 * 1024, WS_SSQM = 384 * 1024;
constexpr size_t WS_SSQ = 1 * MiB;
constexpr size_t WS_LOGF = 4 * MiB;
constexpr size_t WS_CUM = 6 * MiB;
constexpr size_t WS_ROPE = 8 * MiB;
constexpr size_t WS_WGU1 = 9 * MiB, WS_WD1 = 20 * MiB, WS_WIN = 26 * MiB, WS_WOUT = 33 * MiB, WS_WGU2 = 35 * MiB, WS_WD2 = 46 * MiB;
constexpr size_t WS_H = 52 * MiB;
constexpr size_t WS_AO = 184 * MiB;
constexpr size_t WS_BIG = 250 * MiB;
constexpr size_t WS_VT = WS_BIG + 132 * MiB;
constexpr size_t WS_END = WS_BIG + 198 * MiB;

struct Params {
    const float* in[18];
    float* out; unsigned char* ws;
    int ph_lo, ph_hi;
};

__device__ __forceinline__ unsigned f2bf(float f) { unsigned u = __float_as_uint(f); return (u + 0x7fffu + ((u >> 16) & 1u)) >> 16; }
__device__ __forceinline__ unsigned pk2(float lo, float hi) { return f2bf(lo) | (f2bf(hi) << 16); }
__device__ __forceinline__ float bf2f(unsigned short b) { return __uint_as_float(((unsigned)b) << 16); }
__device__ __forceinline__ float bflo(unsigned w) { return __uint_as_float(w << 16); }
__device__ __forceinline__ float bfhi(unsigned w) { return __uint_as_float(w & 0xffff0000u); }
__device__ __forceinline__ float wave_sum(float v) {
#pragma unroll
    for (int o = 1; o < 64; o <<= 1) v += __shfl_xor(v, o);
    return v;
}
struct F8 { float v[8]; };

__device__ __forceinline__ void wconv_item(const float* W, const float* gvec, int K, int N, bf16_t* WT, int mode, LAS float* scr, int item, int nblk, int lane) {
    const int kb = item / nblk, nb = item % nblk, k0 = 64 * kb, n0 = 64 * nb;
    const int nl = 4 * (lane & 15);
    const int ng = n0 + nl;
    int sc; if (mode == 1) { const int pn = ng >> 8, w = ng & 255, bj = w >> 7, c = w & 127; sc = bj * DFF + 128 * pn + c; } else sc = ng;
    const bool valid = (mode != 2) || (ng < NIN);
#pragma unroll 8
    for (int i = 0; i < 16; ++i) { const int kk = 4 * i + (lane >> 4);
        f32x4 w = valid ? __builtin_nontemporal_load((const f32x4*)(W + (size_t)(k0 + kk) * N + sc)) : (f32x4){0.f, 0.f, 0.f, 0.f};
        if (gvec) { const int kx = k0 + kk; const float gs = (mode == 3) ? (kx < 512 ? gvec[kx & 127] * (1.0f - LAMBDA_INIT) : 1.0f) : gvec[kx]; w.x *= gs; w.y *= gs; w.z *= gs; w.w *= gs; }
        *(LAS f32x4*)(scr + kk * 68 + nl) = w; }
    asm volatile("s_waitcnt lgkmcnt(0)" ::: "memory");
    const int c = lane & 7;
#pragma unroll
    for (int j = 0; j < 8; ++j) { const int n = (lane >> 3) + 8 * j; const LAS float* sp = scr + (8 * c) * 68 + n;
        u32x4 o; o.x = pk2(sp[0 * 68], sp[1 * 68]); o.y = pk2(sp[2 * 68], sp[3 * 68]); o.z = pk2(sp[4 * 68], sp[5 * 68]); o.w = pk2(sp[6 * 68], sp[7 * 68]);
        *(u32x4*)(WT + (size_t)(n0 + n) * K + k0 + 8 * c) = o; }
    asm volatile("s_waitcnt lgkmcnt(0)" ::: "memory");
}

__device__ __forceinline__ const float* h0_row(const Params& P, int row) {
    const int b = row / LP, p = row % LP;
    if (p < NPAD) return nullptr;
    if (p < NPAD + NMETA) return P.in[1] + (size_t)(p - NPAD) * D;
    return P.in[0] + ((size_t)b * SEQ + (p - REAL0)) * D;
}

__device__ __forceinline__ void p0_prologue(const Params& P, LAS float* scr_wave, int gw, int NGW, int lane) {
    unsigned char* ws = P.ws;
    constexpr int I_GU = 16 * (NGU / 64), I_D = (DFF / 64) * (D / 64), I_IN = 16 * (NINP / 64), I_OUT = 16 * (D / 64);
    constexpr int NITEMS = 2 * I_GU + 2 * I_D + I_IN + I_OUT;
    for (int it = gw; it < NITEMS; it += NGW) {
        int r = it;
        if (r < I_GU) { wconv_item(P.in[3], P.in[2], D, NGU, (bf16_t*)(ws + WS_WGU1), 1, scr_wave, r, NGU / 64, lane); continue; } r -= I_GU;
        if (r < I_GU) { wconv_item(P.in[15], P.in[14], D, NGU, (bf16_t*)(ws + WS_WGU2), 1, scr_wave, r, NGU / 64, lane); continue; } r -= I_GU;
        if (r < I_D) { wconv_item(P.in[4], nullptr, DFF, D, (bf16_t*)(ws + WS_WD1), 0, scr_wave, r, D / 64, lane); continue; } r -= I_D;
        if (r < I_D) { wconv_item(P.in[16], nullptr, DFF, D, (bf16_t*)(ws + WS_WD2), 0, scr_wave, r, D / 64, lane); continue; } r -= I_D;
        if (r < I_IN) { wconv_item(P.in[6], P.in[5], D, NIN, (bf16_t*)(ws + WS_WIN), 2, scr_wave, r, NINP / 64, lane); continue; } r -= I_IN;
        wconv_item(P.in[13], P.in[12], D, D, (bf16_t*)(ws + WS_WOUT), 3, scr_wave, r, D / 64, lane);
    }
    float* ssq = (float*)(ws + WS_SSQ);
    bf16_t* HB = (bf16_t*)P.out;
    for (int row = gw; row < TP; row += 2 * NGW) {
        const int row2 = row + NGW; const bool has2 = row2 < TP;
        const float* src = h0_row(P, row); const float* src2 = has2 ? h0_row(P, row2) : nullptr;
        f32x4 v[4], u[4]; float s = 0.f, s2 = 0.f;
#pragma unroll
        for (int j = 0; j < 4; ++j) { v[j] = src ? *((const f32x4*)src + lane + 64 * j) : (f32x4){0.f, 0.f, 0.f, 0.f}; u[j] = src2 ? *((const f32x4*)src2 + lane + 64 * j) : (f32x4){0.f, 0.f, 0.f, 0.f}; }
#pragma unroll
        for (int j = 0; j < 4; ++j) { s += (v[j].x * v[j].x + v[j].y * v[j].y) + (v[j].z * v[j].z + v[j].w * v[j].w); s2 += (u[j].x * u[j].x + u[j].y * u[j].y) + (u[j].z * u[j].z + u[j].w * u[j].w); }
        s = wave_sum(s); s2 = wave_sum(s2);
        unsigned long long* o8 = (unsigned long long*)(HB + (size_t)row * D) + lane;
#pragma unroll
        for (int j = 0; j < 4; ++j) o8[64 * j] = (unsigned long long)pk2(v[j].x, v[j].y) | ((unsigned long long)pk2(v[j].z, v[j].w) << 32);
        if (lane < 4) ssq[(size_t)lane * TP + row] = (lane == 0) ? s : 0.f;
        if (has2) {
            unsigned long long* p8 = (unsigned long long*)(HB + (size_t)row2 * D) + lane;
#pragma unroll
            for (int j = 0; j < 4; ++j) p8[64 * j] = (unsigned long long)pk2(u[j].x, u[j].y) | ((unsigned long long)pk2(u[j].z, u[j].w) << 32);
            if (lane < 4) ssq[(size_t)lane * TP + row2] = (lane == 0) ? s2 : 0.f;
        }
    }
    float* rope = (float*)(ws + WS_ROPE);
    for (int e = gw * 64 + lane; e < (NMETA + SEQ) * 8; e += NGW * 64) {
        const int pos = e >> 3, i = e & 7;
        const double invf = (i == 0) ? 1.0 : (i == 1) ? 0.19392274474868576 : (i == 2) ? 0.03760603093086393 : (i == 3) ? 0.007292664737217109 :
                            (i == 4) ? 0.001414213562373095 : (i == 5) ? 0.0002742481756762073 : (i == 6) ? 5.318295896944988e-05 : 1.031338537721246e-05;
        double rev = (double)pos * invf * 0.15915494309189535; rev -= floor(rev);
        const float rf = (float)rev;
        rope[2 * e] = __builtin_amdgcn_cosf(rf); rope[2 * e + 1] = __builtin_amdgcn_sinf(rf);
    }
    if (gw >= 8 && gw < 8 + NMETA) {
        const int r = gw - 8; const float* src = P.in[1] + (size_t)r * D; const float* g1 = P.in[2]; float* AT0 = (float*)(ws + WS_AT0);
        float v[16]; float sq = 0.f;
#pragma unroll
        for (int j = 0; j < 16; ++j) { v[j] = src[lane + 64 * j]; sq += v[j] * v[j]; }
        const float rs = rsqrtf(wave_sum(sq) * (1.0f / D) + RMS_EPS);
#pragma unroll
        for (int j = 0; j < 16; ++j) { const int k = lane + 64 * j; AT0[k * 16 + r] = v[j] * rs * g1[k]; }
        if (lane == 0) ((float*)(ws + WS_SSQM))[r] = 0.f;
    }
    if (gw == 0) {
        const float a = wave_sum(P.in[8][lane] * P.in[9][lane]), b = wave_sum(P.in[10][lane] * P.in[11][lane]);
        if (lane == 0) { ((float*)(ws + WS_CTL))[0] = expf(a) - expf(b) + LAMBDA_INIT; ((unsigned*)(ws + WS_CTL))[16] = 0u; }
        if (lane < 8) ((unsigned*)(ws + WS_CTL))[64 + 64 * lane] = 0u;
    }
}

__device__ __forceinline__ void zero_pad_kv(unsigned char* ws, int gw, int NGW, int lane) {
    {
        float* logf = (float*)(ws + WS_LOGF); bf16_t* QKz = (bf16_t*)(ws + WS_BIG); bf16_t* VTz = (bf16_t*)(ws + WS_VT);
        for (int e = gw * 64 + lane; e < BATCH * NPAD * 8; e += NGW * 64) { const int b = e / (NPAD * 8), o = e % (NPAD * 8); logf[(size_t)b * LP * 8 + o] = 0.f; }
        for (int e = gw * 64 + lane; e < BATCH * 48 * (QKW / 8); e += NGW * 64) { const int b = e / (48 * (QKW / 8)), o = e % (48 * (QKW / 8)); *(u32x4*)(QKz + ((size_t)b * LP + 192) * QKW + (size_t)o * 8) = (u32x4){0u, 0u, 0u, 0u}; }
        for (int e = gw * 64 + lane; e < BATCH * 1024 * 6; e += NGW * 64) { const int bv = e / 6, o = e % 6; *(u32x4*)(VTz + (size_t)bv * LP + 192 + o * 8) = (u32x4){0u, 0u, 0u, 0u}; }
    }
}

__device__ __forceinline__ float row_rstd(const float* ssq, int row) { return rsqrtf(ssq[row] * (1.0f / D) + RMS_EPS); }

struct EpiSwiglu {
    const float* ssq; bf16_t* ACT;
    __device__ __forceinline__ void operator()(int row, int col, const F8& v, const F8& w, float rstd) const {
        float a[8];
        const float k1 = -LOG2E * rstd, k2 = rstd * rstd;
#pragma unroll
        for (int j = 0; j < 8; ++j) a[j] = (v.v[j] * w.v[j]) * (k2 * __builtin_amdgcn_rcpf(1.f + __builtin_amdgcn_exp2f(v.v[j] * k1)));
        u32x4 o; o.x = pk2(a[0], a[1]); o.y = pk2(a[2], a[3]); o.z = pk2(a[4], a[5]); o.w = pk2(a[6], a[7]);
        *(u32x4*)(ACT + (size_t)row * DFF + col) = o;
    }
};
struct EpiResid {
    const Params* P; int from_x; float scale; float* H; bf16_t* HB; const bf16_t* HBin;
    __device__ __forceinline__ F8 load(int row, int col) const {
        F8 r;
        if (from_x) { const float* src = h0_row(*P, row); f32x4 b0 = {0.f, 0.f, 0.f, 0.f}, b1 = b0; if (src) { b0 = __builtin_nontemporal_load((const f32x4*)(src + col)); b1 = __builtin_nontemporal_load((const f32x4*)(src + col + 4)); }
            r.v[0] = b0.x; r.v[1] = b0.y; r.v[2] = b0.z; r.v[3] = b0.w; r.v[4] = b1.x; r.v[5] = b1.y; r.v[6] = b1.z; r.v[7] = b1.w; }
        else { const u32x4 w = *(const u32x4*)(HBin + (size_t)row * D + col);
            r.v[0] = bflo(w.x); r.v[1] = bfhi(w.x); r.v[2] = bflo(w.y); r.v[3] = bfhi(w.y); r.v[4] = bflo(w.z); r.v[5] = bfhi(w.z); r.v[6] = bflo(w.w); r.v[7] = bfhi(w.w); }
        return r;
    }
    __device__ __forceinline__ float finish(int row, int col, const F8& v, const F8& bs) const {
        f32x4 h0 = {bs.v[0] + scale * v.v[0], bs.v[1] + scale * v.v[1], bs.v[2] + scale * v.v[2], bs.v[3] + scale * v.v[3]};
        f32x4 h1 = {bs.v[4] + scale * v.v[4], bs.v[5] + scale * v.v[5], bs.v[6] + scale * v.v[6], bs.v[7] + scale * v.v[7]};
        if (H) { *(f32x4*)(H + (size_t)row * D + col) = h0; *(f32x4*)(H + (size_t)row * D + col + 4) = h1; }
        if (HB) { u32x4 o; o.x = pk2(h0.x, h0.y); o.y = pk2(h0.z, h0.w); o.z = pk2(h1.x, h1.y); o.w = pk2(h1.z, h1.w); *(u32x4*)(HB + (size_t)row * D + col) = o; }
        return (h0.x * h0.x + h0.y * h0.y) + (h0.z * h0.z + h0.w * h0.w) + (h1.x * h1.x + h1.y * h1.y) + (h1.z * h1.z + h1.w * h1.w);
    }
    __device__ __forceinline__ float operator()(int row, int col, const F8& v) const { return finish(row, col, v, load(row, col)); }
};
struct EpiInproj {
    const float* rope; const float* bforget; bf16_t* QK; bf16_t* VT; float* logf;
    __device__ __forceinline__ void qk_rope(int row, int col, const F8& v, const F8& w, const f32x4 (&cs4)[4]) const {
        const int d = col & 63; float a[8];
#pragma unroll
        for (int j = 0; j < 8; ++j) a[j] = v.v[j];
        if (d < 16) {
#pragma unroll
            for (int j = 0; j < 8; ++j) { const float c = cs4[j >> 1][2 * (j & 1)], sn = cs4[j >> 1][2 * (j & 1) + 1]; a[j] = (d < 8) ? v.v[j] * c - w.v[j] * sn : v.v[j] * c + w.v[j] * sn; }
        }
        if (col < 512) {
#pragma unroll
            for (int j = 0; j < 8; ++j) a[j] *= QSCALE;
        }
        u32x4 o; o.x = pk2(a[0], a[1]); o.y = pk2(a[2], a[3]); o.z = pk2(a[4], a[5]); o.w = pk2(a[6], a[7]);
        *(u32x4*)(QK + (size_t)row * QKW + col) = o;
    }
    __device__ __forceinline__ void operator()(int row, int col, const F8& v, const F8& w) const {
        const int b = row / LP, p = row % LP;
        if (col < 1024 || (col >= 1536 && col < 2560)) {
            float a[8]; int dst;
#pragma unroll
            for (int j = 0; j < 8; ++j) a[j] = v.v[j];
            if (col < 1024) {
                const int d = col & 63;
                if (d < 16 && p >= NPAD) {
                    const float* cs = rope + (size_t)(p - NPAD) * 16;
#pragma unroll
                    for (int j = 0; j < 8; ++j) { const float c = cs[2 * j], s = cs[2 * j + 1]; a[j] = (d < 8) ? v.v[j] * c - w.v[j] * s : v.v[j] * c + w.v[j] * s; }
                }
                if (col < 512) {
#pragma unroll
                    for (int j = 0; j < 8; ++j) a[j] *= QSCALE;
                }
                dst = col;
            } else {
                if (col < 2048) {
#pragma unroll
                    for (int j = 0; j < 8; ++j) a[j] *= QSCALE;
                }
                dst = col - 512;
            }
            u32x4 o; o.x = pk2(a[0], a[1]); o.y = pk2(a[2], a[3]); o.z = pk2(a[4], a[5]); o.w = pk2(a[6], a[7]);
            *(u32x4*)(QK + (size_t)row * QKW + dst) = o;
        } else if (col < 3072) {
            const int vcol = (col < 1536) ? col - 1024 : col - 2560 + 512;
            bf16_t* dstp = VT + ((size_t)b * 1024 + vcol) * LP + p;
#pragma unroll
            for (int j = 0; j < 8; ++j) dstp[(size_t)j * LP] = (bf16_t)f2bf(v.v[j]);
        } else if (col == 3072) {
            f32x4 o0, o1; float r[8];
#pragma unroll
            for (int j = 0; j < 8; ++j) { const float x = v.v[j] + bforget[j]; r[j] = (p >= NPAD) ? (fminf(x, 0.f) - log1pf(__expf(-fabsf(x)))) : 0.f; }
            o0 = (f32x4){r[0], r[1], r[2], r[3]}; o1 = (f32x4){r[4], r[5], r[6], r[7]};
            *(f32x4*)(logf + (size_t)row * 8) = o0; *(f32x4*)(logf + (size_t)row * 8 + 4) = o1;
        }
    }
};

template <int MODE  >
__global__ void __launch_bounds__(256) naive_gemm(Params P, const bf16_t* A, const bf16_t* Bt, int K, int norm_in, int norm_out, int from_x, float scale, int writeHB) {
    const int row = blockIdx.x * 256 + threadIdx.x;
    const int c16 = blockIdx.y * 16;
    int n0;
    if (MODE == 0) { const int pn = c16 >> 7, c = c16 & 127; n0 = pn * 256 + c; } else n0 = c16;
    constexpr int NACC = (MODE == 0) ? 32 : 16;
    float acc[NACC];
#pragma unroll
    for (int i = 0; i < NACC; ++i) acc[i] = 0.f;
    const bf16_t* ap = A + (size_t)row * K;
    for (int k = 0; k < K; k += 8) {
        const u32x4 av = *(const u32x4*)(ap + k);
        float a[8] = {bflo(av.x), bfhi(av.x), bflo(av.y), bfhi(av.y), bflo(av.z), bfhi(av.z), bflo(av.w), bfhi(av.w)};
#pragma unroll
        for (int i = 0; i < NACC; ++i) {
            const int n = n0 + (i & 15) + ((i >> 4) << 7);
            const u32x4 bv = *(const u32x4*)(Bt + (size_t)n * K + k);
            acc[i] += a[0] * bflo(bv.x) + a[1] * bfhi(bv.x) + a[2] * bflo(bv.y) + a[3] * bfhi(bv.y) + a[4] * bflo(bv.z) + a[5] * bfhi(bv.z) + a[6] * bflo(bv.w) + a[7] * bfhi(bv.w);
        }
    }
    float* ssq = (float*)(P.ws + WS_SSQ);
    if (MODE == 0) {
        const float rstd = row_rstd(ssq + (size_t)norm_in * TP, row);
        EpiSwiglu E{nullptr, (bf16_t*)(P.ws + WS_BIG)};
        F8 g0, g1, u0, u1;
#pragma unroll
        for (int j = 0; j < 8; ++j) { g0.v[j] = acc[j]; g1.v[j] = acc[8 + j]; u0.v[j] = acc[16 + j]; u1.v[j] = acc[24 + j]; }
        E(row, c16, g0, u0, rstd); E(row, c16 + 8, g1, u1, rstd);
    } else if (MODE == 1) {
        EpiResid E{&P, from_x, scale, (float*)(P.ws + WS_H), writeHB ? (bf16_t*)P.out : nullptr};
        F8 v0, v1;
#pragma unroll
        for (int j = 0; j < 8; ++j) { v0.v[j] = acc[j]; v1.v[j] = acc[8 + j]; }
        const float s = E(row, c16, v0) + E(row, c16 + 8, v1);
        atomicAdd(ssq + (size_t)norm_out * TP + row, s);
    } else {
        const float rstd = row_rstd(ssq + (size_t)norm_in * TP, row);
        EpiInproj E{(const float*)(P.ws + WS_ROPE), P.in[7], (bf16_t*)(P.ws + WS_BIG), (bf16_t*)(P.ws + WS_VT), (float*)(P.ws + WS_LOGF)};
        F8 v0, v1;
#pragma unroll
        for (int j = 0; j < 8; ++j) { v0.v[j] = acc[j] * rstd; v1.v[j] = acc[8 + j] * rstd; }
        E(row, c16, v0, v1); E(row, c16 + 8, v1, v0);
    }
}

constexpr size_t WS_KNMAX = 448 * 1024;
__device__ __forceinline__ void key_norm_max(const bf16_t* QK, float* knmax, int bh, LAS float* sh, int tid) {
    const int b = bh >> 3, h = bh & 7; float mx = 0.f;
    for (int p = NPAD + tid; p < LP; p += 512) { const bf16_t* kr = QK + ((size_t)b * LP + p) * QKW + 1536 + h * 64; float q = 0.f;
#pragma unroll
        for (int i = 0; i < 8; ++i) { const u32x4 w = *(const u32x4*)(kr + 8 * i); const float a0 = bflo(w.x), a1 = bfhi(w.x), a2 = bflo(w.y), a3 = bfhi(w.y), a4 = bflo(w.z), a5 = bfhi(w.z), a6 = bflo(w.w), a7 = bfhi(w.w);
            q += (a0 * a0 + a1 * a1) + (a2 * a2 + a3 * a3) + (a4 * a4 + a5 * a5) + (a6 * a6 + a7 * a7); }
        mx = fmaxf(mx, q); }
#pragma unroll
    for (int o = 1; o < 64; o <<= 1) mx = fmaxf(mx, __shfl_xor(mx, o));
    if ((tid & 63) == 0) sh[tid >> 6] = mx;
    __syncthreads();
    if (tid == 0) { float m = sh[0]; for (int i = 1; i < 8; ++i) m = fmaxf(m, sh[i]); knmax[bh] = sqrtf(m); }
    __syncthreads();
}
__device__ __forceinline__ void cum_scan_seq(const float* logf, float* cum, int bh, LAS float* sh  , int tid) {
    const int b = bh >> 3, h = bh & 7;
    constexpr int PER = 17;
    const int p0 = tid * PER;
    float v[PER]; float s = 0.f;
#pragma unroll
    for (int i = 0; i < PER; ++i) { const int p = p0 + i; v[i] = (p < LP) ? logf[((size_t)b * LP + p) * 8 + h] : 0.f; s += v[i]; v[i] = s; }
    sh[tid] = s;
    __syncthreads();
    for (int off = 1; off < 512; off <<= 1) {
        const float t = (tid >= off) ? sh[tid - off] : 0.f;
        __syncthreads();
        sh[tid] += t;
        __syncthreads();
    }
    const float base = sh[tid] - s;
#pragma unroll
    for (int i = 0; i < PER; ++i) { const int p = p0 + i; if (p < LP) cum[((size_t)b * 8 + h) * LP + p] = (base + v[i]) * LOG2E; }
    __syncthreads();
}

__device__ __forceinline__ void final_norm_rows(const Params& P, int gw, int NGW, int lane) {
    const float* H = (const float*)(P.ws + WS_H); const float* ssq = (const float*)(P.ws + WS_SSQ) + (size_t)3 * TP; const float* g = P.in[17];
    f32x4 gv[4];
#pragma unroll
    for (int j = 0; j < 4; ++j) gv[j] = *((const f32x4*)g + lane + 64 * j);
    for (int t = gw; t < BATCH * SEQ; t += 2 * NGW) {
        const int t2 = t + NGW; const bool has2 = t2 < BATCH * SEQ;
        const int row = (t / SEQ) * LP + REAL0 + (t % SEQ), row2 = has2 ? (t2 / SEQ) * LP + REAL0 + (t2 % SEQ) : row;
        const float rstd = rsqrtf(ssq[row] * (1.0f / D) + RMS_EPS), rstd2 = rsqrtf(ssq[row2] * (1.0f / D) + RMS_EPS);
        const f32x4* hr = (const f32x4*)(H + (size_t)row * D) + lane; const f32x4* hr2 = (const f32x4*)(H + (size_t)row2 * D) + lane;
        f32x4 hv[4], hw[4];
#pragma unroll
        for (int j = 0; j < 4; ++j) { hv[j] = __builtin_nontemporal_load(&hr[64 * j]); hw[j] = __builtin_nontemporal_load(&hr2[64 * j]); }
        f32x4* o = (f32x4*)(P.out + (size_t)t * D) + lane;
#pragma unroll
        for (int j = 0; j < 4; ++j) __builtin_nontemporal_store((f32x4){hv[j].x * rstd * gv[j].x, hv[j].y * rstd * gv[j].y, hv[j].z * rstd * gv[j].z, hv[j].w * rstd * gv[j].w}, &o[64 * j]);
        if (has2) { f32x4* o2 = (f32x4*)(P.out + (size_t)t2 * D) + lane;
#pragma unroll
            for (int j = 0; j < 4; ++j) __builtin_nontemporal_store((f32x4){hw[j].x * rstd2 * gv[j].x, hw[j].y * rstd2 * gv[j].y, hw[j].z * rstd2 * gv[j].z, hw[j].w * rstd2 * gv[j].w}, &o2[64 * j]); }
    }
}

template <bool DIFF>
__device__ __forceinline__ void naive_attn_body(const Params& P, int tid, int bx, int h, int b) {
    constexpr int NS = DIFF ? 4 : 2, RPB = 256 / NS;
    const int ql = tid / NS, sub = tid % NS;
    const int pq = bx * RPB + ql;
    const size_t row = (size_t)b * LP + pq;
    const bf16_t* QK = (const bf16_t*)(P.ws + WS_BIG); const bf16_t* VT = (const bf16_t*)(P.ws + WS_VT); const float* cum = (const float*)(P.ws + WS_CUM) + ((size_t)b * 8 + h) * LP;
    bf16_t* AO = (bf16_t*)(P.ws + WS_AO);
    const float lam = ((const float*)(P.ws + WS_CTL))[0];
    float res[32];
#pragma unroll
    for (int j = 0; j < 32; ++j) res[j] = 0.f;
    const bool live = pq >= NPAD;
    for (int map = 0; map < (DIFF ? 2 : 1); ++map) {
        const int qcol = DIFF ? h * 128 + map * 64 : 1024 + h * 64, kcol = DIFF ? 512 + h * 128 + map * 64 : 1536 + h * 64;
        const int vcol0 = DIFF ? h * 128 + sub * 32 : 512 + h * 64 + sub * 32;
        float q[64];
#pragma unroll
        for (int i = 0; i < 8; ++i) { const u32x4 w = *(const u32x4*)(QK + row * QKW + qcol + 8 * i);
            q[8 * i] = bflo(w.x); q[8 * i + 1] = bfhi(w.x); q[8 * i + 2] = bflo(w.y); q[8 * i + 3] = bfhi(w.y); q[8 * i + 4] = bflo(w.z); q[8 * i + 5] = bfhi(w.z); q[8 * i + 6] = bflo(w.w); q[8 * i + 7] = bfhi(w.w); }
        const float cq = DIFF ? 0.f : cum[pq];
        float m = NEGBIG, l = 0.f, o[32];
#pragma unroll
        for (int j = 0; j < 32; ++j) o[j] = 0.f;
        if (live) for (int s0 = NPAD; s0 <= pq; s0 += 8) {
            float sc[8]; float gm = NEGBIG;
#pragma unroll
            for (int e = 0; e < 8; ++e) {
                const int s = s0 + e; const bf16_t* kr = QK + ((size_t)b * LP + s) * QKW + kcol; float d = 0.f;
#pragma unroll
                for (int i = 0; i < 8; ++i) { const u32x4 w = *(const u32x4*)(kr + 8 * i);
                    d += q[8 * i] * bflo(w.x) + q[8 * i + 1] * bfhi(w.x) + q[8 * i + 2] * bflo(w.y) + q[8 * i + 3] * bfhi(w.y) + q[8 * i + 4] * bflo(w.z) + q[8 * i + 5] * bfhi(w.z) + q[8 * i + 6] * bflo(w.w) + q[8 * i + 7] * bfhi(w.w); }
                if (!DIFF) d += cq - cum[s];
                sc[e] = (s <= pq) ? d : NEGBIG; gm = fmaxf(gm, sc[e]);
            }
            const float mn = fmaxf(m, gm), f = exp2f(m - mn);
            float pw[8]; float ps = 0.f;
#pragma unroll
            for (int e = 0; e < 8; ++e) { pw[e] = (s0 + e <= pq) ? exp2f(sc[e] - mn) : 0.f; ps += pw[e]; }
            l = l * f + ps; m = mn;
#pragma unroll
            for (int j = 0; j < 32; ++j) { const u32x4 w = *(const u32x4*)(VT + ((size_t)b * 1024 + vcol0 + j) * LP + s0);
                o[j] = o[j] * f + (pw[0] * bflo(w.x) + pw[1] * bfhi(w.x) + pw[2] * bflo(w.y) + pw[3] * bfhi(w.y) + pw[4] * bflo(w.z) + pw[5] * bfhi(w.z) + pw[6] * bflo(w.w) + pw[7] * bfhi(w.w)); }
        }
        const float il = (l > 0.f) ? 1.f / l : 0.f;
        if (DIFF) {
#pragma unroll
            for (int j = 0; j < 32; ++j) res[j] = (map == 0) ? o[j] * il : res[j] - lam * o[j] * il;
        } else {
#pragma unroll
            for (int j = 0; j < 32; ++j) res[j] = o[j] * il;
        }
    }
    if (DIFF) {
        float ss = 0.f;
#pragma unroll
        for (int j = 0; j < 32; ++j) ss += res[j] * res[j];
        ss += __shfl_xor(ss, 1); ss += __shfl_xor(ss, 2);
        const float r = rsqrtf(ss * (1.0f / 128.f) + SUBLN_EPS) * (1.0f - LAMBDA_INIT);
        const float* g = P.in[12] + sub * 32;
#pragma unroll
        for (int j = 0; j < 32; ++j) res[j] = res[j] * r * g[j];
    }
    bf16_t* dst = AO + row * D + (DIFF ? h * 128 + sub * 32 : 512 + h * 64 + sub * 32);
#pragma unroll
    for (int j = 0; j < 4; ++j) { u32x4 o4; o4.x = pk2(res[8 * j], res[8 * j + 1]); o4.y = pk2(res[8 * j + 2], res[8 * j + 3]); o4.z = pk2(res[8 * j + 4], res[8 * j + 5]); o4.w = pk2(res[8 * j + 6], res[8 * j + 7]);
        *(u32x4*)(dst + 8 * j) = live ? o4 : (u32x4){0u, 0u, 0u, 0u}; }
}


namespace pg8 {
#define PG8_LAS __attribute__((address_space(3)))
typedef unsigned short bf16_t;
typedef short bf16x8 __attribute__((ext_vector_type(8)));
typedef float f32x4 __attribute__((ext_vector_type(4)));
typedef unsigned u32x4 __attribute__((ext_vector_type(4)));
constexpr int BM = 256, BK = 64, HALF = 128, HTB = HALF * BK * 2  , STAGE_BYTES = 8 * HTB, NXCD = 8, WGM = 8;

__host__ __device__ __forceinline__ int lds_byte(int r, int c) { const int st = (r >> 4) * 2 + (c >> 5), rr = r & 15, cc = c & 31, ob = rr * 64 + cc * 2; return st * 1024 + (ob ^ (((ob >> 9) & 1) << 5)); }
__host__ __device__ __forceinline__ void stage_rc(int b, int& R, int& C) { const int st = b / 1024, sb = b % 1024, swz = sb ^ (((sb >> 9) & 1) << 5); R = (st >> 1) * 16 + swz / 64; C = (st & 1) * 32 + (swz % 64) / 2; }
__host__ __device__ __forceinline__ int perm32(int rho) { const int n = rho >> 4, i = rho & 15; return 8 * (i >> 2) + 4 * n + (i & 3); }

struct Unit { int pm, pn; };
struct Gemm { const bf16_t* A; const bf16_t* Bt; int M, N, K; };

struct StaticOrder {
    int nM, nN, nwg, G, c;
    __host__ __device__ void init(int M, int N, int G_, int c_) { nM = M / BM; nN = N / BM; nwg = nM * nN; G = G_; c = c_; }
    __host__ __device__ bool next(int i, Unit& u) const {
        const long L = (long)i * G + c; if (L >= nwg) return false;
        int wgid = (int)L; { const int q = nwg / NXCD, r = nwg % NXCD, xcd = wgid % NXCD, off = wgid / NXCD; wgid = (xcd < r ? xcd * (q + 1) : r * (q + 1) + (xcd - r) * q) + off; }
        const int nig = WGM * nN, gid = wgid / nig, fm = gid * WGM, gsz = (nM - fm) < WGM ? (nM - fm) : WGM;
        u.pm = fm + ((wgid % nig) % gsz); u.pn = (wgid % nig) / gsz; return true;
    }
    __device__ __forceinline__ void a_ready(const Unit&) const {}
    __device__ __forceinline__ void done(const Unit&) const {}
};

template <class Epi, class Sched, bool ALIGN_EPI = false, bool SP2 = false>
__device__ __forceinline__ void gemm_phase(PG8_LAS unsigned char* lds, const Gemm g, const Sched& S, const Epi& E) {
    const int tid = threadIdx.x, wid = __builtin_amdgcn_readfirstlane(tid >> 6), lane = tid & 63, wr = wid >> 2, wc = wid & 3, fr = lane & 15, fq = lane >> 4;
    const int K = g.K, nt = K / BK;
    unsigned voffA[2], voffB[2];
#pragma unroll
    for (int i = 0; i < 2; ++i) { int R, C; stage_rc(tid * 16 + i * 8192, R, C); const int Rb = Epi::PERM ? ((R & ~31) + perm32(R & 31)) : R;
        voffA[i] = (unsigned)(R * K + C) * 2u; voffB[i] = (unsigned)(Rb * K + C) * 2u; }
    const size_t kstep = (size_t)(BK * 2);
    const size_t hstep = (size_t)HALF * K * 2;
    const size_t tstep = 2 * hstep;
    const unsigned ldsw = (unsigned)wid * 1024u;
    const int aoff = lds_byte(wr * 64 + fr, fq * 8), boff = lds_byte(wc * 32 + fr, fq * 8);
#define PG8_SA(b, h) (((b) * 2 + (h)) * HTB)
#define PG8_SB(b, h) ((4 + (b) * 2 + (h)) * HTB)
#define PG8_STAGE(bufoff, gbase, voff) do { _Pragma("unroll") for (int _i = 0; _i < 2; ++_i) \
        __builtin_amdgcn_global_load_lds((const unsigned*)((const char*)(gbase) + (voff)[_i]), (PG8_LAS unsigned*)(lds + (bufoff) + ldsw + _i * 8192), 16, 0, 0); } while (0)
#define PG8_LDA(dst, b, h) do { _Pragma("unroll") for (int m = 0; m < 4; ++m) _Pragma("unroll") for (int k = 0; k < 2; ++k) dst[m][k] = *(const PG8_LAS bf16x8*)(lds + PG8_SA(b, h) + aoff + m * 2048 + k * 1024); } while (0)
#define PG8_LDB(dst, b, h) do { _Pragma("unroll") for (int n = 0; n < 2; ++n) _Pragma("unroll") for (int k = 0; k < 2; ++k) dst[n][k] = *(const PG8_LAS bf16x8*)(lds + PG8_SB(b, h) + boff + n * 2048 + k * 1024); } while (0)
#define PG8_MMA(ai, bj, At, Bt) do { __builtin_amdgcn_s_setprio(1); _Pragma("unroll") for (int m = 0; m < 4; ++m) _Pragma("unroll") for (int n = 0; n < 2; ++n) _Pragma("unroll") for (int k = 0; k < 2; ++k) \
        acc[ai][bj][m][n] = __builtin_amdgcn_mfma_f32_16x16x32_bf16(Bt[n][k], At[m][k], acc[ai][bj][m][n], 0, 0, 0); __builtin_amdgcn_s_setprio(0); } while (0)
#define PG8_WAIT_V(n) asm volatile("s_waitcnt vmcnt(" #n ")" ::: "memory")
#define PG8_WAIT_L(n) asm volatile("s_waitcnt lgkmcnt(" #n ")" ::: "memory")
#define PG8_BAR __builtin_amdgcn_s_barrier()
#define PG8_SCHED __builtin_amdgcn_sched_barrier(0)
    Unit cur, nxt; int ui = 0;
    if (!S.next(0, cur)) return;
    f32x4 acc[2][2][4][2];
#pragma unroll
    for (int a = 0; a < 2; ++a)
#pragma unroll
        for (int b = 0; b < 2; ++b)
#pragma unroll
            for (int m = 0; m < 4; ++m)
#pragma unroll
                for (int n = 0; n < 2; ++n) acc[a][b][m][n] = (f32x4){0.f, 0.f, 0.f, 0.f};
    bf16x8 At[4][2], B0[2][2], B1[2][2];
    const char* cA = (const char*)g.A + (size_t)cur.pm * tstep; const char* cB = (const char*)g.Bt + (size_t)cur.pn * tstep;
    S.a_ready(cur);
    if constexpr (SP2) {
        PG8_STAGE(PG8_SB(0, 0), cB, voffB); PG8_STAGE(PG8_SB(0, 1), cB + hstep, voffB); PG8_STAGE(PG8_SA(0, 0), cA, voffA); PG8_STAGE(PG8_SA(0, 1), cA + hstep, voffA);
        if (wr == 1) PG8_BAR;
        PG8_WAIT_V(2); PG8_BAR;
        PG8_STAGE(PG8_SB(1, 0), cB + kstep, voffB); PG8_STAGE(PG8_SA(1, 0), cA + kstep, voffA); PG8_STAGE(PG8_SB(1, 1), cB + hstep + kstep, voffB);
        PG8_WAIT_V(6); PG8_BAR;
    } else {
        PG8_STAGE(PG8_SB(0, 0), cB, voffB); PG8_STAGE(PG8_SA(0, 0), cA, voffA); PG8_STAGE(PG8_SB(0, 1), cB + hstep, voffB); PG8_STAGE(PG8_SA(0, 1), cA + hstep, voffA);
        if (wr == 1) PG8_BAR;
        PG8_WAIT_V(4); PG8_BAR;
        PG8_STAGE(PG8_SB(1, 0), cB + kstep, voffB); PG8_STAGE(PG8_SA(1, 0), cA + kstep, voffA); PG8_STAGE(PG8_SB(1, 1), cB + hstep + kstep, voffB);
        PG8_WAIT_V(6); PG8_BAR;
    }
    for (;;) {
        const bool has_next = S.next(ui + 1, nxt);
        const char* nA = has_next ? (const char*)g.A + (size_t)nxt.pm * tstep : cA; const char* nB = has_next ? (const char*)g.Bt + (size_t)nxt.pn * tstep : cB;
        for (int t = 0; t < nt; t += 2) {
            const bool last = (t == nt - 2);
            const char* a1 = cA + (size_t)(t + 1) * kstep;
            const char* a2 = last ? nA : cA + (size_t)(t + 2) * kstep; const char* b2 = last ? nB : cB + (size_t)(t + 2) * kstep;
            const char* a3 = a2 + kstep; const char* b3 = b2 + kstep;
            if (last && has_next) S.a_ready(nxt);
            if constexpr (SP2) {
            PG8_LDB(B0, 0, 0); PG8_LDB(B1, 0, 1); PG8_SCHED; PG8_LDA(At, 0, 0); PG8_STAGE(PG8_SA(1, 1), a1 + hstep, voffA);
            PG8_WAIT_V(8); PG8_WAIT_L(0); PG8_BAR; PG8_MMA(0, 0, At, B0); PG8_MMA(0, 1, At, B1); PG8_BAR; PG8_SCHED;
            PG8_LDA(At, 0, 1); PG8_STAGE(PG8_SB(0, 0), b2, voffB); PG8_STAGE(PG8_SB(0, 1), b2 + hstep, voffB); PG8_STAGE(PG8_SA(0, 0), a2, voffA);
            PG8_WAIT_V(8); PG8_WAIT_L(0); PG8_BAR; PG8_MMA(1, 0, At, B0); PG8_MMA(1, 1, At, B1); PG8_BAR; PG8_SCHED;
            PG8_LDB(B0, 1, 0); PG8_LDB(B1, 1, 1); PG8_SCHED; PG8_LDA(At, 1, 0); PG8_STAGE(PG8_SA(0, 1), a2 + hstep, voffA);
            PG8_WAIT_V(8); PG8_WAIT_L(0); PG8_BAR; PG8_MMA(0, 0, At, B0); PG8_MMA(0, 1, At, B1); PG8_BAR; PG8_SCHED;
            PG8_LDA(At, 1, 1); PG8_STAGE(PG8_SB(1, 0), b3, voffB); PG8_STAGE(PG8_SB(1, 1), b3 + hstep, voffB); PG8_STAGE(PG8_SA(1, 0), a3, voffA);
            PG8_WAIT_V(8); PG8_WAIT_L(0); PG8_BAR; PG8_MMA(1, 0, At, B0); PG8_MMA(1, 1, At, B1); PG8_BAR; PG8_SCHED;
            } else {
            PG8_LDB(B0, 0, 0); PG8_SCHED; PG8_LDA(At, 0, 0); PG8_STAGE(PG8_SA(1, 1), a1 + hstep, voffA);
            PG8_WAIT_L(8); PG8_BAR; PG8_WAIT_L(0); PG8_MMA(0, 0, At, B0); PG8_BAR; PG8_SCHED;
            PG8_LDB(B1, 0, 1); PG8_STAGE(PG8_SB(0, 0), b2, voffB);
            PG8_BAR; PG8_WAIT_L(0); PG8_MMA(0, 1, At, B1); PG8_BAR;
            PG8_LDA(At, 0, 1); PG8_STAGE(PG8_SA(0, 0), a2, voffA);
            PG8_BAR; PG8_WAIT_L(0); PG8_MMA(1, 0, At, B0); PG8_BAR; PG8_SCHED;
            PG8_STAGE(PG8_SB(0, 1), b2 + hstep, voffB);
            PG8_WAIT_V(6); PG8_BAR; PG8_MMA(1, 1, At, B1); PG8_BAR;
            PG8_LDB(B0, 1, 0); PG8_SCHED; PG8_LDA(At, 1, 0); PG8_STAGE(PG8_SA(0, 1), a2 + hstep, voffA);
            PG8_WAIT_L(8); PG8_BAR; PG8_WAIT_L(0); PG8_MMA(0, 0, At, B0); PG8_BAR; PG8_SCHED;
            PG8_LDB(B1, 1, 1); PG8_STAGE(PG8_SB(1, 0), b3, voffB);
            PG8_BAR; PG8_WAIT_L(0); PG8_MMA(0, 1, At, B1); PG8_BAR;
            PG8_LDA(At, 1, 1); PG8_STAGE(PG8_SA(1, 0), a3, voffA);
            PG8_BAR; PG8_WAIT_L(0); PG8_MMA(1, 0, At, B0); PG8_BAR; PG8_SCHED;
            PG8_STAGE(PG8_SB(1, 1), b3 + hstep, voffB);
            PG8_WAIT_V(6); PG8_BAR; PG8_MMA(1, 1, At, B1); PG8_BAR;
            }
        }
        if constexpr (ALIGN_EPI) { if (wr == 0) PG8_BAR; }
        if constexpr (!Epi::AFTER_DRAIN) { E(acc, cur, wr, wc, fr, fq); S.done(cur); }
        if (!has_next) break;
#pragma unroll
        for (int a = 0; a < 2; ++a)
#pragma unroll
            for (int b = 0; b < 2; ++b)
#pragma unroll
                for (int m = 0; m < 4; ++m)
#pragma unroll
                    for (int n = 0; n < 2; ++n) acc[a][b][m][n] = (f32x4){0.f, 0.f, 0.f, 0.f};
        cur = nxt; cA = nA; cB = nB; ++ui;
        if constexpr (ALIGN_EPI) { if (wr == 1) PG8_BAR; }
    }
    PG8_WAIT_V(0);
    if constexpr (!ALIGN_EPI) { if (wr == 0) PG8_BAR; }
    PG8_BAR;
    if constexpr (Epi::AFTER_DRAIN) { E.fused(acc, cur, wr, wc, fr, fq, lds, wid, lane); S.done(cur); }
#undef PG8_SA
#undef PG8_SB
#undef PG8_STAGE
#undef PG8_LDA
#undef PG8_LDB
#undef PG8_MMA
#undef PG8_WAIT_V
#undef PG8_WAIT_L
#undef PG8_BAR
#undef PG8_SCHED
}
}


template <int NW>
__device__ __forceinline__ void side16_dot(const float* AT, const float* W, int ldw, int K, const int (&col)[NW], const float* gk, LAS float* red, float (&res)[NW]) {
    const int tid = threadIdx.x, lane = tid & 63, w = tid >> 6, c = lane & 15, kq = lane >> 4;
    float acc[NW][16];
#pragma unroll
    for (int wi = 0; wi < NW; ++wi)
#pragma unroll
        for (int r = 0; r < 16; ++r) acc[wi][r] = 0.f;
    const int ks = K >> 3, kbeg = w * ks;
#pragma unroll 8
    for (int k = kbeg + kq; k < kbeg + ks; k += 4) {
        const f32x4 a0 = *(const f32x4*)(AT + (size_t)k * 16), a1 = *(const f32x4*)(AT + (size_t)k * 16 + 4), a2 = *(const f32x4*)(AT + (size_t)k * 16 + 8), a3 = *(const f32x4*)(AT + (size_t)k * 16 + 12);
        const float gs = gk ? gk[k] : 1.f;
#pragma unroll
        for (int wi = 0; wi < NW; ++wi) { const float wv = (col[wi] >= 0) ? W[(size_t)k * ldw + col[wi]] * gs : 0.f;
            acc[wi][0] += a0.x * wv; acc[wi][1] += a0.y * wv; acc[wi][2] += a0.z * wv; acc[wi][3] += a0.w * wv; acc[wi][4] += a1.x * wv; acc[wi][5] += a1.y * wv; acc[wi][6] += a1.z * wv; acc[wi][7] += a1.w * wv;
            acc[wi][8] += a2.x * wv; acc[wi][9] += a2.y * wv; acc[wi][10] += a2.z * wv; acc[wi][11] += a2.w * wv; acc[wi][12] += a3.x * wv; acc[wi][13] += a3.y * wv; acc[wi][14] += a3.z * wv; acc[wi][15] += a3.w * wv; }
    }
#pragma unroll
    for (int wi = 0; wi < NW; ++wi)
#pragma unroll
        for (int r = 0; r < 16; ++r) { float v = acc[wi][r]; v += __shfl_xor(v, 16); v += __shfl_xor(v, 32); if (kq == 0) red[((wi * 8 + w) * 16 + r) * 16 + c] = v; }
    __syncthreads();
    if (tid < 256) {
#pragma unroll
        for (int wi = 0; wi < NW; ++wi) { float v = 0.f;
#pragma unroll
            for (int ww = 0; ww < 8; ++ww) v += red[(wi * 8 + ww) * 256 + tid];
            res[wi] = v; }
    }
    __syncthreads();
}
__device__ __forceinline__ void side_stage1(const Params& P, LAS float* red, int t) {
    const int tid = threadIdx.x, c = tid & 15;
    const int col[2] = {16 * t + c, DFF + 16 * t + c}; float res[2];
    side16_dot<2>((const float*)(P.ws + WS_AT0), P.in[3], NGU, D, col, nullptr, red, res);
    if (tid < 256) { const int r = tid >> 4, cc = tid & 15; const float g = res[0], u = res[1]; ((float*)(P.ws + WS_ACTT))[(16 * t + cc) * 16 + r] = g * u / (1.f + __expf(-g)); }
}
__device__ __forceinline__ void side_stage2(const Params& P, LAS float* red, int t) {
    const int tid = threadIdx.x, c = tid & 15;
    const int col[1] = {16 * t + c}; float res[1];
    side16_dot<1>((const float*)(P.ws + WS_ACTT), P.in[4], D, DFF, col, nullptr, red, res);
    if (tid < 256) { const int r = tid >> 4, cc = tid & 15, n = 16 * t + cc; const float h1 = P.in[1][(size_t)r * D + n] + 0.5f * res[0];
        ((float*)(P.ws + WS_H1T))[n * 16 + r] = h1;
        float q = h1 * h1; q += __shfl_xor(q, 1); q += __shfl_xor(q, 2); q += __shfl_xor(q, 4); q += __shfl_xor(q, 8);
        if (cc == 0) unsafeAtomicAdd((float*)(P.ws + WS_SSQM) + r, q); }
}
__device__ __forceinline__ void side_stage3(const Params& P, LAS float* red, int t) {
    const int tid = threadIdx.x, c = tid & 15;
    const int kind = (t >= 128) ? 4 : (t >> 5);
    const int n0 = (kind == 0) ? 512 + 16 * t : (kind == 1) ? 1024 + 16 * (t - 32) : (kind == 2) ? 2048 + 16 * (t - 64) : (kind == 3) ? 2560 + 16 * (t - 96) : 3072;
    const int col[1] = {(n0 + c < NIN) ? n0 + c : -1}; float res[1];
    side16_dot<1>((const float*)(P.ws + WS_H1T), P.in[6], NIN, D, col, P.in[5], red, res);
    float v = 0.f; int r = 0, cc = 0;
    if (tid < 256) { r = tid >> 4; cc = tid & 15; v = res[0] * rsqrtf(((const float*)(P.ws + WS_SSQM))[r] * (1.0f / D) + RMS_EPS); red[tid] = v; }
    __syncthreads();
    if (tid < 256) {
        const int n = n0 + cc; const int p = NPAD + r;
        bf16_t* QK = (bf16_t*)(P.ws + WS_BIG); bf16_t* VT = (bf16_t*)(P.ws + WS_VT); float* logf = (float*)(P.ws + WS_LOGF);
        if (kind == 0 || kind == 2) {
            float o = v;
            if (kind == 0 && (n & 63) < 16) { const float pr = red[tid ^ 8]; const float* cs = (const float*)(P.ws + WS_ROPE) + (size_t)r * 16 + 2 * (n & 7);
                o = ((n & 63) < 8) ? v * cs[0] - pr * cs[1] : v * cs[0] + pr * cs[1]; }
            const int dst = (kind == 0) ? n : n - 512;
            for (int b = 0; b < BATCH; ++b) QK[((size_t)b * LP + p) * QKW + dst] = (bf16_t)f2bf(o);
        } else if (kind == 1 || kind == 3) {
            const int vcol = (kind == 1) ? n - 1024 : n - 2560 + 512;
            for (int b = 0; b < BATCH; ++b) VT[((size_t)b * 1024 + vcol) * LP + p] = (bf16_t)f2bf(v);
        } else if (cc < 8) {
            const float x = v + P.in[7][cc]; const float lf = fminf(x, 0.f) - log1pf(__expf(-fabsf(x)));
            for (int b = 0; b < BATCH; ++b) logf[((size_t)b * LP + p) * 8 + cc] = lf;
        }
    }
    __syncthreads();
}


__device__ __forceinline__ void gates_rows(const Params& P, int widx, int nw, int lane) {
    typedef short bf16x8 __attribute__((ext_vector_type(8))); typedef float f32x16 __attribute__((ext_vector_type(16)));
    const bf16_t* HB = (const bf16_t*)P.out; const bf16_t* WG = (const bf16_t*)(P.ws + WS_WIN) + (size_t)3072 * D;
    const float* ssq1 = (const float*)(P.ws + WS_SSQ) + TP; float* logf = (float*)(P.ws + WS_LOGF); const float* bfg = P.in[7];
    const int ql = lane & 31, hi = lane >> 5;
    for (int t = widx; t < 1024; t += nw) {
        const int lt = t >> 3, row0 = (lt + (lt >> 5) + 1) * 256 + (t & 7) * 32;
        const bf16_t* ap = WG + (size_t)ql * D + 8 * hi; const bf16_t* bp = HB + (size_t)(row0 + ql) * D + 8 * hi;
        f32x16 acc;
#pragma unroll
        for (int r = 0; r < 16; ++r) acc[r] = 0.f;
#pragma unroll 16
        for (int ks = 0; ks < 64; ++ks) { const bf16x8 a = *(const bf16x8*)(ap + 16 * ks), b = *(const bf16x8*)(bp + 16 * ks); acc = __builtin_amdgcn_mfma_f32_32x32x16_bf16(a, b, acc, 0, 0, 0); }
        const int row = row0 + ql; const float rstd = row_rstd(ssq1, row);
        f32x4 o;
#pragma unroll
        for (int j = 0; j < 4; ++j) { const float x = acc[j] * rstd + bfg[4 * hi + j]; o[j] = fminf(x, 0.f) - log1pf(__expf(-fabsf(x))); }
        *(f32x4*)(logf + (size_t)row * 8 + 4 * hi) = o;
    }
}

struct LiveOrder {
    pg8::StaticOrder S;
    __device__ void init(int N, int G, int c) { S.init(128 * 256, N, G, c); }
    __device__ bool next(int i, pg8::Unit& u) const { if (!S.next(i, u)) return false; u.pm = u.pm + (u.pm >> 5) + 1; return true; }
    __device__ __forceinline__ void a_ready(const pg8::Unit&) const {}
    __device__ __forceinline__ void done(const pg8::Unit&) const {}
};
__device__ __forceinline__ F8 acc8(const f32x4 (&acc)[2][2][4][2], int ai, int bj, int m) {
    F8 r; const f32x4 a = acc[ai][bj][m][0], b = acc[ai][bj][m][1];
    r.v[0] = a[0]; r.v[1] = a[1]; r.v[2] = a[2]; r.v[3] = a[3]; r.v[4] = b[0]; r.v[5] = b[1]; r.v[6] = b[2]; r.v[7] = b[3]; return r;
}
struct PgSwiglu {
    static constexpr bool PERM = true, AFTER_DRAIN = false;
    const float* ssq_in; bf16_t* ACT;
    __device__ __forceinline__ void operator()(const f32x4 (&acc)[2][2][4][2], const pg8::Unit& u, int wr, int wc, int fr, int fq) const {
        const EpiSwiglu E{nullptr, ACT};
        const int col = u.pn * 128 + wc * 32 + 8 * fq;
        float rs[2][4];
#pragma unroll
        for (int ai = 0; ai < 2; ++ai)
#pragma unroll
            for (int m = 0; m < 4; ++m) rs[ai][m] = ssq_in[u.pm * 256 + ai * 128 + wr * 64 + m * 16 + fr];
#pragma unroll
        for (int ai = 0; ai < 2; ++ai)
#pragma unroll
            for (int m = 0; m < 4; ++m) rs[ai][m] = rsqrtf(rs[ai][m] * (1.0f / D) + RMS_EPS);
#pragma unroll
        for (int ai = 0; ai < 2; ++ai)
#pragma unroll
            for (int m = 0; m < 4; ++m) { const int row = u.pm * 256 + ai * 128 + wr * 64 + m * 16 + fr;
                E(row, col, acc8(acc, ai, 0, m), acc8(acc, ai, 1, m), rs[ai][m]); }
    }
};
struct PgResid {
    static constexpr bool PERM = true, AFTER_DRAIN = false;
    EpiResid E; float* ssq_out;
    __device__ __forceinline__ void operator()(const f32x4 (&acc)[2][2][4][2], const pg8::Unit& u, int wr, int wc, int fr, int fq) const {
#pragma unroll
        for (int ai = 0; ai < 2; ++ai) {
            F8 bs[4][2];
#pragma unroll
            for (int m = 0; m < 4; ++m)
#pragma unroll
                for (int bj = 0; bj < 2; ++bj) bs[m][bj] = E.load(u.pm * 256 + ai * 128 + wr * 64 + m * 16 + fr, u.pn * 256 + bj * 128 + wc * 32 + 8 * fq);
#pragma unroll
            for (int m = 0; m < 4; ++m) { const int row = u.pm * 256 + ai * 128 + wr * 64 + m * 16 + fr; float s = 0.f;
#pragma unroll
                for (int bj = 0; bj < 2; ++bj) s += E.finish(row, u.pn * 256 + bj * 128 + wc * 32 + 8 * fq, acc8(acc, ai, bj, m), bs[m][bj]);
                s += __shfl_xor(s, 16); s += __shfl_xor(s, 32);
                if (fq == 0) unsafeAtomicAdd(ssq_out + row, s); }
        }
    }
};
struct PgInproj {
    static constexpr bool PERM = true, AFTER_DRAIN = false;
    EpiInproj E; const float* ssq_in;
    __device__ __forceinline__ void operator()(const f32x4 (&acc)[2][2][4][2], const pg8::Unit& u, int wr, int wc, int fr, int fq) const {
        const bool rope_tile = u.pn < 4;
        float rs[2][4];
        if (rope_tile) {
            const bool need = ((wc & 1) == 0) && (fq < 2);
            float rr[2][4];
#pragma unroll
            for (int ai = 0; ai < 2; ++ai)
#pragma unroll
                for (int m = 0; m < 4; ++m) rr[ai][m] = ssq_in[u.pm * 256 + ai * 128 + wr * 64 + m * 16 + fr];
#pragma unroll
            for (int ah = 0; ah < 4; ++ah) {
                const int ai = ah >> 1, m0 = (ah & 1) * 2;
                f32x4 cst[2][4];
#pragma unroll
                for (int mm = 0; mm < 2; ++mm) { const int p = (u.pm * 256 + ai * 128 + wr * 64 + (m0 + mm) * 16 + fr) % LP; const f32x4* cp = (const f32x4*)(E.rope + (size_t)(need ? p - NPAD : 0) * 16);
#pragma unroll
                    for (int i = 0; i < 4; ++i) cst[mm][i] = need ? cp[i] : (f32x4){0.f, 0.f, 0.f, 0.f}; }
#pragma unroll
                for (int mm = 0; mm < 2; ++mm) { const int m = m0 + mm; const int row = u.pm * 256 + ai * 128 + wr * 64 + m * 16 + fr; const float rstd = rsqrtf(rr[ai][m] * (1.0f / D) + RMS_EPS);
#pragma unroll
                    for (int bj = 0; bj < 2; ++bj) { F8 v = acc8(acc, ai, bj, m), w;
#pragma unroll
                        for (int j = 0; j < 8; ++j) v.v[j] *= rstd;
#pragma unroll
                        for (int j = 0; j < 8; ++j) w.v[j] = __shfl_xor(v.v[j], 16);
                        E.qk_rope(row, u.pn * 256 + bj * 128 + wc * 32 + 8 * fq, v, w, cst[mm]); } }
            }
            return;
        }
#pragma unroll
        for (int ai = 0; ai < 2; ++ai)
#pragma unroll
            for (int m = 0; m < 4; ++m) rs[ai][m] = ssq_in[u.pm * 256 + ai * 128 + wr * 64 + m * 16 + fr];
#pragma unroll
        for (int ai = 0; ai < 2; ++ai)
#pragma unroll
            for (int m = 0; m < 4; ++m) rs[ai][m] = rsqrtf(rs[ai][m] * (1.0f / D) + RMS_EPS);
#pragma unroll
        for (int ai = 0; ai < 2; ++ai)
#pragma unroll
            for (int m = 0; m < 4; ++m) { const int row = u.pm * 256 + ai * 128 + wr * 64 + m * 16 + fr; const float rstd = rs[ai][m];
#pragma unroll
                for (int bj = 0; bj < 2; ++bj) { F8 v = acc8(acc, ai, bj, m), w;
#pragma unroll
                    for (int j = 0; j < 8; ++j) v.v[j] *= rstd;
                    if (rope_tile) {
#pragma unroll
                        for (int j = 0; j < 8; ++j) w.v[j] = __shfl_xor(v.v[j], 16);
                    } else w = v;
                    E(row, u.pn * 256 + bj * 128 + wc * 32 + 8 * fq, v, w); } }
    }
};


namespace fa {
typedef short bf16x8 __attribute__((ext_vector_type(8)));
typedef float f32x16 __attribute__((ext_vector_type(16)));
typedef unsigned u32x2 __attribute__((ext_vector_type(2)));
typedef float f32x2_t __attribute__((ext_vector_type(2))); typedef __bf16 bf16x2_t __attribute__((ext_vector_type(2)));
__device__ __forceinline__ unsigned cvtpk(float lo, float hi) { f32x2_t v = {lo, hi}; bf16x2_t b = __builtin_convertvector(v, bf16x2_t); return __builtin_bit_cast(unsigned, b); }
constexpr int KS = 272, VS = 272;
constexpr int OFF_K = 0, OFF_V = 128 * KS, OFF_CK = OFF_V + 128 * VS, BUF = OFF_CK + 1024;
constexpr int OFF_X = 0, OFF_UNIT = 2 * BUF;
constexpr int NUNITS = 64 * 32, KT0 = 3;
static_assert(65536 <= BUF && OFF_UNIT + 64 <= 147456, "fa LDS map");
#define FA_MFMA(a, b, c) __builtin_amdgcn_mfma_f32_32x32x16_bf16((a), (b), (c), 0, 0, 0)
__device__ __forceinline__ float max3f(float a, float b, float c) { return __builtin_fmaxf(__builtin_fmaxf(a, b), c); }

template <bool DIFF>
__device__ __forceinline__ void unit(const Params& P, LAS unsigned char* L, int b, int hu, int qb, float lam) {
    constexpr int NDB = DIFF ? 4 : 2;
    const int tid = threadIdx.x, lane = tid & 63, w = __builtin_amdgcn_readfirstlane(tid >> 6), g = w >> 2, wq = w & 3, ql = lane & 31, hi = lane >> 5;
    const bf16_t* QK = (const bf16_t*)(P.ws + WS_BIG); const bf16_t* VT = (const bf16_t*)(P.ws + WS_VT); const float* cum = (const float*)(P.ws + WS_CUM);
    bf16_t* AO = (bf16_t*)(P.ws + WS_AO);
    const int qbw = DIFF ? qb : 2 * qb + g;
    const int st_top = DIFF ? qb : 2 * qb + 1;
    const int qcol = DIFF ? hu * 128 + g * 64 : 1024 + hu * 64;
    const int kcol0 = DIFF ? 512 + hu * 128 : 1536 + hu * 64;
    const int vcol0 = DIFF ? hu * 128 : 512 + hu * 64;
    const int q_abs = 128 * qbw + 32 * wq + ql;
    const size_t qrow = (size_t)b * LP + q_abs;
    bf16x8 qf[4];
#pragma unroll
    for (int ds = 0; ds < 4; ++ds) qf[ds] = *(const bf16x8*)(QK + qrow * QKW + qcol + 16 * ds + 8 * hi);
    const float cq = DIFF ? 0.f : cum[((size_t)b * 8 + hu) * LP + q_abs];
    const bf16_t* kg = DIFF ? QK + ((size_t)b * LP + (tid >> 4)) * QKW + kcol0 + 8 * (tid & 15) : QK + ((size_t)b * LP + (tid >> 3)) * QKW + kcol0 + 8 * (tid & 7);
    const int kl = DIFF ? (tid >> 4) * KS + 16 * (tid & 15) : (tid >> 3) * KS + 16 * (tid & 7);
    const bf16_t* vg = VT + ((size_t)b * 1024 + vcol0 + (tid >> 4)) * LP + 8 * (tid & 15);
    const int vl = (tid >> 4) * VS + 16 * (tid & 15);
    const float* cgp = cum + ((size_t)b * 8 + hu) * LP + (tid & 127);
    u32x4 rk0, rk1, rk2, rk3, rv0, rv1, rv2, rv3; float rc = 0.f;
#define FA_LOAD(st) do { const bf16_t* kp_ = kg + (size_t)(128 * (st)) * QKW; const bf16_t* vp_ = vg + 128 * (st); \
        if (DIFF) { rk0 = *(const u32x4*)(kp_); rk1 = *(const u32x4*)(kp_ + (size_t)32 * QKW); rk2 = *(const u32x4*)(kp_ + (size_t)64 * QKW); rk3 = *(const u32x4*)(kp_ + (size_t)96 * QKW); \
            rv0 = *(const u32x4*)(vp_); rv1 = *(const u32x4*)(vp_ + (size_t)32 * LP); rv2 = *(const u32x4*)(vp_ + (size_t)64 * LP); rv3 = *(const u32x4*)(vp_ + (size_t)96 * LP); } \
        else { rk0 = *(const u32x4*)(kp_); rk1 = *(const u32x4*)(kp_ + (size_t)64 * QKW); rv0 = *(const u32x4*)(vp_); rv1 = *(const u32x4*)(vp_ + (size_t)32 * LP); if (tid < 128) rc = cgp[128 * (st)]; } } while (0)
#define FA_STORE(bo) do { LAS unsigned char* kd_ = L + (bo) + OFF_K + kl; LAS unsigned char* vd_ = L + (bo) + OFF_V + vl; \
        if (DIFF) { *(LAS u32x4*)(kd_) = rk0; *(LAS u32x4*)(kd_ + 32 * KS) = rk1; *(LAS u32x4*)(kd_ + 64 * KS) = rk2; *(LAS u32x4*)(kd_ + 96 * KS) = rk3; \
            *(LAS u32x4*)(vd_) = rv0; *(LAS u32x4*)(vd_ + 32 * VS) = rv1; *(LAS u32x4*)(vd_ + 64 * VS) = rv2; *(LAS u32x4*)(vd_ + 96 * VS) = rv3; } \
        else { *(LAS u32x4*)(kd_) = rk0; *(LAS u32x4*)(kd_ + 64 * KS) = rk1; *(LAS u32x4*)(vd_) = rv0; *(LAS u32x4*)(vd_ + 32 * VS) = rv1; if (tid < 128) *(LAS float*)(L + (bo) + OFF_CK + 4 * tid) = rc; } } while (0)
    const int pim = (ql & 0x13) | ((ql & 4) << 1) | ((ql & 8) >> 1);
    const int ka = pim * KS + ((DIFF ? 64 * g : 0) + 8 * hi) * 2;
    const int va = ql * VS + 16 * hi;
    float m_ref = 0.f, l = 0.f;
    bool first = true;
    f32x16 oacc[NDB];
#pragma unroll
    for (int db = 0; db < NDB; ++db)
#pragma unroll
        for (int r = 0; r < 16; ++r) oacc[db][r] = 0.f;
    f32x16 negm, lacc;
#pragma unroll
    for (int r = 0; r < 16; ++r) { negm[r] = 0.f; lacc[r] = 0.f; }
    bf16x8 onesf;
#pragma unroll
    for (int j = 0; j < 8; ++j) onesf[j] = (ql == 0) ? (short)0x3F80 : (short)0;
    LAS float* qnw = (LAS float*)(L + OFF_UNIT + 16);
    if (!DIFF) {
        float q2 = 0.f;
#pragma unroll
        for (int ds = 0; ds < 4; ++ds) { const u32x4 w = __builtin_bit_cast(u32x4, qf[ds]); const float a0 = bflo(w.x), a1 = bfhi(w.x), a2 = bflo(w.y), a3 = bfhi(w.y), a4 = bflo(w.z), a5 = bfhi(w.z), a6 = bflo(w.w), a7 = bfhi(w.w);
            q2 += (a0 * a0 + a1 * a1) + (a2 * a2 + a3 * a3) + (a4 * a4 + a5 * a5) + (a6 * a6 + a7 * a7); }
        q2 += __shfl_xor(q2, 32);
#pragma unroll
        for (int o = 1; o < 32; o <<= 1) q2 = fmaxf(q2, __shfl_xor(q2, o));
        if (lane == 0) qnw[w] = q2;
    }
    FA_LOAD(st_top); FA_STORE(0);
    __syncthreads();
    asm volatile("" : "+v"(qf[0]), "+v"(qf[1]), "+v"(qf[2]), "+v"(qf[3]));
    float cqp = cq; asm volatile("" : "+v"(cqp));
    int st_end = 0;
    if (!DIFF) {
        float qn2 = qnw[0];
#pragma unroll
        for (int i = 1; i < 8; ++i) qn2 = fmaxf(qn2, qnw[i]);
        const float* cs = cum + ((size_t)b * 8 + hu) * LP;
        const float base = 2.0f * 1.001f * sqrtf(qn2) * ((const float*)(P.ws + WS_KNMAX))[b * 8 + hu] + cs[256 * qb] + 2.0f;
        const int sti = st_top - lane;
        const bool dead = (sti >= 1) && (base - cs[128 * (sti > 0 ? sti : 1) + 127] < -150.0f);
        const unsigned long long mask = __ballot(dead);
        if (mask) st_end = st_top - (int)__builtin_ctzll(mask);
        st_end = __builtin_amdgcn_readfirstlane(st_end);
    }
    int bo = 0;
    for (int st = st_top; st > st_end; --st) {
        if (st - 1 > st_end) FA_LOAD(st - 1);
#pragma unroll
        for (int hh = 1; hh >= 0; --hh) {
        const int k0 = 128 * st + 64 * hh;
        if (k0 + 63 >= NPAD && k0 <= 128 * qbw + 32 * wq + 31) {
            const LAS unsigned char* Kb = L + bo + OFF_K + 64 * hh * KS; const LAS unsigned char* Vb = L + bo + OFF_V + 128 * hh;
            f32x16 s0, s1;
            __builtin_amdgcn_s_setprio(1);
            if (DIFF) {
                const bf16x8 a0 = *(const LAS bf16x8*)(Kb + ka), a1 = *(const LAS bf16x8*)(Kb + ka + 32 * KS);
                s0 = FA_MFMA(a0, qf[0], negm); s1 = FA_MFMA(a1, qf[0], negm);
            } else {
                const float cqm = cqp - m_ref;
                const LAS float* ck = (const LAS float*)(L + bo + OFF_CK) + 64 * hh + 8 * hi;
#pragma unroll
                for (int t = 0; t < 2; ++t) { const f32x4 a = *(const LAS f32x4*)(ck + 16 * t), c = *(const LAS f32x4*)(ck + 16 * t + 4), d = *(const LAS f32x4*)(ck + 32 + 16 * t), e = *(const LAS f32x4*)(ck + 32 + 16 * t + 4);
#pragma unroll
                    for (int j = 0; j < 4; ++j) { s0[8 * t + j] = cqm - a[j]; s0[8 * t + 4 + j] = cqm - c[j]; s1[8 * t + j] = cqm - d[j]; s1[8 * t + 4 + j] = cqm - e[j]; } }
                const bf16x8 a0 = *(const LAS bf16x8*)(Kb + ka), a1 = *(const LAS bf16x8*)(Kb + ka + 32 * KS);
                s0 = FA_MFMA(a0, qf[0], s0); s1 = FA_MFMA(a1, qf[0], s1);
            }
#pragma unroll
            for (int ds = 1; ds < 4; ++ds) { const bf16x8 a0 = *(const LAS bf16x8*)(Kb + ka + 32 * ds), a1 = *(const LAS bf16x8*)(Kb + ka + 32 * KS + 32 * ds);
                s0 = FA_MFMA(a0, qf[ds], s0); s1 = FA_MFMA(a1, qf[ds], s1); }
            __builtin_amdgcn_s_setprio(0);
            if (k0 < NPAD || k0 + 63 > 128 * qbw + 32 * wq) {
#pragma unroll
                for (int r = 0; r < 16; ++r) { const int key = k0 + 16 * (r >> 3) + 8 * hi + (r & 7);
                    if (key > q_abs || key < NPAD) s0[r] = NEGBIG;
                    if (key + 32 > q_abs || key + 32 < NPAD) s1[r] = NEGBIG; }
            }
            float tm = max3f(s0[0], s0[1], s1[0]), tm2 = max3f(s0[2], s0[3], s1[1]); tm = max3f(tm, s1[2], s1[3]);
#pragma unroll
            for (int r = 4; r < 16; r += 4) { tm = max3f(tm, s0[r], s0[r + 1]); tm2 = max3f(tm2, s0[r + 2], s0[r + 3]); tm = max3f(tm, s1[r], s1[r + 1]); tm2 = max3f(tm2, s1[r + 2], s1[r + 3]); }
            tm = fmaxf(tm, tm2);
            { const auto rr = __builtin_amdgcn_permlane32_swap(__float_as_uint(tm), __float_as_uint(tm), false, false); tm = fmaxf(__uint_as_float(rr[0]), __uint_as_float(rr[1])); }
            float tmpost = tm;
            if (first || __any(tm > 8.0f)) {
                const float dl = first ? tm : fmaxf(tm, 0.f);
                m_ref += dl; tmpost = tm - dl;
                if (!first) { const float f = __builtin_amdgcn_exp2f(-dl); l *= f; lacc[0] *= f;
#pragma unroll
                    for (int db = 0; db < NDB; ++db)
#pragma unroll
                        for (int r = 0; r < 16; ++r) oacc[db][r] *= f; }
#pragma unroll
                for (int r = 0; r < 16; ++r) { s0[r] -= dl; s1[r] -= dl; }
                if (DIFF) {
#pragma unroll
                    for (int r = 0; r < 16; ++r) negm[r] = -m_ref;
                }
                first = false;
            }
            if (!__all(tmpost < -150.0f)) {
            float ps = 0.f, ps2 = 0.f;
#pragma unroll
            for (int r = 0; r < 16; ++r) { s0[r] = __builtin_amdgcn_exp2f(s0[r]); s1[r] = __builtin_amdgcn_exp2f(s1[r]); if (DIFF) { ps += s0[r]; ps2 += s1[r]; asm volatile("" : "+v"(ps), "+v"(ps2)); } }
            if (DIFF) l += ps + ps2;
            bf16x8 pb[4];
            { u32x4 t0 = {cvtpk(s0[0], s0[1]), cvtpk(s0[2], s0[3]), cvtpk(s0[4], s0[5]), cvtpk(s0[6], s0[7])}; pb[0] = __builtin_bit_cast(bf16x8, t0);
              u32x4 t1 = {cvtpk(s0[8], s0[9]), cvtpk(s0[10], s0[11]), cvtpk(s0[12], s0[13]), cvtpk(s0[14], s0[15])}; pb[1] = __builtin_bit_cast(bf16x8, t1);
              u32x4 t2 = {cvtpk(s1[0], s1[1]), cvtpk(s1[2], s1[3]), cvtpk(s1[4], s1[5]), cvtpk(s1[6], s1[7])}; pb[2] = __builtin_bit_cast(bf16x8, t2);
              u32x4 t3 = {cvtpk(s1[8], s1[9]), cvtpk(s1[10], s1[11]), cvtpk(s1[12], s1[13]), cvtpk(s1[14], s1[15])}; pb[3] = __builtin_bit_cast(bf16x8, t3); }
            __builtin_amdgcn_s_setprio(1);
#pragma unroll
            for (int ks = 0; ks < 4; ++ks) {
#pragma unroll
                for (int db = 0; db < NDB; ++db) { const bf16x8 av = *(const LAS bf16x8*)(Vb + va + 32 * db * VS + 32 * ks); oacc[db] = FA_MFMA(av, pb[ks], oacc[db]); }
                if (!DIFF) lacc = FA_MFMA(onesf, pb[ks], lacc);
            }
            __builtin_amdgcn_s_setprio(0);
            }
        }
        }
        if (st - 1 > st_end) FA_STORE(bo ^ BUF);
        __syncthreads();
        bo ^= BUF;
    }
#undef FA_LOAD
#undef FA_STORE
    if (DIFF) l += __shfl_xor(l, 32); else l = __shfl(lacc[0], ql);
    const float inv = (q_abs >= NPAD) ? 1.0f / l : 0.f;
    if (DIFF) {
        LAS float* X = (LAS float*)(L + OFF_X);
        if (g == 1) {
#pragma unroll
            for (int db = 0; db < NDB; ++db)
#pragma unroll
                for (int r = 0; r < 16; ++r) X[((wq * 4 + db) * 16 + r) * 64 + lane] = oacc[db][r] * inv;
        }
        __syncthreads();
        if (g == 0) {
            float ss = 0.f;
#pragma unroll
            for (int db = 0; db < NDB; ++db)
#pragma unroll
                for (int r = 0; r < 16; ++r) { const float c = oacc[db][r] * inv - lam * X[((wq * 4 + db) * 16 + r) * 64 + lane]; oacc[db][r] = c; ss += c * c; }
            ss += __shfl_xor(ss, 32);
            const float rr = rsqrtf(ss * (1.0f / 128.f) + SUBLN_EPS);
            bf16_t* dst = AO + qrow * D + hu * 128;
#pragma unroll
            for (int db = 0; db < NDB; ++db)
#pragma unroll
                for (int t = 0; t < 4; ++t) { const int d = 32 * db + 8 * t + 4 * hi;
                    u32x2 o; o.x = cvtpk(oacc[db][4 * t] * rr, oacc[db][4 * t + 1] * rr); o.y = cvtpk(oacc[db][4 * t + 2] * rr, oacc[db][4 * t + 3] * rr);
                    *(u32x2*)(dst + d) = o; }
        }
    } else {
        bf16_t* dst = AO + qrow * D + 512 + hu * 64;
#pragma unroll
        for (int db = 0; db < NDB; ++db)
#pragma unroll
            for (int t = 0; t < 4; ++t) { const int d = 32 * db + 8 * t + 4 * hi;
                u32x2 o; o.x = cvtpk(oacc[db][4 * t] * inv, oacc[db][4 * t + 1] * inv); o.y = cvtpk(oacc[db][4 * t + 2] * inv, oacc[db][4 * t + 3] * inv);
                *(u32x2*)(dst + d) = o; }
    }
}

__device__ __forceinline__ void phase(const Params& P, LAS unsigned char* L) {
    const int tid = threadIdx.x;
    unsigned* ctr = (unsigned*)(P.ws + WS_CTL) + 64;
    LAS int* su = (LAS int*)(L + OFF_UNIT);
    const float lam = ((const float*)(P.ws + WS_CTL))[0];
    const int x0 = (int)(__builtin_amdgcn_s_getreg((3 << 11) | 20) & 7u);
    int a = 0;
    for (;;) {
        const int x = (x0 + a) & 7;
        if (tid == 0) *su = (int)atomicAdd(ctr + 64 * x, 1u);
        __syncthreads();
        const int i = __builtin_amdgcn_readfirstlane(*su);
        __syncthreads();
        if (i >= 256) { if (++a == 8) break; continue; }
        if (i < 128) { const int d = 2 * x + (i & 1); unit<true>(P, L, d >> 2, d & 3, 65 - (i >> 1), lam); }
        else { const int j = i - 128; const int f = 4 * x + (j & 3); unit<false>(P, L, f >> 3, f & 7, 32 - (j >> 2), lam); }
    }
}
}

#ifndef FAST_ATTN
#define FAST_ATTN 1
#endif
template <bool DIFF> __global__ void __launch_bounds__(256) naive_attn(Params P) { naive_attn_body<DIFF>(P, threadIdx.x, blockIdx.x, blockIdx.y, blockIdx.z); }
#define XB_TMO      128
#define XB_XCNT(j)  (256  + 64 * (j))
#define XB_XSUB(j)  (1280 + 64 * (j))
#define XB_XGEN(j)  (2304 + 64 * (j))
#define XB_TOP      3328
#define XB_TOPGEN   3392
#define XCD_BAR_WORDS 3456
#define XB_SPIN_CAP (1u << 18)

__device__ __forceinline__ unsigned xb_ld(unsigned* p)              { return __hip_atomic_load(p, __ATOMIC_RELAXED, __HIP_MEMORY_SCOPE_AGENT); }
__device__ __forceinline__ unsigned xb_add(unsigned* p, unsigned v) { return __hip_atomic_fetch_add(p, v, __ATOMIC_RELAXED, __HIP_MEMORY_SCOPE_AGENT); }
__device__ __forceinline__ unsigned xb_xcc_id() { return (unsigned)__builtin_amdgcn_s_getreg((3 << 11) | 20) & 0xFu; }
#define XB_SPIN(cond, bar) do { unsigned _sp = 0; while (cond) { __builtin_amdgcn_s_sleep(1); \
    if ((++_sp & 255u) == 0u) { if (xb_ld(&(bar)[XB_TMO])) break; if (_sp > XB_SPIN_CAP) { atomicAdd(&(bar)[XB_TMO], 1u); break; } } } } while (0)

struct XcdBarrier {
    unsigned* bar; unsigned x;
    volatile LAS unsigned* st;
};

__device__ __forceinline__ XcdBarrier xcd_barrier_post(unsigned* bar, volatile LAS unsigned* st) {
    XcdBarrier b; b.bar = bar; b.x = xb_xcc_id(); b.st = st;
    if (threadIdx.x == 0) (void)xb_add(&bar[XB_XCNT(b.x)], 1u);
    return b;
}
__device__ __forceinline__ void xcd_barrier_complete(unsigned* bar, unsigned x, unsigned& nloc, unsigned& nx) {
    const unsigned G = gridDim.x * gridDim.y * gridDim.z;
    unsigned sum, cnt, mine, sp = 0u;
    for (;;) {
        sum = 0u; cnt = 0u; mine = 0u;
#pragma unroll
        for (unsigned j = 0; j < 16; ++j) { const unsigned c = xb_ld(&bar[XB_XCNT(j)]); sum += c; cnt += (c > 0u) ? 1u : 0u; mine = (j == x) ? c : mine; }
        if (sum == G) break;
        __builtin_amdgcn_s_sleep(1);
        if ((++sp & 255u) == 0u) { if (xb_ld(&bar[XB_TMO])) break; if (sp > XB_SPIN_CAP) { atomicAdd(&bar[XB_TMO], 1u); break; } }
    }
    nloc = mine > 0u ? mine : 1u; nx = cnt > 0u ? cnt : 1u;
}

__device__ __forceinline__ void xcd_barrier(const XcdBarrier& b) {
    asm volatile("s_waitcnt vmcnt(0)" ::: "memory");
    __syncthreads();
    if (threadIdx.x == 0) {
        unsigned* bar = b.bar;
        __builtin_amdgcn_s_waitcnt(0);
        unsigned nloc = b.st[0], nx = b.st[1];
        if (nloc == 0u) { xcd_barrier_complete(bar, b.x, nloc, nx); b.st[0] = nloc; b.st[1] = nx; }
        const unsigned old = xb_add(&bar[XB_XSUB(b.x)], 1u);
        const unsigned gen = old / nloc;
        if (old + 1u == (gen + 1u) * nloc) {
            __builtin_amdgcn_fence(__ATOMIC_RELEASE, "agent");
            asm volatile("s_waitcnt vmcnt(0)" ::: "memory");
            const unsigned og = xb_add(&bar[XB_TOP], 1u);
            const unsigned tg = og / nx;
            if (og + 1u == (tg + 1u) * nx) xb_add(&bar[XB_TOPGEN], 1u);
            else XB_SPIN(xb_ld(&bar[XB_TOPGEN]) == tg, bar);
            __builtin_amdgcn_fence(__ATOMIC_ACQUIRE, "agent");
            xb_add(&bar[XB_XGEN(b.x)], 1u);
            asm volatile("s_waitcnt vmcnt(0)" ::: "memory");
        } else {
            XB_SPIN(xb_ld(&bar[XB_XGEN(b.x)]) == gen, bar);
            __builtin_amdgcn_fence(__ATOMIC_ACQUIRE, "agent");
            asm volatile("s_waitcnt vmcnt(0)" ::: "memory");
        }
    }
    __syncthreads();
}

constexpr size_t WS_XBAR = 16 * 1024;
constexpr int LDS_XBST = 147456 - 64;
constexpr int LDS_BYTES = 147456;
constexpr int N_PHASES = 10;
#ifndef MK_PER_PHASE
#define MK_PER_PHASE 0
#endif

__global__ void __launch_bounds__(512, 2) mk(Params P) {
    extern __shared__ __attribute__((aligned(16))) unsigned char lds[];
    cg::grid_group grid = cg::this_grid();
    LAS unsigned char* L = (LAS unsigned char*)lds;
    const int tid = threadIdx.x, lane = tid & 63, wave = __builtin_amdgcn_readfirstlane(tid >> 6);
    const int G = gridDim.x, gw = blockIdx.x * 8 + wave, NGW = G * 8;
    unsigned char* ws = P.ws;
    float* ssq = (float*)(ws + WS_SSQ);
    bf16_t* HB = (bf16_t*)P.out; bf16_t* ACT = (bf16_t*)(ws + WS_BIG); bf16_t* QK = (bf16_t*)(ws + WS_BIG); bf16_t* VT = (bf16_t*)(ws + WS_VT); bf16_t* AO = (bf16_t*)(ws + WS_AO);
    float* H = (float*)(ws + WS_H);
    const int lo = P.ph_lo, hi = P.ph_hi;
#define IN(k) (lo <= (k) && (k) < hi)
    volatile LAS unsigned* xst = (volatile LAS unsigned*)(L + LDS_XBST);
    if (tid < 2) xst[tid] = 0u;
    __syncthreads();
    unsigned* xbar_words = (unsigned*)(ws + WS_XBAR);
    XcdBarrier xbar; xbar.bar = xbar_words; xbar.x = 0; xbar.st = xst;
    if (hi - lo > 1) xbar = xcd_barrier_post(xbar_words, xst);
    if (hi > 1000) grid.sync();
#define SEAM(k) do { if (IN(k) && IN((k) + 1)) xcd_barrier(xbar); } while (0)

    if (IN(0)) { p0_prologue(P, (LAS float*)(L + wave * 17408), gw, NGW, lane); }
    SEAM(0);
    if (IN(1)) {
        for (int t = blockIdx.x; t < DFF / 16; t += G) side_stage1(P, (LAS float*)L, t);
        pg8::Gemm g{HB, (const bf16_t*)(ws + WS_WGU1), TP, NGU, D}; LiveOrder S; S.init(NGU, G, (int)blockIdx.x);
        PgSwiglu E{ssq, ACT};
        pg8::gemm_phase<PgSwiglu, LiveOrder, true, true>(L, g, S, E);
    }
    SEAM(1);
    if (IN(2)) {
        for (int t = blockIdx.x; t < D / 16; t += G) side_stage2(P, (LAS float*)L, t);
        pg8::Gemm g{ACT, (const bf16_t*)(ws + WS_WD1), TP, D, DFF}; LiveOrder S; S.init(D, G, (int)blockIdx.x);
        PgResid E{EpiResid{&P, 1, 0.5f, nullptr, HB, nullptr}, ssq + (size_t)1 * TP};
        pg8::gemm_phase<PgResid, LiveOrder, true, true>(L, g, S, E);
    }
    SEAM(2);
    if (IN(3)) {
        zero_pad_kv(ws, gw, NGW, lane);
        for (int t = blockIdx.x; t < 129; t += G) side_stage3(P, (LAS float*)L, t);
        gates_rows(P, wave * G + (int)blockIdx.x, NGW, lane);
        pg8::Gemm g{HB, (const bf16_t*)(ws + WS_WIN), TP, 3072, D}; LiveOrder S; S.init(3072, G, (int)blockIdx.x);
        PgInproj E{EpiInproj{(const float*)(ws + WS_ROPE), P.in[7], QK, VT, (float*)(ws + WS_LOGF)}, ssq + (size_t)1 * TP};
        pg8::gemm_phase<PgInproj, LiveOrder, true, true>(L, g, S, E);
    }
    SEAM(3);
    if (IN(4)) {
        if (G >= 64) { if (blockIdx.x < 32) cum_scan_seq((const float*)(ws + WS_LOGF), (float*)(ws + WS_CUM), blockIdx.x, (LAS float*)L, tid);
                       else if (blockIdx.x < 64) key_norm_max(QK, (float*)(ws + WS_KNMAX), blockIdx.x - 32, (LAS float*)L, tid); }
        else { for (int bh = blockIdx.x; bh < 32; bh += G) { cum_scan_seq((const float*)(ws + WS_LOGF), (float*)(ws + WS_CUM), bh, (LAS float*)L, tid); key_norm_max(QK, (float*)(ws + WS_KNMAX), bh, (LAS float*)L, tid); } }
    }
    SEAM(4);
    if (IN(5)) {
#if FAST_ATTN
        fa::phase(P, L);
#endif
    }
    SEAM(5);
    if (IN(6)) {
        pg8::Gemm g{AO, (const bf16_t*)(ws + WS_WOUT), TP, D, D}; LiveOrder S; S.init(D, G, (int)blockIdx.x);
        PgResid E{EpiResid{&P, 0, 1.0f, nullptr, HB, HB}, ssq + (size_t)2 * TP};
        pg8::gemm_phase<PgResid, LiveOrder, true, true>(L, g, S, E);
    }
    SEAM(6);
    if (IN(7)) {
        pg8::Gemm g{HB, (const bf16_t*)(ws + WS_WGU2), TP, NGU, D}; LiveOrder S; S.init(NGU, G, (int)blockIdx.x);
        PgSwiglu E{ssq + (size_t)2 * TP, ACT};
        pg8::gemm_phase<PgSwiglu, LiveOrder, true, true>(L, g, S, E);
    }
    SEAM(7);
    if (IN(8)) {
        pg8::Gemm g{ACT, (const bf16_t*)(ws + WS_WD2), TP, D, DFF}; LiveOrder S; S.init(D, G, (int)blockIdx.x);
        PgResid E{EpiResid{&P, 0, 0.5f, H, nullptr, HB}, ssq + (size_t)3 * TP};
        pg8::gemm_phase<PgResid, LiveOrder, true, true>(L, g, S, E);
    }
    SEAM(8);
    if (IN(9)) final_norm_rows(P, gw, NGW, lane);
#undef IN
#undef SEAM
}

extern "C" void kernel_launch(void* const* d_in, const int* in_sizes, int n_in, void* d_out, int out_size, void* d_ws, size_t ws_size, hipStream_t stream) {
    if (n_in != 18 || out_size != BATCH * SEQ * D || ws_size < WS_END) { fprintf(stderr, "kernel_launch: unexpected shapes (n_in %d out %d ws %zu need %zu)\n", n_in, out_size, ws_size, (size_t)WS_END); return; }
    static int grid = 0;
    if (grid == 0) {
        int dev = 0, cus = 0, per_cu = 0;
        (void)hipGetDevice(&dev); (void)hipDeviceGetAttribute(&cus, hipDeviceAttributeMultiprocessorCount, dev);
        (void)hipFuncSetAttribute((const void*)mk, hipFuncAttributeMaxDynamicSharedMemorySize, LDS_BYTES);
        (void)hipOccupancyMaxActiveBlocksPerMultiprocessor(&per_cu, (const void*)mk, 512, LDS_BYTES);
        if (per_cu < 1) { fprintf(stderr, "kernel_launch: occupancy query says %d blocks per CU\n", per_cu); per_cu = 1; }
        grid = cus * per_cu;
    }
    Params P{};
    for (int i = 0; i < 18; ++i) P.in[i] = (const float*)d_in[i];
    P.out = (float*)d_out; P.ws = (unsigned char*)d_ws;
#if MK_PER_PHASE
    for (int ph = 0; ph < N_PHASES; ++ph) { P.ph_lo = ph; P.ph_hi = ph + 1;
        if (ph == 5 && !FAST_ATTN) { hipLaunchKernelGGL(naive_attn<true>, dim3(LP / 64, 4, BATCH), dim3(256), 0, stream, P); hipLaunchKernelGGL(naive_attn<false>, dim3(LP / 128, 8, BATCH), dim3(256), 0, stream, P); continue; }
        hipLaunchKernelGGL(mk, dim3(grid), dim3(512), LDS_BYTES, stream, P); }
#else
    P.ph_lo = 0; P.ph_hi = N_PHASES;
    if (hipMemsetAsync((unsigned char*)d_ws + WS_XBAR, 0, XCD_BAR_WORDS * 4, stream) != hipSuccess) { fprintf(stderr, "kernel_launch: memset of the barrier words failed\n"); return; }
    void* args[] = {&P};
    hipError_t e = hipLaunchCooperativeKernel((const void*)mk, dim3(grid), dim3(512), args, LDS_BYTES, stream);
    if (e != hipSuccess) fprintf(stderr, "cooperative launch failed: %s (grid %d)\n", hipGetErrorString(e), grid);
#endif
}
```
